# Optimizing an MI355X kernel written in HIP

```python
import math
import numpy as np
import jax
import jax.numpy as jnp
from jax import lax

D_MODEL = 1024
BATCH = 8
SEQ = 2048
DEPTH = 1

GRID_W = 64
CTX_LEN = 256
MIX_WIDTH = D_MODEL
MOD_CHUNKS = 6
EPS = 1e-6

ATTN_HEADS = 8
ATTN_KV_HEADS = 2
ATTN_HEAD_DIM = (MIX_WIDTH // 2) // ATTN_HEADS
ROPE_BASE = 10000.0
Q_BLOCK = 128

DN_HEADS = 4
DN_HEAD_DIM = (MIX_WIDTH // 2) // DN_HEADS
DN_CONV_W = 5
DN_CHUNK = 64

N_EXPERTS = 16
EC_CAPACITY_FACTOR = 2
EXPERT_FF = 1024

ATTN_Q_W = ATTN_HEADS * ATTN_HEAD_DIM
ATTN_KV_W = ATTN_KV_HEADS * ATTN_HEAD_DIM
DN_W = DN_HEADS * DN_HEAD_DIM
IN_SPLITS = (ATTN_Q_W, ATTN_KV_W, ATTN_KV_W, DN_W, DN_W, DN_W, DN_W, 2 * DN_HEADS, 2 * DN_HEADS)
IN_WIDTH = sum(IN_SPLITS)
IN_OFFSETS = tuple(int(v) for v in np.cumsum(IN_SPLITS)[:-1])

kernel_name = "hybrid_dit_gqa_gdn_ec_moe"


def rmsnorm(x, w):
    xf = x.astype(jnp.float32)
    xf = xf * lax.rsqrt(jnp.mean(xf * xf, axis=-1, keepdims=True) + EPS)
    return xf.astype(x.dtype) * w


def l2norm(x):
    xf = x.astype(jnp.float32)
    return (xf * lax.rsqrt(jnp.sum(xf * xf, axis=-1, keepdims=True) + EPS)).astype(x.dtype)


def modulate(h, shift, scale):
    return h * (1 + scale) + shift


def split_heads(t, n_heads):
    b, l, w = t.shape
    return t.reshape(b, l, n_heads, w // n_heads).transpose(0, 2, 1, 3)


def merge_heads(t):
    b, n, l, d = t.shape
    return t.transpose(0, 2, 1, 3).reshape(b, l, n * d)


def rope_axis(x, pos):
    m = x.shape[-1] // 2
    freqs = ROPE_BASE ** (-jnp.arange(m, dtype=jnp.float32) / m)
    ang = pos.astype(jnp.float32)[:, None] * freqs[None, :]
    cos = jnp.cos(ang).astype(x.dtype)
    sin = jnp.sin(ang).astype(x.dtype)
    x1, x2 = x[..., :m], x[..., m:]
    return jnp.concatenate([x1 * cos - x2 * sin, x2 * cos + x1 * sin], axis=-1)


def rope2d(x, rows, cols):
    h = x.shape[-1] // 2
    return jnp.concatenate([rope_axis(x[..., :h], rows), rope_axis(x[..., h:], cols)], axis=-1)


def attend_blocked(q, k, v):
    b, hq, lq, dh = q.shape
    hkv = k.shape[1]
    grp = hq // hkv
    nb = lq // Q_BLOCK
    qb = q.reshape(b, hkv, grp, nb, Q_BLOCK, dh).transpose(3, 0, 1, 2, 4, 5)
    scale = dh ** -0.5

    def one_block(qblk):
        s = jnp.einsum('bkgqd,bksd->bkgqs', qblk, k).astype(jnp.float32) * scale
        p = jax.nn.softmax(s, axis=-1).astype(v.dtype)
        return jnp.einsum('bkgqs,bksd->bkgqd', p, v)

    ob = lax.map(one_block, qb)
    return ob.transpose(1, 2, 3, 0, 4, 5).reshape(b, hq, lq, dh)


def short_conv(x, w):
    pad = DN_CONV_W // 2
    return lax.conv_general_dilated(
        x, w[:, None, :], window_strides=(1,), padding=[(pad, pad)],
        dimension_numbers=('NWC', 'WIO', 'NWC'), feature_group_count=x.shape[-1])


def delta_rule_chunked(q, k, v, g, beta, s0, need_output):
    f32 = jnp.float32
    b, h, l, dk = q.shape
    dv = v.shape[-1]
    n = l // DN_CHUNK
    q = q.astype(f32).reshape(b, h, n, DN_CHUNK, dk)
    k = k.astype(f32).reshape(b, h, n, DN_CHUNK, dk)
    v = v.astype(f32).reshape(b, h, n, DN_CHUNK, dv)
    g = g.astype(f32).reshape(b, h, n, DN_CHUNK)
    beta = beta.astype(f32).reshape(b, h, n, DN_CHUNK)

    g_cum = jnp.cumsum(g, axis=-1)
    tril = jnp.tril(jnp.ones((DN_CHUNK, DN_CHUNK), dtype=bool))
    eye = jnp.eye(DN_CHUNK, dtype=bool)
    decay = jnp.exp(jnp.where(tril, g_cum[..., :, None] - g_cum[..., None, :], -jnp.inf))
    k_beta = k * beta[..., None]
    a_strict = jnp.where(tril & ~eye, jnp.einsum('bhnid,bhnjd->bhnij', k_beta, k) * decay, 0.0)
    unit_lower = a_strict + eye.astype(f32)
    rhs = jnp.concatenate([v * beta[..., None], k_beta * jnp.exp(g_cum)[..., None]], axis=-1)
    sol = lax.linalg.triangular_solve(unit_lower, rhs, left_side=True, lower=True, unit_diagonal=True)
    u, w = sol[..., :dv], sol[..., dv:]
    k_dec = k * jnp.exp(g_cum[..., -1:] - g_cum)[..., None]
    g_last = jnp.exp(g_cum[..., -1])

    xs = [u, w, k_dec, g_last]
    if need_output:
        qk = jnp.einsum('bhnid,bhnjd->bhnij', q, k) * decay
        q_dec = q * jnp.exp(g_cum)[..., None]
        xs += [qk, q_dec]
    xs = tuple(jnp.moveaxis(t, 2, 0) for t in xs)

    def step(s, inp):
        u_c, w_c, kd_c, gl_c = inp[:4]
        v_new = u_c - jnp.einsum('bhck,bhkv->bhcv', w_c, s)
        s_next = s * gl_c[..., None, None] + jnp.einsum('bhck,bhcv->bhkv', kd_c, v_new)
        if need_output:
            qk_c, qd_c = inp[4:]
            o = jnp.einsum('bhck,bhkv->bhcv', qd_c, s) + jnp.einsum('bhij,bhjv->bhiv', qk_c, v_new)
            return s_next, o
        return s_next, None

    s_final, o = lax.scan(step, s0.astype(f32), xs)
    if need_output:
        o = jnp.moveaxis(o, 0, 2).reshape(b, h, l, dv)
    return o, s_final


def dn_gates(alpha, beta_logits, a_log, dt_bias):
    b, l, _ = alpha.shape
    alpha = alpha.astype(jnp.float32).reshape(b, l, 2, DN_HEADS).transpose(2, 0, 3, 1)
    beta = jax.nn.sigmoid(beta_logits.astype(jnp.float32).reshape(b, l, 2, DN_HEADS).transpose(2, 0, 3, 1))
    a = jnp.exp(a_log.astype(jnp.float32))[:, None, :, None]
    g = -a * jax.nn.softplus(alpha + dt_bias.astype(jnp.float32)[:, None, :, None])
    return g, beta


def token_mixer(h_lat, h_ctx, rows, cols, w_in, q_norm_w, k_norm_w, conv_w, a_log, dt_bias,
                o_norm_w, w_out, update_ctx):
    p_lat = h_lat @ w_in
    p_ctx = h_ctx @ w_in
    aq_l, ak_l, av_l, dq_l, dk_l, dv_l, dz_l, db_l, da_l = jnp.split(p_lat, IN_OFFSETS, axis=-1)
    aq_c, ak_c, av_c, dq_c, dk_c, dv_c, dz_c, db_c, da_c = jnp.split(p_ctx, IN_OFFSETS, axis=-1)

    def attn_qkv(aq, ak, av):
        q = rmsnorm(split_heads(aq, ATTN_HEADS), q_norm_w)
        k = rmsnorm(split_heads(ak, ATTN_KV_HEADS), k_norm_w)
        return q, k, split_heads(av, ATTN_KV_HEADS)

    q_l, k_l, v_l = attn_qkv(aq_l, ak_l, av_l)
    q_l = rope2d(q_l, rows, cols)
    k_l = rope2d(k_l, rows, cols)
    q_c, k_c, v_c = attn_qkv(aq_c, ak_c, av_c)
    k_all = jnp.concatenate([k_c, k_l], axis=2)
    v_all = jnp.concatenate([v_c, v_l], axis=2)
    att_lat = merge_heads(attend_blocked(q_l, k_all, v_all))

    def dn_qkv(dq, dk, dv):
        qkv = jax.nn.silu(short_conv(jnp.concatenate([dq, dk, dv], axis=-1), conv_w))
        q, k, v = jnp.split(qkv, 3, axis=-1)
        q = l2norm(split_heads(q, DN_HEADS)) * (DN_HEAD_DIM ** -0.5)
        k = l2norm(split_heads(k, DN_HEADS))
        return q, k, split_heads(v, DN_HEADS)

    dq_lh, dk_lh, dv_lh = dn_qkv(dq_l, dk_l, dv_l)
    dq_ch, dk_ch, dv_ch = dn_qkv(dq_c, dk_c, dv_c)
    g_l, b_l = dn_gates(da_l, db_l, a_log, dt_bias)
    g_c, b_c = dn_gates(da_c, db_c, a_log, dt_bias)
    batch = h_lat.shape[0]

    def seq_flip(t):
        return jnp.flip(t, axis=2)

    outs_lat, outs_ctx = [], []
    for d in range(2):
        ctx_in = (dq_ch, dk_ch, dv_ch, g_c[d], b_c[d])
        lat_in = (dq_lh, dk_lh, dv_lh, g_l[d], b_l[d])
        if d == 1:
            ctx_in = tuple(seq_flip(t) for t in ctx_in)
            lat_in = tuple(seq_flip(t) for t in lat_in)
        s0 = jnp.zeros((batch, DN_HEADS, DN_HEAD_DIM, DN_HEAD_DIM), jnp.float32)
        o_c, s_c = delta_rule_chunked(*ctx_in, s0, need_output=update_ctx)
        o_l, _ = delta_rule_chunked(*lat_in, s_c, need_output=True)
        outs_lat.append(seq_flip(o_l) if d == 1 else o_l)
        if update_ctx:
            outs_ctx.append(seq_flip(o_c) if d == 1 else o_c)

    def dn_output(o, dz):
        o = o.astype(dz.dtype).transpose(0, 2, 1, 3)
        z = dz.reshape(dz.shape[0], dz.shape[1], DN_HEADS, DN_HEAD_DIM)
        y = rmsnorm(o, o_norm_w) * jax.nn.silu(z)
        return y.reshape(dz.shape[0], dz.shape[1], DN_W)

    dn_lat = dn_output(outs_lat[0] + outs_lat[1], dz_l)
    y_lat = jnp.concatenate([att_lat, dn_lat], axis=-1) @ w_out

    y_ctx = None
    if update_ctx:
        att_ctx = merge_heads(attend_blocked(q_c, k_c, v_c))
        dn_ctx = dn_output(outs_ctx[0] + outs_ctx[1], dz_c)
        y_ctx = jnp.concatenate([att_ctx, dn_ctx], axis=-1) @ w_out
    return y_lat, y_ctx


def expert_choice_ffn(h, router_w, w_gate, w_up, w_down):
    b, t, d = h.shape
    cap = EC_CAPACITY_FACTOR * t // N_EXPERTS
    affinity = jax.nn.softmax((h @ router_w).astype(jnp.float32), axis=-1)
    gates, idx = lax.top_k(jnp.swapaxes(affinity, 1, 2), cap)
    xg = jax.vmap(lambda hb, ib: hb[ib])(h, idx)
    hid = jax.nn.silu(jnp.einsum('becd,edf->becf', xg, w_gate)) * jnp.einsum('becd,edf->becf', xg, w_up)
    y = jnp.einsum('becf,efd->becd', hid, w_down) * gates[..., None].astype(h.dtype)
    return jax.vmap(lambda yb, ib: jnp.zeros((t, d), yb.dtype).at[ib.reshape(-1)].add(yb.reshape(-1, d)))(y, idx)


def setup_inputs(seed: int = 0) -> dict:
    key = jax.random.key(seed)
    ks = jax.random.split(key, 20)
    f32 = jnp.float32

    def nrm(k, shape, scale):
        return jax.random.normal(k, shape, f32) * scale

    dt = jnp.exp(jax.random.uniform(ks[14], (DEPTH, 2, DN_HEADS), f32, math.log(1e-3), math.log(1e-1)))
    return {
        "x": nrm(ks[0], (BATCH, SEQ, D_MODEL), 1.0),
        "c": nrm(ks[1], (BATCH, D_MODEL), 1.0),
        "ctx": nrm(ks[2], (BATCH, CTX_LEN, D_MODEL), 1.0),
        "c_ctx": nrm(ks[3], (D_MODEL,), 1.0),
        "w_mod": nrm(ks[4], (DEPTH, D_MODEL, MOD_CHUNKS * D_MODEL), 0.5 * D_MODEL ** -0.5),
        "b_mod": nrm(ks[5], (DEPTH, MOD_CHUNKS * D_MODEL), 0.02),
        "norm1_w": 1.0 + nrm(ks[6], (DEPTH, D_MODEL), 0.02),
        "norm2_w": 1.0 + nrm(ks[7], (DEPTH, D_MODEL), 0.02),
        "w_in": nrm(ks[8], (DEPTH, D_MODEL, IN_WIDTH), D_MODEL ** -0.5),
        "q_norm_w": 1.0 + nrm(ks[9], (DEPTH, ATTN_HEAD_DIM), 0.02),
        "k_norm_w": 1.0 + nrm(ks[10], (DEPTH, ATTN_HEAD_DIM), 0.02),
        "conv_w": nrm(ks[11], (DEPTH, DN_CONV_W, 3 * DN_W), DN_CONV_W ** -0.5),
        "a_log": jnp.log(jax.random.uniform(ks[12], (DEPTH, 2, DN_HEADS), f32, 1.0, 16.0)),
        "dt_bias": dt + jnp.log(-jnp.expm1(-dt)),
        "o_norm_w": 1.0 + nrm(ks[13], (DEPTH, DN_HEAD_DIM), 0.02),
        "w_out": nrm(ks[15], (DEPTH, MIX_WIDTH, D_MODEL), MIX_WIDTH ** -0.5),
        "router_w": nrm(ks[16], (DEPTH, D_MODEL, N_EXPERTS), D_MODEL ** -0.5),
        "w_gate": nrm(ks[17], (DEPTH, N_EXPERTS, D_MODEL, EXPERT_FF), D_MODEL ** -0.5),
        "w_up": nrm(ks[18], (DEPTH, N_EXPERTS, D_MODEL, EXPERT_FF), D_MODEL ** -0.5),
        "w_down": nrm(ks[19], (DEPTH, N_EXPERTS, EXPERT_FF, D_MODEL), EXPERT_FF ** -0.5),
    }


def reference(x, c, ctx, c_ctx, w_mod, b_mod, norm1_w, norm2_w, w_in, q_norm_w, k_norm_w, conv_w,
              a_log, dt_bias, o_norm_w, w_out, router_w, w_gate, w_up, w_down):
    seq_len = x.shape[1]
    n_rows = seq_len // GRID_W
    rows = jnp.repeat(jnp.arange(n_rows, dtype=jnp.int32), GRID_W)
    cols = jnp.tile(jnp.arange(GRID_W, dtype=jnp.int32), n_rows)
    silu_c = jax.nn.silu(c)
    silu_cc = jax.nn.silu(c_ctx)
    for l in range(DEPTH):
        update_ctx = l < DEPTH - 1
        mod_lat = silu_c @ w_mod[l] + b_mod[l]
        mod_ctx = silu_cc @ w_mod[l] + b_mod[l]
        sh1, sc1, g1, sh2, sc2, g2 = jnp.split(mod_lat[:, None, :], MOD_CHUNKS, axis=-1)
        csh1, csc1, cg1, csh2, csc2, cg2 = jnp.split(mod_ctx, MOD_CHUNKS, axis=-1)

        h_lat = modulate(rmsnorm(x, norm1_w[l]), sh1, sc1)
        h_ctx = modulate(rmsnorm(ctx, norm1_w[l]), csh1, csc1)
        y_lat, y_ctx = token_mixer(h_lat, h_ctx, rows, cols, w_in[l], q_norm_w[l], k_norm_w[l], conv_w[l],
                                   a_log[l], dt_bias[l], o_norm_w[l], w_out[l], update_ctx)
        x = x + g1 * y_lat
        h2 = modulate(rmsnorm(x, norm2_w[l]), sh2, sc2)
        x = x + g2 * expert_choice_ffn(h2, router_w[l], w_gate[l], w_up[l], w_down[l])

        if update_ctx:
            ctx = ctx + cg1 * y_ctx
            h2c = modulate(rmsnorm(ctx, norm2_w[l]), csh2, csc2)
            ctx = ctx + cg2 * expert_choice_ffn(h2c, router_w[l], w_gate[l], w_up[l], w_down[l])
    return x
```

```cpp
#include <hip/hip_runtime.h>
#include <cstdio>
#include <cstdint>
namespace pg8 {
#define PG8_LAS __attribute__((address_space(3)))
typedef unsigned short bf16_t;
typedef short bf16x8 __attribute__((ext_vector_type(8)));
typedef float f32x4 __attribute__((ext_vector_type(4)));
typedef unsigned u32x4 __attribute__((ext_vector_type(4)));
constexpr int BM = 256, BK = 64, HALF = 128, HTB = HALF * BK * 2  , STAGE_BYTES = 8 * HTB, NXCD = 8, WGM = 8;

__host__ __device__ __forceinline__ int lds_byte(int r, int c) { const int st = (r >> 4) * 2 + (c >> 5), rr = r & 15, cc = c & 31, ob = rr * 64 + cc * 2; return st * 1024 + (ob ^ (((ob >> 9) & 1) << 5)); }
__host__ __device__ __forceinline__ void stage_rc(int b, int& R, int& C) { const int st = b / 1024, sb = b % 1024, swz = sb ^ (((sb >> 9) & 1) << 5); R = (st >> 1) * 16 + swz / 64; C = (st & 1) * 32 + (swz % 64) / 2; }
__host__ __device__ __forceinline__ int perm32(int rho) { const int n = rho >> 4, i = rho & 15; return 8 * (i >> 2) + 4 * n + (i & 3); }

struct Unit { int pm, pn; };
struct Gemm { const bf16_t* A; const bf16_t* Bt; int M, N, K; };

struct StaticOrder {
    int nM, nN, nwg, G, c;
    __host__ __device__ void init(int M, int N, int G_, int c_) { nM = M / BM; nN = N / BM; nwg = nM * nN; G = G_; c = c_; }
    __host__ __device__ bool next(int i, Unit& u) const {
        const long L = (long)i * G + c; if (L >= nwg) return false;
        int wgid = (int)L; { const int q = nwg / NXCD, r = nwg % NXCD, xcd = wgid % NXCD, off = wgid / NXCD; wgid = (xcd < r ? xcd * (q + 1) : r * (q + 1) + (xcd - r) * q) + off; }
        const int nig = WGM * nN, gid = wgid / nig, fm = gid * WGM, gsz = (nM - fm) < WGM ? (nM - fm) : WGM;
        u.pm = fm + ((wgid % nig) % gsz); u.pn = (wgid % nig) / gsz; return true;
    }
    __device__ __forceinline__ void a_ready(const Unit&) const {}
    __device__ __forceinline__ void done(const Unit&) const {}
};

__device__ __forceinline__ unsigned cvt_pk_bf16(float lo, float hi) { unsigned r; asm volatile("v_cvt_pk_bf16_f32 %0, %1, %2" : "=v"(r) : "v"(lo), "v"(hi)); return r; }
__device__ __forceinline__ float silu_f(float x) { return x * __builtin_amdgcn_rcpf(1.0f + __expf(-x)); }
struct EpiIn {
    static constexpr bool PERM = true, AFTER_DRAIN = false;
    bf16_t *PA, *PD, *PZ;
    __device__ __forceinline__ void operator()(const f32x4 (&acc)[2][2][4][2], const Unit& u, int wr, int wc, int fr, int fq) const {
        bf16_t* base; int ldc, colt;
        if (u.pn < 3) { base = PA; ldc = 768; colt = u.pn * 256; }
        else if (u.pn < 9) { base = PD; ldc = 1536; colt = (u.pn - 3) * 256; }
        else { base = PZ; ldc = 512; colt = (u.pn - 9) * 256; }
        const int row0 = u.pm * BM + wr * 64 + fr, col0 = colt + wc * 32 + 8 * fq;
#pragma unroll
        for (int ai = 0; ai < 2; ++ai)
#pragma unroll
            for (int m = 0; m < 4; ++m) { bf16_t* rowp = base + (size_t)(row0 + ai * HALF + m * 16) * ldc + col0;
#pragma unroll
                for (int bj = 0; bj < 2; ++bj) { const f32x4 v0 = acc[ai][bj][m][0], v1 = acc[ai][bj][m][1];
                    u32x4 w; w.x = cvt_pk_bf16(v0[0], v0[1]); w.y = cvt_pk_bf16(v0[2], v0[3]); w.z = cvt_pk_bf16(v1[0], v1[1]); w.w = cvt_pk_bf16(v1[2], v1[3]);
                    *(u32x4*)(rowp + bj * HALF) = w; } }
    }
};
struct EpiOut {
    static constexpr bool PERM = false, AFTER_DRAIN = false;
    const float* x; const float* mod; float* out;
    __device__ __forceinline__ void operator()(const f32x4 (&acc)[2][2][4][2], const Unit& u, int wr, int wc, int fr, int fq) const {
        const int row0 = u.pm * BM + wr * 64 + fr, col0 = u.pn * BM + wc * 32 + 4 * fq;
        const float* g1 = mod + (size_t)(u.pm >> 3) * 6144 + 2048;
        f32x4 gv[2][2];
#pragma unroll
        for (int bj = 0; bj < 2; ++bj)
#pragma unroll
            for (int n = 0; n < 2; ++n) gv[bj][n] = *(const f32x4*)(g1 + col0 + bj * HALF + n * 16);
#pragma unroll
        for (int ai = 0; ai < 2; ++ai)
#pragma unroll
            for (int m = 0; m < 4; ++m) { const size_t off = (size_t)(row0 + ai * HALF + m * 16) * 1024 + col0;
#pragma unroll
                for (int bj = 0; bj < 2; ++bj)
#pragma unroll
                    for (int n = 0; n < 2; ++n) { const f32x4 xv = *(const f32x4*)(x + off + bj * HALF + n * 16);
                        *(f32x4*)(out + off + bj * HALF + n * 16) = xv + gv[bj][n] * acc[ai][bj][m][n]; } }
    }
};
struct EpiGLU {
    static constexpr bool PERM = true, AFTER_DRAIN = false;
    bf16_t* HID;
    __device__ __forceinline__ void operator()(const f32x4 (&acc)[2][2][4][2], const Unit& u, int wr, int wc, int fr, int fq) const {
        const int row0 = u.pm * BM + wr * 64 + fr, col0 = (u.pn & 7) * 128 + wc * 32 + 8 * fq;
#pragma unroll
        for (int ai = 0; ai < 2; ++ai)
#pragma unroll
            for (int m = 0; m < 4; ++m) { bf16_t* rowp = HID + (size_t)(row0 + ai * HALF + m * 16) * 1024 + col0;
                float hv[8];
#pragma unroll
                for (int n = 0; n < 2; ++n)
#pragma unroll
                    for (int j = 0; j < 4; ++j) hv[n * 4 + j] = silu_f(acc[ai][0][m][n][j]) * acc[ai][1][m][n][j];
                u32x4 w; w.x = cvt_pk_bf16(hv[0], hv[1]); w.y = cvt_pk_bf16(hv[2], hv[3]); w.z = cvt_pk_bf16(hv[4], hv[5]); w.w = cvt_pk_bf16(hv[6], hv[7]);
                *(u32x4*)rowp = w; }
    }
};
struct EpiDown {
    static constexpr bool PERM = true, AFTER_DRAIN = false;
    bf16_t* Yb; const float* gatev;
    __device__ __forceinline__ void operator()(const f32x4 (&acc)[2][2][4][2], const Unit& u, int wr, int wc, int fr, int fq) const {
        const int e = u.pm >> 3, b = u.pm & 7;
        const int r0 = wr * 64 + fr, col0 = (u.pn & 3) * 256 + wc * 32 + 8 * fq;
        const float* gp = gatev + (size_t)(b * 16 + e) * 256;
#pragma unroll
        for (int ai = 0; ai < 2; ++ai)
#pragma unroll
            for (int m = 0; m < 4; ++m) { const int s = r0 + ai * HALF + m * 16; const float gt = gp[s];
                bf16_t* rowp = Yb + ((size_t)u.pm * BM + s) * 1024 + col0;
#pragma unroll
                for (int bj = 0; bj < 2; ++bj) { const f32x4 v0 = acc[ai][bj][m][0] * gt, v1 = acc[ai][bj][m][1] * gt;
                    u32x4 w; w.x = cvt_pk_bf16(v0[0], v0[1]); w.y = cvt_pk_bf16(v0[2], v0[3]); w.z = cvt_pk_bf16(v1[0], v1[1]); w.w = cvt_pk_bf16(v1[2], v1[3]);
                    *(u32x4*)(rowp + bj * HALF) = w; } }
    }
};
struct SchedIn {
    int G, c;
    __device__ __forceinline__ bool next(int i, Unit& u) const {
        const int L = i * G + c; if (L >= 760) return false;
        if (L < 704) { StaticOrder S; S.init(16384, 2816, G, c); Unit t; S.next(i, t); u.pm = (t.pm >> 3) * 9 + 1 + (t.pm & 7); u.pn = t.pn; }
        else { const int j = L - 704; u.pm = (j / 7) * 9; u.pn = 2 + (j % 7); }
        return true;
    }
    __device__ __forceinline__ void a_ready(const Unit&) const {}
    __device__ __forceinline__ void done(const Unit&) const {}
};
template <int NPN> struct SchedExp {
    int G, c;
    __device__ __forceinline__ bool next(int i, Unit& u) const {
        const int per = G >> 3, x = c & 7, loc = c >> 3;
        const int uidx = i * per + loc; if (uidx >= 2 * 8 * NPN) return false;
        const int e = x + 8 * (uidx / (8 * NPN)), w = uidx % (8 * NPN);
        u.pm = e * 8 + (w & 7); u.pn = e * NPN + (w >> 3); return true;
    }
    __device__ __forceinline__ void a_ready(const Unit&) const {}
    __device__ __forceinline__ void done(const Unit&) const {}
};
template <class Epi, class Sched, bool ALIGN_EPI = false, bool SP2 = false>
__device__ __forceinline__ void gemm_phase(PG8_LAS unsigned char* lds, const Gemm g, const Sched& S, const Epi& E) {
    const int tid = threadIdx.x, wid = __builtin_amdgcn_readfirstlane(tid >> 6), lane = tid & 63, wr = wid >> 2, wc = wid & 3, fr = lane & 15, fq = lane >> 4;
    const int K = g.K, nt = K / BK;
    unsigned voffA[2], voffB[2];
#pragma unroll
    for (int i = 0; i < 2; ++i) { int R, C; stage_rc(tid * 16 + i * 8192, R, C); const int Rb = Epi::PERM ? ((R & ~31) + perm32(R & 31)) : R;
        voffA[i] = (unsigned)(R * K + C) * 2u; voffB[i] = (unsigned)(Rb * K + C) * 2u; }
    const size_t kstep = (size_t)(BK * 2);
    const size_t hstep = (size_t)HALF * K * 2;
    const size_t tstep = 2 * hstep;
    const unsigned ldsw = (unsigned)wid * 1024u;
    const int aoff = lds_byte(wr * 64 + fr, fq * 8), boff = lds_byte(wc * 32 + fr, fq * 8);
#define PG8_SA(b, h) (((b) * 2 + (h)) * HTB)
#define PG8_SB(b, h) ((4 + (b) * 2 + (h)) * HTB)
#define PG8_STAGE(bufoff, gbase, voff) do { _Pragma("unroll") for (int _i = 0; _i < 2; ++_i) \
        __builtin_amdgcn_global_load_lds((const unsigned*)((const char*)(gbase) + (voff)[_i]), (PG8_LAS unsigned*)(lds + (bufoff) + ldsw + _i * 8192), 16, 0, 0); } while (0)
#define PG8_LDA(dst, b, h) do { _Pragma("unroll") for (int m = 0; m < 4; ++m) _Pragma("unroll") for (int k = 0; k < 2; ++k) dst[m][k] = *(const PG8_LAS bf16x8*)(lds + PG8_SA(b, h) + aoff + m * 2048 + k * 1024); } while (0)
#define PG8_LDB(dst, b, h) do { _Pragma("unroll") for (int n = 0; n < 2; ++n) _Pragma("unroll") for (int k = 0; k < 2; ++k) dst[n][k] = *(const PG8_LAS bf16x8*)(lds + PG8_SB(b, h) + boff + n * 2048 + k * 1024); } while (0)
#define PG8_MMA(ai, bj, At, Bt) do { __builtin_amdgcn_s_setprio(1); _Pragma("unroll") for (int m = 0; m < 4; ++m) _Pragma("unroll") for (int n = 0; n < 2; ++n) _Pragma("unroll") for (int k = 0; k < 2; ++k) \
        acc[ai][bj][m][n] = __builtin_amdgcn_mfma_f32_16x16x32_bf16(Bt[n][k], At[m][k], acc[ai][bj][m][n], 0, 0, 0); __builtin_amdgcn_s_setprio(0); } while (0)
#define PG8_WAIT_V(n) asm volatile("s_waitcnt vmcnt(" #n ")" ::: "memory")
#define PG8_WAIT_L(n) asm volatile("s_waitcnt lgkmcnt(" #n ")" ::: "memory")
#define PG8_BAR __builtin_amdgcn_s_barrier()
#define PG8_SCHED __builtin_amdgcn_sched_barrier(0)
    Unit cur, nxt; int ui = 0;
    if (!S.next(0, cur)) return;
    f32x4 acc[2][2][4][2];
#pragma unroll
    for (int a = 0; a < 2; ++a)
#pragma unroll
        for (int b = 0; b < 2; ++b)
#pragma unroll
            for (int m = 0; m < 4; ++m)
#pragma unroll
                for (int n = 0; n < 2; ++n) acc[a][b][m][n] = (f32x4){0.f, 0.f, 0.f, 0.f};
    bf16x8 At[4][2], B0[2][2], B1[2][2];
    const char* cA = (const char*)g.A + (size_t)cur.pm * tstep; const char* cB = (const char*)g.Bt + (size_t)cur.pn * tstep;
    S.a_ready(cur);
    if constexpr (SP2) {
        PG8_STAGE(PG8_SB(0, 0), cB, voffB); PG8_STAGE(PG8_SB(0, 1), cB + hstep, voffB); PG8_STAGE(PG8_SA(0, 0), cA, voffA); PG8_STAGE(PG8_SA(0, 1), cA + hstep, voffA);
        if (wr == 1) PG8_BAR;
        PG8_WAIT_V(2); PG8_BAR;
        PG8_STAGE(PG8_SB(1, 0), cB + kstep, voffB); PG8_STAGE(PG8_SA(1, 0), cA + kstep, voffA); PG8_STAGE(PG8_SB(1, 1), cB + hstep + kstep, voffB);
        PG8_WAIT_V(6); PG8_BAR;
    } else {
        PG8_STAGE(PG8_SB(0, 0), cB, voffB); PG8_STAGE(PG8_SA(0, 0), cA, voffA); PG8_STAGE(PG8_SB(0, 1), cB + hstep, voffB); PG8_STAGE(PG8_SA(0, 1), cA + hstep, voffA);
        if (wr == 1) PG8_BAR;
        PG8_WAIT_V(4); PG8_BAR;
        PG8_STAGE(PG8_SB(1, 0), cB + kstep, voffB); PG8_STAGE(PG8_SA(1, 0), cA + kstep, voffA); PG8_STAGE(PG8_SB(1, 1), cB + hstep + kstep, voffB);
        PG8_WAIT_V(6); PG8_BAR;
    }
    for (;;) {
        const bool has_next = S.next(ui + 1, nxt);
        const char* nA = has_next ? (const char*)g.A + (size_t)nxt.pm * tstep : cA; const char* nB = has_next ? (const char*)g.Bt + (size_t)nxt.pn * tstep : cB;
        for (int t = 0; t < nt; t += 2) {
            const bool last = (t == nt - 2);
            const char* a1 = cA + (size_t)(t + 1) * kstep;
            const char* a2 = last ? nA : cA + (size_t)(t + 2) * kstep; const char* b2 = last ? nB : cB + (size_t)(t + 2) * kstep;
            const char* a3 = a2 + kstep; const char* b3 = b2 + kstep;
            if (last && has_next) S.a_ready(nxt);
            if constexpr (SP2) {
            PG8_LDB(B0, 0, 0); PG8_LDB(B1, 0, 1); PG8_SCHED; PG8_LDA(At, 0, 0); PG8_STAGE(PG8_SA(1, 1), a1 + hstep, voffA);
            PG8_WAIT_V(8); PG8_WAIT_L(0); PG8_BAR; PG8_MMA(0, 0, At, B0); PG8_MMA(0, 1, At, B1); PG8_BAR; PG8_SCHED;
            PG8_LDA(At, 0, 1); PG8_STAGE(PG8_SB(0, 0), b2, voffB); PG8_STAGE(PG8_SB(0, 1), b2 + hstep, voffB); PG8_STAGE(PG8_SA(0, 0), a2, voffA);
            PG8_WAIT_V(8); PG8_WAIT_L(0); PG8_BAR; PG8_MMA(1, 0, At, B0); PG8_MMA(1, 1, At, B1); PG8_BAR; PG8_SCHED;
            PG8_LDB(B0, 1, 0); PG8_LDB(B1, 1, 1); PG8_SCHED; PG8_LDA(At, 1, 0); PG8_STAGE(PG8_SA(0, 1), a2 + hstep, voffA);
            PG8_WAIT_V(8); PG8_WAIT_L(0); PG8_BAR; PG8_MMA(0, 0, At, B0); PG8_MMA(0, 1, At, B1); PG8_BAR; PG8_SCHED;
            PG8_LDA(At, 1, 1); PG8_STAGE(PG8_SB(1, 0), b3, voffB); PG8_STAGE(PG8_SB(1, 1), b3 + hstep, voffB); PG8_STAGE(PG8_SA(1, 0), a3, voffA);
            PG8_WAIT_V(8); PG8_WAIT_L(0); PG8_BAR; PG8_MMA(1, 0, At, B0); PG8_MMA(1, 1, At, B1); PG8_BAR; PG8_SCHED;
            } else {
            PG8_LDB(B0, 0, 0); PG8_SCHED; PG8_LDA(At, 0, 0); PG8_STAGE(PG8_SA(1, 1), a1 + hstep, voffA);
            PG8_WAIT_L(8); PG8_BAR; PG8_WAIT_L(0); PG8_MMA(0, 0, At, B0); PG8_BAR; PG8_SCHED;
            PG8_LDB(B1, 0, 1); PG8_STAGE(PG8_SB(0, 0), b2, voffB);
            PG8_BAR; PG8_WAIT_L(0); PG8_MMA(0, 1, At, B1); PG8_BAR;
            PG8_LDA(At, 0, 1); PG8_STAGE(PG8_SA(0, 0), a2, voffA);
            PG8_BAR; PG8_WAIT_L(0); PG8_MMA(1, 0, At, B0); PG8_BAR; PG8_SCHED;
            PG8_STAGE(PG8_SB(0, 1), b2 + hstep, voffB);
            PG8_WAIT_V(6); PG8_BAR; PG8_MMA(1, 1, At, B1); PG8_BAR;
            PG8_LDB(B0, 1, 0); PG8_SCHED; PG8_LDA(At, 1, 0); PG8_STAGE(PG8_SA(0, 1), a2 + hstep, voffA);
            PG8_WAIT_L(8); PG8_BAR; PG8_WAIT_L(0); PG8_MMA(0, 0, At, B0); PG8_BAR; PG8_SCHED;
            PG8_LDB(B1, 1, 1); PG8_STAGE(PG8_SB(1, 0), b3, voffB);
            PG8_BAR; PG8_WAIT_L(0); PG8_MMA(0, 1, At, B1); PG8_BAR;
            PG8_LDA(At, 1, 1); PG8_STAGE(PG8_SA(1, 0), a3, voffA);
            PG8_BAR; PG8_WAIT_L(0); PG8_MMA(1, 0, At, B0); PG8_BAR; PG8_SCHED;
            PG8_STAGE(PG8_SB(1, 1), b3 + hstep, voffB);
            PG8_WAIT_V(6); PG8_BAR; PG8_MMA(1, 1, At, B1); PG8_BAR;
            }
        }
        if constexpr (ALIGN_EPI) { if (wr == 0) PG8_BAR; }
        if constexpr (!Epi::AFTER_DRAIN) { E(acc, cur, wr, wc, fr, fq); S.done(cur); }
        if (!has_next) break;
#pragma unroll
        for (int a = 0; a < 2; ++a)
#pragma unroll
            for (int b = 0; b < 2; ++b)
#pragma unroll
                for (int m = 0; m < 4; ++m)
#pragma unroll
                    for (int n = 0; n < 2; ++n) acc[a][b][m][n] = (f32x4){0.f, 0.f, 0.f, 0.f};
        cur = nxt; cA = nA; cB = nB; ++ui;
        if constexpr (ALIGN_EPI) { if (wr == 1) PG8_BAR; }
    }
    PG8_WAIT_V(0);
    if constexpr (!ALIGN_EPI) { if (wr == 0) PG8_BAR; }
    PG8_BAR;
    if constexpr (Epi::AFTER_DRAIN) { E.fused(acc, cur, wr, wc, fr, fq, lds, wid, lane); S.done(cur); }
#undef PG8_SA
#undef PG8_SB
#undef PG8_STAGE
#undef PG8_LDA
#undef PG8_LDB
#undef PG8_MMA
#undef PG8_WAIT_V
#undef PG8_WAIT_L
#undef PG8_BAR
#undef PG8_SCHED
}
}
#include <hip/hip_bf16.h>
#include <cmath>
namespace attn_body {
using bf16=__hip_bfloat16;
using bf16x8=__attribute__((ext_vector_type(8)))short;
using s16x4=__attribute__((ext_vector_type(4)))short;
using f32x16=__attribute__((ext_vector_type(16)))float;
using u32x4=__attribute__((ext_vector_type(4)))unsigned;
constexpr int D=64, QP=768, KVP=768, OP=1024, NTILES=36;
constexpr int NW=8,QBLK=32,QB=QBLK*NW,KVBLK=64;
constexpr int ATTN_UNIT_ROWS=QB;
__device__ __forceinline__ int crow(int r,int hi){return (r&3)+8*(r>>2)+4*hi;}
#define SBAR() __builtin_amdgcn_sched_barrier(0)

constexpr int NSLOT=3, SLOTB=8192;
constexpr int LDS_K=0, LDS_V=NSLOT*SLOTB, LDS_WS=2*NSLOT*SLOTB, LDS_OST=LDS_WS+NW*64*4, LDS_BYTES=LDS_OST+NW*4096;
constexpr float C2=0.125f*1.4426950408889634f;
__device__ __forceinline__ void glds16(const void*gsrc,unsigned lds_dst){unsigned keep;
  asm volatile("s_mov_b32 %0, m0\n\ts_mov_b32 m0, %2\n\ts_nop 0\n\tglobal_load_lds_dwordx4 %1, off\n\ts_mov_b32 m0, %0":"=&s"(keep):"v"(gsrc),"s"(lds_dst):"memory");}
__device__ __forceinline__ float max3f(float a,float b,float c){float r;asm("v_max3_f32 %0, %1, %2, %3":"=v"(r):"v"(a),"v"(b),"v"(c));return r;}
__device__ __forceinline__ float max2f(float a,float b){float r;asm("v_max_f32_e32 %0, %1, %2":"=v"(r):"v"(a),"v"(b));return r;}
__device__ __forceinline__ float fadd_s(float a,float b){float r;asm("v_add_f32_e32 %0, %1, %2":"=v"(r):"v"(a),"v"(b));return r;}
__device__ __forceinline__ float fsub_s(float a,float b){float r;asm("v_sub_f32_e32 %0, %1, %2":"=v"(r):"v"(a),"v"(b));return r;}
typedef float f32x2_t __attribute__((ext_vector_type(2))); typedef __bf16 bf16x2_t __attribute__((ext_vector_type(2)));
__device__ __forceinline__ unsigned cvtpk_s(float lo,float hi){f32x2_t v={lo,hi};bf16x2_t b=__builtin_convertvector(v,bf16x2_t);return __builtin_bit_cast(unsigned,b);}
#define WAIT_BAR(N) asm volatile("s_waitcnt vmcnt(" #N ") lgkmcnt(0)\n\ts_barrier":::"memory")

__device__ __forceinline__ void qkt(f32x16&p0,f32x16&p1,const char*Kslot,const bf16x8*qr,const f32x16&negm,int r32,int hi){
  const char*kb=Kslot+hi*1024+r32*16;
  #pragma unroll
  for(int d0=0;d0<4;++d0){
    const bf16x8 b0=*reinterpret_cast<const bf16x8*>(kb+d0*2048);
    const bf16x8 b1=*reinterpret_cast<const bf16x8*>(kb+d0*2048+512);
    if(d0==0){p0=__builtin_amdgcn_mfma_f32_32x32x16_bf16(b0,qr[0],negm,0,0,0);p1=__builtin_amdgcn_mfma_f32_32x32x16_bf16(b1,qr[0],negm,0,0,0);}
    else{p0=__builtin_amdgcn_mfma_f32_32x32x16_bf16(b0,qr[d0],p0,0,0,0);p1=__builtin_amdgcn_mfma_f32_32x32x16_bf16(b1,qr[d0],p1,0,0,0);}}
}
typedef __attribute__((address_space(3))) const char* lds_cptr;
typedef short v4i16_t __attribute__((ext_vector_type(4)));
__device__ __forceinline__ void kload8(bf16x8*kf,lds_cptr kp){
  kf[0]=*(const __attribute__((address_space(3))) bf16x8*)(kp);      kf[1]=*(const __attribute__((address_space(3))) bf16x8*)(kp+512);
  kf[2]=*(const __attribute__((address_space(3))) bf16x8*)(kp+2048); kf[3]=*(const __attribute__((address_space(3))) bf16x8*)(kp+2560);
  kf[4]=*(const __attribute__((address_space(3))) bf16x8*)(kp+4096); kf[5]=*(const __attribute__((address_space(3))) bf16x8*)(kp+4608);
  kf[6]=*(const __attribute__((address_space(3))) bf16x8*)(kp+6144); kf[7]=*(const __attribute__((address_space(3))) bf16x8*)(kp+6656);
}
__device__ __forceinline__ void kload2(bf16x8*kf,lds_cptr kp,int j){ kf[2*j]=*(const __attribute__((address_space(3))) bf16x8*)(kp+j*2048); kf[2*j+1]=*(const __attribute__((address_space(3))) bf16x8*)(kp+j*2048+512); }
__device__ __forceinline__ s16x4 vtr(lds_cptr p){ return __builtin_bit_cast(s16x4,__builtin_amdgcn_ds_read_tr16_b64_v4i16((__attribute__((address_space(3))) v4i16_t*)p)); }
__device__ __forceinline__ float rowmax(const f32x16&p0,const f32x16&p1){
  float a=max3f(p0[0],p0[1],p1[0]),b=max3f(p0[2],p0[3],p1[1]);a=max3f(a,p1[2],p1[3]);
  #pragma unroll
  for(int r=4;r<16;r+=4){a=max3f(a,p0[r],p0[r+1]);b=max3f(b,p0[r+2],p0[r+3]);a=max3f(a,p1[r],p1[r+1]);b=max3f(b,p1[r+2],p1[r+3]);}
  const float m=max2f(a,b);
  auto rr=__builtin_amdgcn_permlane32_swap(__float_as_uint(m),__float_as_uint(m),false,false);
  return max2f(__uint_as_float(rr[0]),__uint_as_float(rr[1]));
}
__device__ __forceinline__ void pv(f32x16*o,int vb,bf16x8 pa0,bf16x8 pa1,bf16x8 pa2,bf16x8 pa3){
  #pragma unroll
  for(int d0=0;d0<2;++d0){s16x4 lo[4],hi[4];
    #pragma unroll
    for(int ks=0;ks<4;++ks){
      asm volatile("ds_read_b64_tr_b16 %0,%1 offset:%c2":"=&v"(lo[ks]):"v"(vb),"i"(d0*4096+ks*1024):"memory");
      asm volatile("ds_read_b64_tr_b16 %0,%1 offset:%c2":"=&v"(hi[ks]):"v"(vb),"i"(d0*4096+ks*1024+512):"memory");}
    asm volatile("s_waitcnt lgkmcnt(0)":::"memory");SBAR();
    #define PK(k) (bf16x8){lo[k][0],lo[k][1],lo[k][2],lo[k][3],hi[k][0],hi[k][1],hi[k][2],hi[k][3]}
    o[d0]=__builtin_amdgcn_mfma_f32_32x32x16_bf16(pa0,PK(0),o[d0],0,0,0);
    o[d0]=__builtin_amdgcn_mfma_f32_32x32x16_bf16(pa1,PK(1),o[d0],0,0,0);
    o[d0]=__builtin_amdgcn_mfma_f32_32x32x16_bf16(pa2,PK(2),o[d0],0,0,0);
    o[d0]=__builtin_amdgcn_mfma_f32_32x32x16_bf16(pa3,PK(3),o[d0],0,0,0);
    #undef PK
  }
}

#ifndef ATTN_STORE16
#define ATTN_STORE16(p,v) (*(u32x4*)(p)=(v))
#endif
template<int THRL> __device__ __forceinline__ void attn_unit(const bf16*Qw0,const bf16*__restrict__ Kh,const bf16*__restrict__ Vh,bf16*Ow0,char*shm){
  const int tid=threadIdx.x,lane=tid&63,r32=lane&31,hi=lane>>5; const int wid=__builtin_amdgcn_readfirstlane(tid>>6);
  const bf16*Qw=Qw0+(long)wid*QBLK*QP;


  const unsigned lds0=(unsigned)(uintptr_t)shm;
  float*wsf=(float*)(shm+LDS_WS)+wid*64;
  const bf16*ksrc=Kh+(long)lane*KVP+wid*8;
  const bf16*vsrc=Vh+(long)(16*(wid&3)+(lane>>2))*KVP+(wid>>2)*32+(lane&3)*8;
  const unsigned kdst=lds0+LDS_K+wid*1024, vdst=lds0+LDS_V+wid*1024;
  #define DMA_K(t,slot) glds16(ksrc+(long)(t)*KVBLK*KVP,(unsigned)__builtin_amdgcn_readfirstlane(kdst+(slot)))
  #define DMA_V(t,slot) glds16(vsrc+(long)(t)*KVBLK*KVP,(unsigned)__builtin_amdgcn_readfirstlane(vdst+(slot)))
  const int vb0=(int)(lds0+LDS_V)+((lane>>4)&1)*32+(lane&3)*8+(4*hi+((lane&15)>>2))*64;
  const char*Kbase=shm+LDS_K; bf16x8 kf[8];
  const lds_cptr shm3=(lds_cptr)shm; const lds_cptr kp0=shm3+LDS_K+hi*1024+r32*16; const lds_cptr vp0=shm3+LDS_V+((lane>>4)&1)*32+(lane&3)*8+(4*hi+((lane&15)>>2))*64;
  constexpr int NT=NTILES;
  DMA_K(0,0);DMA_V(0,0);DMA_K(1,SLOTB);
  bf16x8 qr[4];
  #pragma unroll
  for(int d0=0;d0<4;++d0)qr[d0]=*reinterpret_cast<const bf16x8*>(&Qw[(long)r32*QP+d0*16+hi*8]);
  float mhat=0.f,l_reg=0.f;f32x16 o[2];o[0]=f32x16{};o[1]=f32x16{};f32x16 negm=f32x16{};asm volatile("":"+v"(negm));

  #define CMASK(P0,P1,t) do{}while(0)
  bool resc=false;
  #define START(P0,P1) do{ const float rm=rowmax(P0,P1); resc=false; \
    { const float dl=rm; mhat=fadd_s(mhat,dl); \
      _Pragma("unroll") for(int r=0;r<16;++r){P0[r]=fsub_s(P0[r],dl);P1[r]=fsub_s(P1[r],dl);} \
      _Pragma("unroll") for(int r=0;r<16;++r)negm[r]=-mhat; asm volatile("":"+v"(negm)); } \
    _Pragma("unroll") for(int r=0;r<16;++r)P0[r]=__builtin_amdgcn_exp2f(P0[r]); }while(0)
  #define RESC() do{ if(resc){ asm volatile("s_waitcnt lgkmcnt(0)":::"memory"); \
      _Pragma("unroll") for(int d_=0;d_<2;++d_) _Pragma("unroll") for(int r=0;r<16;++r)o[d_][r]*=wsf[crow(r,hi)]; } }while(0)
  f32x16 pA0,pA1,pB0,pB1;
  int sl_prev=0,sl_cur=0,sl_next=SLOTB;
  #define ROT() do{sl_prev=sl_cur;sl_cur=sl_next;sl_next=(sl_next==(NSLOT-1)*SLOTB)?0:sl_next+SLOTB;}while(0)
  DMA_K(2,2*SLOTB);
  WAIT_BAR(3);
  qkt(pA0,pA1,Kbase,qr,negm,r32,hi);asm volatile("s_nop 15\n\ts_nop 7":"+v"(pA0),"+v"(pA1));CMASK(pA0,pA1,0);
  START(pA0,pA1);
  _Pragma("unroll") for(int r=0;r<16;++r)pA1[r]=__builtin_amdgcn_exp2f(pA1[r]);
  WAIT_BAR(0);
  DMA_K(3,0);DMA_V(1,SLOTB);
  ROT();
  kload8(kf,kp0+sl_cur);
  WAIT_BAR(2);
  s16x4 vlo[8],vhi[8]; u32x4 pw0,pw1,pw2,pw3;
  #define PKW(P,B) cvtpk_s(P[B],P[B+1])
  #define PAF(k) __builtin_bit_cast(bf16x8,pw##k)
  #define VFR(i) (bf16x8){vlo[i][0],vlo[i][1],vlo[i][2],vlo[i][3],vhi[i][0],vhi[i][1],vhi[i][2],vhi[i][3]}
  #define PIN(x) asm volatile("":"+v"(x))
  #define MX3(a,b,c) __builtin_fmaxf(__builtin_fmaxf((a),(b)),(c))
  #define GAPA(MF,A0,A1,A2,A3,W0,W1,PW) do{ MF; sacc+=A0; sacc+=A1; sacc+=A2; sacc+=A3; PIN(sacc); W0; W1; PIN(PW); SBAR(); }while(0)
  #define EX(v) __builtin_amdgcn_exp2f(v)
  #define GAPB(MF,X,B) do{ MF; X[B]=EX(X[B]); X[B+1]=EX(X[B+1]); X[B+2]=EX(X[B+2]); X[B+3]=EX(X[B+3]); PIN(X); SBAR(); }while(0)
  #define VRD(i) do{ vlo[i]=vtr(vp_+(((i)>>2)*4096+((i)&3)*1024)); vhi[i]=vtr(vp_+(((i)>>2)*4096+((i)&3)*1024+512)); }while(0)
  #define KRD(G,j) do{ if(G){ kload2(kf,kp0+sl_next,j); SBAR(); } }while(0)
  #define STEP(C0,C1,P0,P1,t,GK,GV,GL) do{ SBAR(); \
    const lds_cptr vp_=vp0+sl_prev; \
    VRD(0); SBAR(); float sacc=(P0[0]+P0[1]); \
    GAPA(C0=__builtin_amdgcn_mfma_f32_32x32x16_bf16(kf[0],qr[0],negm,0,0,0), P0[2],P0[3],P0[4],P0[5],     pw0[0]=PKW(P0,0), pw0[1]=PKW(P0,2), pw0); \
    VRD(4); SBAR(); GAPA(C1=__builtin_amdgcn_mfma_f32_32x32x16_bf16(kf[1],qr[0],negm,0,0,0), P0[6],P0[7],P0[8],P0[9],     pw0[2]=PKW(P0,4), pw0[3]=PKW(P0,6), pw0); \
    VRD(1); SBAR(); GAPA(C0=__builtin_amdgcn_mfma_f32_32x32x16_bf16(kf[2],qr[1],C0,0,0,0),   P0[10],P0[11],P0[12],P0[13], pw1[0]=PKW(P0,8), pw1[1]=PKW(P0,10), pw1); \
    VRD(5); SBAR(); GAPA(C1=__builtin_amdgcn_mfma_f32_32x32x16_bf16(kf[3],qr[1],C1,0,0,0),   P0[14],P0[15],P1[0],P1[1],   pw1[2]=PKW(P0,12),pw1[3]=PKW(P0,14), pw1); \
    VRD(2); SBAR(); GAPA(C0=__builtin_amdgcn_mfma_f32_32x32x16_bf16(kf[4],qr[2],C0,0,0,0),   P1[2],P1[3],P1[4],P1[5],     pw2[0]=PKW(P1,0), pw2[1]=PKW(P1,2), pw2); \
    VRD(6); SBAR(); GAPA(C1=__builtin_amdgcn_mfma_f32_32x32x16_bf16(kf[5],qr[2],C1,0,0,0),   P1[6],P1[7],P1[8],P1[9],     pw2[2]=PKW(P1,4), pw2[3]=PKW(P1,6), pw2); \
    VRD(3); SBAR(); GAPA(C0=__builtin_amdgcn_mfma_f32_32x32x16_bf16(kf[6],qr[3],C0,0,0,0),   P1[10],P1[11],P1[12],P1[13], pw3[0]=PKW(P1,8), pw3[1]=PKW(P1,10), pw3); \
    VRD(7); SBAR(); GAPA(C1=__builtin_amdgcn_mfma_f32_32x32x16_bf16(kf[7],qr[3],C1,0,0,0),   P1[14],P1[15],0.f,0.f,       pw3[2]=PKW(P1,12),pw3[3]=PKW(P1,14), pw3); \
    l_reg+=sacc; \
    if(GK){DMA_K((t)+3,sl_cur);} if(GV){DMA_V((t)+1,sl_next);} \
    CMASK(C0,C1,t); \
    { float a=MX3(C0[0],C0[1],C1[0]),b=MX3(C0[2],C0[3],C1[1]); a=MX3(a,C1[2],C1[3]); \
      _Pragma("unroll") for(int r=4;r<16;r+=4){a=MX3(a,C0[r],C0[r+1]);b=MX3(b,C0[r+2],C0[r+3]);a=MX3(a,C1[r],C1[r+1]);b=MX3(b,C1[r+2],C1[r+3]);} \
      float rm=__builtin_fmaxf(a,b); { auto rr=__builtin_amdgcn_permlane32_swap(__float_as_uint(rm),__float_as_uint(rm),false,false); rm=__builtin_fmaxf(__uint_as_float(rr[0]),__uint_as_float(rr[1])); } \
      resc=false; \
      if(__builtin_expect(__any(rm>(float)THRL),0)){ const float dl=__builtin_fmaxf(rm,0.f); mhat+=dl; \
        _Pragma("unroll") for(int r=0;r<16;++r){C0[r]-=dl;C1[r]-=dl;} \
        _Pragma("unroll") for(int r=0;r<16;++r)negm[r]=-mhat; asm volatile("":"+v"(negm)); \
        const float f=__builtin_amdgcn_exp2f(-dl); l_reg*=f; if(hi==0)wsf[r32]=f; resc=true; } } \
    SBAR(); \
    GAPB(o[0]=__builtin_amdgcn_mfma_f32_32x32x16_bf16(PAF(0),VFR(0),o[0],0,0,0), C0,0); \
    GAPB(o[1]=__builtin_amdgcn_mfma_f32_32x32x16_bf16(PAF(0),VFR(4),o[1],0,0,0), C0,4); \
    KRD(GL,0); GAPB(o[0]=__builtin_amdgcn_mfma_f32_32x32x16_bf16(PAF(1),VFR(1),o[0],0,0,0), C0,8); \
    KRD(GL,1); GAPB(o[1]=__builtin_amdgcn_mfma_f32_32x32x16_bf16(PAF(1),VFR(5),o[1],0,0,0), C0,12); \
    KRD(GL,2); GAPB(o[0]=__builtin_amdgcn_mfma_f32_32x32x16_bf16(PAF(2),VFR(2),o[0],0,0,0), C1,0); \
    KRD(GL,3); GAPB(o[1]=__builtin_amdgcn_mfma_f32_32x32x16_bf16(PAF(2),VFR(6),o[1],0,0,0), C1,4); \
    GAPB(o[0]=__builtin_amdgcn_mfma_f32_32x32x16_bf16(PAF(3),VFR(3),o[0],0,0,0), C1,8); \
    GAPB(o[1]=__builtin_amdgcn_mfma_f32_32x32x16_bf16(PAF(3),VFR(7),o[1],0,0,0), C1,12); \
    }while(0)
  int t=1;
  #undef CMASK
  #define CMASK(P0,P1,t) do{}while(0)
  for(;t+5<NT;t+=2){
    STEP(pB0,pB1,pA0,pA1,t,true,true,true);     WAIT_BAR(2); RESC(); ROT();
    STEP(pA0,pA1,pB0,pB1,t+1,true,true,true);   WAIT_BAR(2); RESC(); ROT();
  }
  #undef CMASK
  #define CMASK(P0,P1,t) do{}while(0)
  #define ENDW(tt) do{ if((tt)+3<NT){WAIT_BAR(2);} else if((tt)+2<NT){WAIT_BAR(1);} else {WAIT_BAR(0);} }while(0)
  for(;t+1<NT;t+=2){
    STEP(pB0,pB1,pA0,pA1,t,(t+3<NT),(t+1<NT),(t+1<NT));       ENDW(t);   RESC(); ROT();
    STEP(pA0,pA1,pB0,pB1,t+1,(t+4<NT),(t+2<NT),(t+2<NT));     ENDW(t+1); RESC(); ROT();
  }
  STEP(pB0,pB1,pA0,pA1,NT-1,false,false,false); RESC();
  { float sacc=pB0[0]+pB0[1]; _Pragma("unroll") for(int r=2;r<16;++r)sacc+=pB0[r]; _Pragma("unroll") for(int r=0;r<16;++r)sacc+=pB1[r]; l_reg+=sacc;
    pw0=(u32x4){PKW(pB0,0),PKW(pB0,2),PKW(pB0,4),PKW(pB0,6)};pw1=(u32x4){PKW(pB0,8),PKW(pB0,10),PKW(pB0,12),PKW(pB0,14)};pw2=(u32x4){PKW(pB1,0),PKW(pB1,2),PKW(pB1,4),PKW(pB1,6)};pw3=(u32x4){PKW(pB1,8),PKW(pB1,10),PKW(pB1,12),PKW(pB1,14)};
    SBAR(); pv(o,vb0+sl_cur,PAF(0),PAF(1),PAF(2),PAF(3)); }
  #undef PKW
  #undef PAF
  #undef VFR
  #undef PIN
  #undef MX3
  #undef GAPA
  #undef GAPB
  #undef EX
  #undef VRD
  #undef KRD
  #undef STEP
  #undef ENDW
  {auto rr=__builtin_amdgcn_permlane32_swap(__float_as_uint(l_reg),__float_as_uint(l_reg),false,false);l_reg=__uint_as_float(rr[0])+__uint_as_float(rr[1]);}
  if(hi==0)wsf[32+r32]=l_reg;asm volatile("s_waitcnt lgkmcnt(0)":::"memory");
  float rli[16];
  #pragma unroll
  for(int r=0;r<16;++r)rli[r]=__builtin_amdgcn_rcpf(wsf[32+crow(r,hi)]);
  bf16*Ow=Ow0+(long)wid*QBLK*OP;
  { bf16*stg=(bf16*)(shm+LDS_OST)+wid*2048;
    #pragma unroll
    for(int r=0;r<16;++r){const int orow=crow(r,hi);
      #pragma unroll
      for(int d0=0;d0<2;++d0)stg[orow*64+d0*32+r32]=__float2bfloat16(o[d0][r]*rli[r]);}
    asm volatile("s_waitcnt lgkmcnt(0)":::"memory");
    #pragma unroll
    for(int i=0;i<4;++i){const int row=i*8+(lane>>3),ch=lane&7; const u32x4 v=*(const u32x4*)(stg+row*64+ch*8); ATTN_STORE16(Ow+(long)row*OP+ch*8,v);} }
  asm volatile("s_waitcnt lgkmcnt(0)\n\ts_barrier":::"memory");
  #undef DMA_K
  #undef DMA_V
  #undef CMASK
  #undef START
  #undef RESC
  #undef ROT
}
constexpr int ATTN_LDS_BYTES=LDS_BYTES;
#undef SBAR
#undef WAIT_BAR
}
#define GAS __attribute__((address_space(1)))
#define LAS __attribute__((address_space(3)))
typedef unsigned short bf16;
typedef unsigned v4u __attribute__((ext_vector_type(4)));
typedef float f32x4 __attribute__((ext_vector_type(4)));
typedef short bf16x8 __attribute__((ext_vector_type(8)));
typedef GAS unsigned gu32;
typedef GAS unsigned long long gu64;
#define RLX_AGENT __ATOMIC_RELAXED, __HIP_MEMORY_SCOPE_AGENT
#define LDS_WAIT() asm volatile("s_waitcnt lgkmcnt(0)" ::: "memory")
#define VM_WAIT() asm volatile("s_waitcnt vmcnt(0)" ::: "memory")
__device__ __forceinline__ unsigned long long rt() { return __builtin_amdgcn_s_memrealtime(); }
__device__ __forceinline__ unsigned f2bf(float f) { unsigned u = __builtin_bit_cast(unsigned, f); return (u + 0x7fffu + ((u >> 16) & 1u)) >> 16; }
__device__ __forceinline__ unsigned pk2(float lo, float hi) { return f2bf(lo) | (f2bf(hi) << 16); }

#define XB_TMO      128
#define XB_XCNT(j)  (256  + 64 * (j))
#define XB_XSUB(j)  (1280 + 64 * (j))
#define XB_XGEN(j)  (2304 + 64 * (j))
#define XB_TOP      3328
#define XB_TOPGEN   3392
#define XCD_BAR_WORDS 3456
#define XB_SPIN_CAP (1u << 18)

__device__ __forceinline__ unsigned xb_ld(unsigned* p)              { return __hip_atomic_load(p, __ATOMIC_RELAXED, __HIP_MEMORY_SCOPE_AGENT); }
__device__ __forceinline__ unsigned xb_add(unsigned* p, unsigned v) { return __hip_atomic_fetch_add(p, v, __ATOMIC_RELAXED, __HIP_MEMORY_SCOPE_AGENT); }
__device__ __forceinline__ unsigned xb_xcc_id() { return (unsigned)__builtin_amdgcn_s_getreg((3 << 11) | 20) & 0xFu; }
#define XB_SPIN(cond, bar) do { unsigned _sp = 0; while (cond) { __builtin_amdgcn_s_sleep(1); \
    if ((++_sp & 255u) == 0u) { if (xb_ld(&(bar)[XB_TMO])) break; if (_sp > XB_SPIN_CAP) { atomicAdd(&(bar)[XB_TMO], 1u); break; } } } } while (0)

struct XcdBarrier {
    unsigned* bar; unsigned x;
    volatile LAS unsigned* st;
};

__device__ __forceinline__ XcdBarrier xcd_barrier_post(unsigned* bar, volatile LAS unsigned* st) {
    XcdBarrier b; b.bar = bar; b.x = xb_xcc_id(); b.st = st;
    if (threadIdx.x == 0) (void)xb_add(&bar[XB_XCNT(b.x)], 1u);
    return b;
}
__device__ __forceinline__ void xcd_barrier_complete(unsigned* bar, unsigned x, unsigned& nloc, unsigned& nx) {
    const unsigned G = gridDim.x * gridDim.y * gridDim.z;
    unsigned sum, cnt, mine, sp = 0u;
    for (;;) {
        sum = 0u; cnt = 0u; mine = 0u;
#pragma unroll
        for (unsigned j = 0; j < 16; ++j) { const unsigned c = xb_ld(&bar[XB_XCNT(j)]); sum += c; cnt += (c > 0u) ? 1u : 0u; mine = (j == x) ? c : mine; }
        if (sum == G) break;
        __builtin_amdgcn_s_sleep(1);
        if ((++sp & 255u) == 0u) { if (xb_ld(&bar[XB_TMO])) break; if (sp > XB_SPIN_CAP) { atomicAdd(&bar[XB_TMO], 1u); break; } }
    }
    nloc = mine > 0u ? mine : 1u; nx = cnt > 0u ? cnt : 1u;
}

__device__ __forceinline__ void xcd_barrier(const XcdBarrier& b) {
    asm volatile("s_waitcnt vmcnt(0)" ::: "memory");
    __syncthreads();
    if (threadIdx.x == 0) {
        unsigned* bar = b.bar;
        __builtin_amdgcn_s_waitcnt(0);
        unsigned nloc = b.st[0], nx = b.st[1];
        if (nloc == 0u) { xcd_barrier_complete(bar, b.x, nloc, nx); b.st[0] = nloc; b.st[1] = nx; }
        const unsigned old = xb_add(&bar[XB_XSUB(b.x)], 1u);
        const unsigned gen = old / nloc;
        if (old + 1u == (gen + 1u) * nloc) {
            __builtin_amdgcn_fence(__ATOMIC_RELEASE, "agent");
            asm volatile("s_waitcnt vmcnt(0)" ::: "memory");
            const unsigned og = xb_add(&bar[XB_TOP], 1u);
            const unsigned tg = og / nx;
            if (og + 1u == (tg + 1u) * nx) xb_add(&bar[XB_TOPGEN], 1u);
            else XB_SPIN(xb_ld(&bar[XB_TOPGEN]) == tg, bar);
            __builtin_amdgcn_fence(__ATOMIC_ACQUIRE, "agent");
            xb_add(&bar[XB_XGEN(b.x)], 1u);
            asm volatile("s_waitcnt vmcnt(0)" ::: "memory");
        } else {
            XB_SPIN(xb_ld(&bar[XB_XGEN(b.x)]) == gen, bar);
            __builtin_amdgcn_fence(__ATOMIC_ACQUIRE, "agent");
            asm volatile("s_waitcnt vmcnt(0)" ::: "memory");
        }
    }
    __syncthreads();
}
constexpr int NB = 8, SEQL = 2048, CTXL = 256, TOK = 2304, DM_ = 1024, MROWS = NB * TOK, NLAT = NB * SEQL, INW = 2832, NIN = 2816;
constexpr int NPHASE = 13;
#ifndef MK_MULTI
#define MK_MULTI 1
#endif
constexpr size_t MiB = 1u << 20;
constexpr size_t WS_CTL = 0, CTL_ZERO_BYTES = 65536;
constexpr size_t WS_MOD = 1 * MiB;
constexpr size_t WS_ROPE = WS_MOD + 256 * 1024;
constexpr size_t WS_G = 2 * MiB;
constexpr size_t WS_BETA = WS_G + 640 * 1024;
constexpr size_t WS_EG = WS_BETA + 640 * 1024;
constexpr size_t WS_EK = WS_EG + 640 * 1024;
constexpr size_t WS_GLAST = WS_EK + 640 * 1024;
constexpr size_t WS_AFF = 5 * MiB;
constexpr size_t WS_IDX = 6 * MiB;
constexpr size_t WS_GATE = WS_IDX + 256 * 1024;
constexpr size_t WS_INV = 7 * MiB;
constexpr size_t S1 = 8 * MiB;
constexpr size_t WS_XN = S1;
constexpr size_t WS_DQ = WS_XN, WS_DK = WS_XN + 18 * MiB;
constexpr size_t WS_PD = WS_XN + 36 * MiB;
constexpr size_t WS_TU = WS_PD, WS_QKD = WS_PD + 36 * MiB;
constexpr size_t WS_DKT = WS_PD + 54 * MiB;
constexpr size_t WS_DVT = WS_DKT + 18 * MiB;
constexpr size_t WS_PA = WS_DVT + 18 * MiB;
constexpr size_t WS_PZ = WS_PA + 27 * MiB;
constexpr size_t WS_Y = WS_PZ + 18 * MiB;
constexpr size_t WS_DO = WS_Y + 32 * MiB;
constexpr size_t WS_WIN = WS_DO + 64 * MiB;
constexpr size_t WS_WOUT = WS_WIN + 6 * MiB;
constexpr size_t WS_END1 = WS_WOUT + 2 * MiB;
constexpr size_t WS_WGU = S1;
constexpr size_t WS_YB = WS_WGU;
constexpr size_t WS_WD = WS_WGU + 64 * MiB;
constexpr size_t WS_H2 = WS_WD + 32 * MiB;
constexpr size_t WS_XG = WS_H2 + 32 * MiB;
constexpr size_t WS_HID = WS_XG + 64 * MiB;
constexpr size_t WS_END2 = WS_HID + 64 * MiB;
constexpr size_t WS_NEED = WS_END1 > WS_END2 ? WS_END1 : WS_END2;
constexpr int CW_TMO = 0, CW_CODE = 1, CW_ATTNQ = 64, CW_BAR = 4096;
constexpr int LDS_BYTES = 147456;
constexpr int MISC_OFF = 146944;

typedef unsigned u32x2 __attribute__((ext_vector_type(2)));
__device__ __forceinline__ float bf2f(unsigned short h) { return __builtin_bit_cast(float, (unsigned)h << 16); }
__device__ __forceinline__ float bflo(unsigned w) { return __builtin_bit_cast(float, w << 16); }
__device__ __forceinline__ float bfhi(unsigned w) { return __builtin_bit_cast(float, w & 0xffff0000u); }
__device__ __forceinline__ float wave_sum(float v) {
#pragma unroll
    for (int o = 1; o < 64; o <<= 1) v += __shfl_xor(v, o);
    return v;
}
__device__ __forceinline__ float reduce16(const float (&a)[16], int lane) {
    float b8[8], b4[4], b2[2];
#pragma unroll
    for (int e = 0; e < 8; ++e) { const float send = (lane & 32) ? a[e] : a[e + 8], keep = (lane & 32) ? a[e + 8] : a[e]; b8[e] = keep + __shfl_xor(send, 32); }
#pragma unroll
    for (int e = 0; e < 4; ++e) { const float send = (lane & 16) ? b8[e] : b8[e + 4], keep = (lane & 16) ? b8[e + 4] : b8[e]; b4[e] = keep + __shfl_xor(send, 16); }
#pragma unroll
    for (int e = 0; e < 2; ++e) { const float send = (lane & 8) ? b4[e] : b4[e + 2], keep = (lane & 8) ? b4[e + 2] : b4[e]; b2[e] = keep + __shfl_xor(send, 8); }
    const float send = (lane & 4) ? b2[0] : b2[1], keep = (lane & 4) ? b2[1] : b2[0];
    float r = keep + __shfl_xor(send, 4);
    r += __shfl_xor(r, 2); r += __shfl_xor(r, 1);
    return r;
}

struct Frame {
    LAS unsigned char* lds; unsigned char* ldsg;
    volatile LAS unsigned* MISC;
    gu32* ctl;
    int tid, lane, wave, G, gw, NGW;
    float* out; unsigned char* ws;
};
#define WSP(T, off) ((T*)(F.ws + (off)))

__device__ __forceinline__ void transpose_item(const float* W, int ldw, int k0, int n0, bf16* dst, int K, LAS float* scr, int lane) {
#pragma unroll 8
    for (int i = 0; i < 32; ++i) { const int kk = 2 * i + (lane >> 5); scr[kk * 33 + (lane & 31)] = W[(size_t)(k0 + kk) * ldw + n0 + (lane & 31)]; }
    LDS_WAIT(); asm volatile("" ::: "memory");
    const int c = lane & 7;
#pragma unroll
    for (int j = 0; j < 4; ++j) { const int n = (lane >> 3) + 8 * j; const LAS float* s = scr + (8 * c) * 33 + n;
        v4u o; o.x = pk2(s[0 * 33], s[1 * 33]); o.y = pk2(s[2 * 33], s[3 * 33]); o.z = pk2(s[4 * 33], s[5 * 33]); o.w = pk2(s[6 * 33], s[7 * 33]);
        *(GAS v4u*)(dst + (size_t)n * K + 8 * c) = o; }
    LDS_WAIT(); asm volatile("" ::: "memory");
}
__device__ __forceinline__ void p0_phase(Frame& F, const float* c_, const float* c_ctx_, const float* w_mod_, const float* b_mod_, const float* w_in_, const float* w_out_) {
    float* MOD = WSP(float, WS_MOD);
    if (blockIdx.x < 192) {
        LAS float* sc = (LAS float*)F.lds;
        LAS float* red = (LAS float*)(F.lds + 36864);
        for (int i = F.tid; i < 9 * 1024; i += 512) { const int r = i >> 10, k = i & 1023; const float v = (r < 8) ? c_[r * 1024 + k] : c_ctx_[k]; sc[i] = v / (1.0f + expf(-v)); }
        __syncthreads();
        const int col = F.tid & 31, kg = F.tid >> 5, n0 = blockIdx.x * 32;
        float acc[9];
#pragma unroll
        for (int r = 0; r < 9; ++r) acc[r] = 0.f;
        const float* wp = w_mod_ + (size_t)kg * 6144 + n0 + col;
#pragma unroll 8
        for (int i = 0; i < 64; ++i) { const float w = wp[(size_t)i * 16 * 6144]; const int k = kg + 16 * i;
#pragma unroll
            for (int r = 0; r < 9; ++r) acc[r] += sc[r * 1024 + k] * w; }
#pragma unroll
        for (int r = 0; r < 9; ++r) red[(kg * 9 + r) * 32 + col] = acc[r];
        __syncthreads();
        if (F.tid < 288) { const int r = F.tid >> 5, cc = F.tid & 31; float s = 0.f;
#pragma unroll
            for (int g2 = 0; g2 < 16; ++g2) s += red[(g2 * 9 + r) * 32 + cc];
            MOD[r * 6144 + n0 + cc] = s + b_mod_[n0 + cc]; }
        __syncthreads();
    } else if (blockIdx.x == 200) {
        float* RT = WSP(float, WS_ROPE);
        for (int i = F.tid; i < 1024; i += 512) { const int pos = i >> 4, fi = i & 15; const float fr = powf(10000.0f, -(float)fi / 16.0f); const float ang = (float)pos * fr;
            RT[2 * i] = cosf(ang); RT[2 * i + 1] = sinf(ang); }
    }
    LAS float* scr = (LAS float*)(F.lds + 57344 + F.wave * 8448);
    bf16* WinT = WSP(bf16, WS_WIN); bf16* WoutT = WSP(bf16, WS_WOUT);
    constexpr int I_IN = 16 * 88, I_OUT = 16 * 32;
    for (int it = F.gw; it < I_IN + I_OUT; it += F.NGW) {
        if (it < I_IN) { const int kb = it / 88, nb = it % 88; transpose_item(w_in_, INW, 64 * kb, 32 * nb, WinT + (size_t)(32 * nb) * 1024 + 64 * kb, 1024, scr, F.lane); }
        else { const int r = it - I_IN, kb = r / 32, nb = r % 32; transpose_item(w_out_, 1024, 64 * kb, 32 * nb, WoutT + (size_t)(32 * nb) * 1024 + 64 * kb, 1024, scr, F.lane); }
    }
}

__device__ __forceinline__ float softplus_f(float x) { return fmaxf(x, 0.f) + log1pf(expf(-fabsf(x))); }
__device__ __forceinline__ void p1_phase(Frame& F, const float* x_, const float* ctx_, const float* norm1_w_, const float* w_in_, const float* a_log_, const float* dt_bias_) {
    LAS float* wt = (LAS float*)F.lds;
    for (int i = F.tid; i < 16384; i += 512) { const int k = i >> 4, e = i & 15; wt[e * 1024 + k] = w_in_[(size_t)k * INW + NIN + e]; }
    __syncthreads();
    const float* MOD = WSP(float, WS_MOD); bf16* XN = WSP(bf16, WS_XN); float* Gg = WSP(float, WS_G); float* Bt = WSP(float, WS_BETA);
    const int lane = F.lane;
    for (int row = F.gw; row < MROWS; row += F.NGW) {
        const int b = row / TOK, t = row - b * TOK;
        const float* src = (t < CTXL) ? ctx_ + (size_t)(b * CTXL + t) * 1024 : x_ + (size_t)(b * SEQL + t - CTXL) * 1024;
        const float* mod = MOD + (size_t)(t < CTXL ? 8 : b) * 6144;
        f32x4 v[4]; float ss = 0.f;
#pragma unroll
        for (int j = 0; j < 4; ++j) { v[j] = *(const f32x4*)(src + 4 * lane + 256 * j); ss += (v[j].x * v[j].x + v[j].y * v[j].y) + (v[j].z * v[j].z + v[j].w * v[j].w); }
        const float rstd = 1.0f / sqrtf(wave_sum(ss) * (1.0f / 1024.0f) + 1e-6f);
        float acc[16];
#pragma unroll
        for (int e = 0; e < 16; ++e) acc[e] = 0.f;
#pragma unroll
        for (int j = 0; j < 4; ++j) { const int k = 4 * lane + 256 * j;
            const f32x4 nw = *(const f32x4*)(norm1_w_ + k), sh = *(const f32x4*)(mod + k), sc = *(const f32x4*)(mod + 1024 + k);
            const f32x4 h = (v[j] * rstd) * nw * (sc + 1.0f) + sh;
            u32x2 w; w.x = pk2(h.x, h.y); w.y = pk2(h.z, h.w); *(u32x2*)(XN + (size_t)row * 1024 + k) = w;
#pragma unroll
            for (int e = 0; e < 16; ++e) { const f32x4 w4 = *(const LAS f32x4*)(wt + e * 1024 + k); acc[e] += (h.x * w4.x + h.y * w4.y) + (h.z * w4.z + h.w * w4.w); }
            asm volatile("" ::: "memory"); }
        const float val = reduce16(acc, lane);
        if ((lane & 3) == 0) { const int e = lane >> 2;
            if (e < 8) { const int dir = e >> 2, hh = e & 3; Bt[(size_t)((dir * 8 + b) * 4 + hh) * TOK + t] = 1.0f / (1.0f + expf(-val)); }
            else { const int e2 = e - 8, dir = e2 >> 2, hh = e2 & 3; Gg[(size_t)((dir * 8 + b) * 4 + hh) * TOK + t] = -expf(a_log_[dir * 4 + hh]) * softplus_f(val + dt_bias_[dir * 4 + hh]); } }
    }
}

__device__ __forceinline__ void qk_prep8(float (&f)[8], const float* nw, bool rope, int prow, int pcol, const float* RT, int c, float scale) {
    float ss = 0.f;
#pragma unroll
    for (int j = 0; j < 8; ++j) ss += f[j] * f[j];
    ss += __shfl_xor(ss, 1); ss += __shfl_xor(ss, 2); ss += __shfl_xor(ss, 4);
    const float rstd = 1.0f / sqrtf(ss * (1.0f / 64.0f) + 1e-6f);
#pragma unroll
    for (int j = 0; j < 8; ++j) f[j] = f[j] * rstd * nw[8 * c + j];
    const int pos = (c & 4) ? pcol : prow;
#pragma unroll
    for (int j = 0; j < 8; ++j) { const float p = __shfl_xor(f[j], 2);
        if (rope) { const int fi = 8 * (c & 1) + j; const float cs = RT[2 * (pos * 16 + fi)], sn = RT[2 * (pos * 16 + fi) + 1]; f[j] = f[j] * cs + ((c & 2) ? p * sn : -p * sn); } }
#pragma unroll
    for (int j = 0; j < 8; ++j) f[j] *= scale;
}
__device__ __forceinline__ void p3_phase(Frame& F, const float* q_norm_w_, const float* k_norm_w_, const float* conv_w_) {
    bf16* PA = WSP(bf16, WS_PA); const float* RT = WSP(float, WS_ROPE);
    const int lane = F.lane;
    for (int row = F.gw; row < MROWS; row += F.NGW) {
        const int b = row / TOK, t = row - b * TOK; const bool lat = t >= CTXL; const int tl = t - CTXL, prow = tl >> 6, pcol = tl & 63;
        bf16* pa = PA + (size_t)row * 768;
        if (lat) {
            const v4u raw = *(const v4u*)(pa + 8 * lane); float f[8] = {bflo(raw.x), bfhi(raw.x), bflo(raw.y), bfhi(raw.y), bflo(raw.z), bfhi(raw.z), bflo(raw.w), bfhi(raw.w)};
            qk_prep8(f, q_norm_w_, true, prow, pcol, RT, lane & 7, attn_body::C2);
            v4u o; o.x = pk2(f[0], f[1]); o.y = pk2(f[2], f[3]); o.z = pk2(f[4], f[5]); o.w = pk2(f[6], f[7]); *(v4u*)(pa + 8 * lane) = o;
        }
        { const int kl = lane & 15;
            const v4u raw = *(const v4u*)(pa + 512 + 8 * kl); float f[8] = {bflo(raw.x), bfhi(raw.x), bflo(raw.y), bfhi(raw.y), bflo(raw.z), bfhi(raw.z), bflo(raw.w), bfhi(raw.w)};
            qk_prep8(f, k_norm_w_, lat, prow, pcol, RT, kl & 7, 1.0f);
            v4u o; o.x = pk2(f[0], f[1]); o.y = pk2(f[2], f[3]); o.z = pk2(f[4], f[5]); o.w = pk2(f[6], f[7]);
            if (lane < 16) *(v4u*)(pa + 512 + 8 * kl) = o; }
    }
    const bf16* PD = WSP(bf16, WS_PD); bf16* DQ = WSP(bf16, WS_DQ); bf16* DK = WSP(bf16, WS_DK); bf16* DKT = WSP(bf16, WS_DKT); bf16* DVT = WSP(bf16, WS_DVT);
    LAS bf16* tile = (LAS bf16*)(F.lds + F.wave * 16640);
    for (int it = F.gw; it < NB * 36 * 12; it += F.NGW) {
        const int hh = it & 3, ty = (it >> 2) % 3, bn = it / 12, n = bn % 36, b = bn / 36;
        const int t0 = 64 * n, lo = (n < 4) ? 0 : CTXL, hi = (n < 4) ? CTXL : TOK;
        const int col = ty * 512 + hh * 128 + 2 * lane;
        float w0[5], w1[5];
#pragma unroll
        for (int j = 0; j < 5; ++j) { w0[j] = conv_w_[j * 1536 + col]; w1[j] = conv_w_[j * 1536 + col + 1]; }
        const bf16* src = PD + (size_t)(b * TOK) * 1536 + col;
        unsigned raw[68];
#pragma unroll
        for (int i = 0; i < 68; ++i) { const int tt = t0 - 2 + i; const bool ok = (tt >= lo) && (tt < hi); const unsigned vv = *(const unsigned*)(src + (size_t)(ok ? tt : t0) * 1536); raw[i] = ok ? vv : 0u; }
        const float osc = (ty == 0) ? 0.08838834764831845f : 1.0f;
#pragma unroll
        for (int i = 0; i < 64; ++i) {
            float a0 = 0.f, a1 = 0.f;
#pragma unroll
            for (int j = 0; j < 5; ++j) { a0 += bflo(raw[i + j]) * w0[j]; a1 += bfhi(raw[i + j]) * w1[j]; }
            a0 = a0 / (1.0f + __expf(-a0)); a1 = a1 / (1.0f + __expf(-a1));
            if (ty < 2) { const float ss = wave_sum(a0 * a0 + a1 * a1); const float sc = osc / sqrtf(ss + 1e-6f); a0 *= sc; a1 *= sc; }
            const unsigned pk = pk2(a0, a1);
            if (ty == 0) *(unsigned*)(DQ + ((size_t)(b * 4 + hh) * TOK + t0 + i) * 128 + 2 * lane) = pk;
            else { if (ty == 1) *(unsigned*)(DK + ((size_t)(b * 4 + hh) * TOK + t0 + i) * 128 + 2 * lane) = pk;
                *(LAS unsigned*)(tile + i * 130 + 2 * lane) = pk; }
        }
        if (ty >= 1) {
            LDS_WAIT(); asm volatile("" ::: "memory");
            bf16* dst = (ty == 1 ? DKT : DVT) + (size_t)((b * 4 + hh) * 36 + n) * 8192;
#pragma unroll 4
            for (int q = 0; q < 16; ++q) { const int ch = q * 8 + (lane >> 3), j0 = 8 * (lane & 7); const LAS bf16* s = tile + j0 * 130 + ch;
                v4u o; o.x = (unsigned)s[0] | ((unsigned)s[130] << 16); o.y = (unsigned)s[260] | ((unsigned)s[390] << 16); o.z = (unsigned)s[520] | ((unsigned)s[650] << 16); o.w = (unsigned)s[780] | ((unsigned)s[910] << 16);
                *(v4u*)(dst + ch * 64 + j0) = o; }
            LDS_WAIT(); asm volatile("" ::: "memory");
        }
    }
}

__device__ __forceinline__ void p4_phase(Frame& F, bf16* TW) {
    const bf16* DQ = WSP(bf16, WS_DQ); const bf16* DK = WSP(bf16, WS_DK);
    const float* Gg = WSP(float, WS_G); const float* Bt = WSP(float, WS_BETA);
    bf16* TU = WSP(bf16, WS_TU); bf16* QKD = WSP(bf16, WS_QKD);
    float* EG = WSP(float, WS_EG); float* EK = WSP(float, WS_EK); float* GL = WSP(float, WS_GLAST);
    LAS float* M = (LAS float*)(F.lds + F.wave * 17152);
    LAS float* gcv = M + 64 * 65;
    LAS float* btv = gcv + 64;
    const int lane = F.lane, fr = lane & 15, fq = lane >> 4;
    for (int task = F.gw; task < NB * 4 * 36 * 2; task += F.NGW) {
        const int dir = task & 1, n = (task >> 1) % 36, bh = task / 72;
        const size_t tokbase = (size_t)bh * TOK + 64 * n;
        const bf16* Kc = DK + tokbase * 128; const bf16* Qc = DQ + tokbase * 128;
        const size_t gbase = (size_t)(dir * 32 + bh) * TOK + 64 * n;
        const int rl = dir ? 63 - lane : lane;
        const float gl = Gg[gbase + rl], bl = Bt[gbase + rl];
        float gc = gl;
#pragma unroll
        for (int o = 1; o < 64; o <<= 1) { const float u = __shfl_up(gc, o); if (lane >= o) gc += u; }
        gcv[lane] = gc; btv[lane] = bl;
        bf16x8 kf[4][4], qf[4][4];
        const bool outc = n >= 4;
#pragma unroll
        for (int rt = 0; rt < 4; ++rt) { const int i = 16 * rt + fr, ro = dir ? 63 - i : i;
#pragma unroll
            for (int ks = 0; ks < 4; ++ks) { kf[rt][ks] = *(const bf16x8*)(Kc + ro * 128 + 32 * ks + 8 * fq); qf[rt][ks] = *(const bf16x8*)(Qc + ro * 128 + 32 * ks + 8 * fq); } }
        LDS_WAIT(); asm volatile("" ::: "memory");
        bf16* qkd = QKD + ((size_t)(dir * 32 + bh) * 32 + (n - 4)) * 4096;
#pragma unroll
        for (int rt = 0; rt < 4; ++rt)
#pragma unroll
            for (int ct = 0; ct < 4; ++ct) {
                f32x4 a = {0.f, 0.f, 0.f, 0.f}, q = {0.f, 0.f, 0.f, 0.f};
#pragma unroll
                for (int ks = 0; ks < 4; ++ks) { a = __builtin_amdgcn_mfma_f32_16x16x32_bf16(kf[rt][ks], kf[ct][ks], a, 0, 0, 0); q = __builtin_amdgcn_mfma_f32_16x16x32_bf16(qf[rt][ks], kf[ct][ks], q, 0, 0, 0); }
                const int j = 16 * ct + fr; const float gj = gcv[j];
#pragma unroll
                for (int r = 0; r < 4; ++r) { const int i = 16 * rt + 4 * fq + r; const float dec = __expf(fminf(gcv[i] - gj, 0.f));
                    M[i * 65 + j] = (i > j) ? btv[i] * a[r] * dec : 0.f;
                    if (outc) { const int io = dir ? 63 - i : i, jo = dir ? 63 - j : j; qkd[io * 64 + jo] = (bf16)f2bf((i >= j) ? q[r] * dec : 0.f); } }
            }
        LDS_WAIT(); asm volatile("" ::: "memory");
        M[lane] = (lane == 0) ? 1.f : 0.f;
        LDS_WAIT(); asm volatile("" ::: "memory");
        for (int i = 1; i < 64; ++i) {
            float acc = 0.f;
            for (int j = 0; j < i; ++j) acc = fmaf(M[i * 65 + j], M[j * 65 + lane], acc);
            LDS_WAIT(); asm volatile("" ::: "memory");
            M[i * 65 + lane] = (lane < i) ? -acc : (lane == i ? 1.f : 0.f);
            LDS_WAIT(); asm volatile("" ::: "memory");
        }
        const float bj = bl, ej = __expf(gc);
        bf16* tu = TU + ((size_t)(dir * 32 + bh) * 36 + n) * 4096; bf16* tw = TW + ((size_t)(dir * 32 + bh) * 36 + n) * 4096;
        for (int i = 0; i < 64; ++i) { const float tv = M[i * 65 + lane] * bj; const int io = dir ? 63 - i : i;
            tu[io * 64 + rl] = (bf16)f2bf(tv); tw[io * 64 + rl] = (bf16)f2bf(tv * ej); }
        const float glast = __shfl(gc, 63);
        EG[gbase + rl] = ej; EK[gbase + rl] = __expf(glast - gc);
        if (lane == 0) GL[(size_t)(dir * 32 + bh) * 36 + n] = __expf(glast);
        LDS_WAIT(); asm volatile("" ::: "memory");
    }
}

__device__ __forceinline__ f32x4 mm2(const LAS bf16* ap, const LAS bf16* bp, f32x4 acc) {
    acc = __builtin_amdgcn_mfma_f32_16x16x32_bf16(*(const LAS bf16x8*)ap, *(const LAS bf16x8*)bp, acc, 0, 0, 0);
    acc = __builtin_amdgcn_mfma_f32_16x16x32_bf16(*(const LAS bf16x8*)(ap + 32), *(const LAS bf16x8*)(bp + 32), acc, 0, 0, 0);
    return acc;
}
__device__ __forceinline__ f32x4 mm4(const LAS bf16* ap, const LAS bf16* bp, f32x4 acc) {
#pragma unroll
    for (int ks = 0; ks < 4; ++ks) acc = __builtin_amdgcn_mfma_f32_16x16x32_bf16(*(const LAS bf16x8*)(ap + 32 * ks), *(const LAS bf16x8*)(bp + 32 * ks), acc, 0, 0, 0);
    return acc;
}
__device__ __forceinline__ u32x2 pack4(f32x4 v) { u32x2 w; w.x = pk2(v[0], v[1]); w.y = pk2(v[2], v[3]); return w; }
constexpr int SC_KT = 0, SC_VT = 18432, SC_QS = 27648, SC_TU = 45056, SC_TW = 54272, SC_QK = 63488, SC_ST = 72704, SC_WM = 90112, SC_VN = 107520, SC_VS = 116736, SC_EG = 125952, SC_EK = 126208;
__device__ __forceinline__ void dn_scan(Frame& F, int item, const bf16* TWg) {
    const int vh = item & 1, dir = (item >> 1) & 1, bh = item >> 2, b = bh >> 2, hh = bh & 3;
    const bf16* DQ = WSP(bf16, WS_DQ); const bf16* DKT = WSP(bf16, WS_DKT); const bf16* DVT = WSP(bf16, WS_DVT);
    const bf16* TUg = WSP(bf16, WS_TU); const bf16* QKg = WSP(bf16, WS_QKD);
    const float* EG = WSP(float, WS_EG); const float* EK = WSP(float, WS_EK); const float* GL = WSP(float, WS_GLAST);
    float* DO = WSP(float, WS_DO) + (size_t)dir * NLAT * 512;
    LAS bf16* KT = (LAS bf16*)(F.lds + SC_KT); LAS bf16* VT = (LAS bf16*)(F.lds + SC_VT); LAS bf16* QS = (LAS bf16*)(F.lds + SC_QS);
    LAS bf16* TU = (LAS bf16*)(F.lds + SC_TU); LAS bf16* TW = (LAS bf16*)(F.lds + SC_TW); LAS bf16* QK = (LAS bf16*)(F.lds + SC_QK);
    LAS bf16* ST = (LAS bf16*)(F.lds + SC_ST); LAS bf16* WM = (LAS bf16*)(F.lds + SC_WM); LAS bf16* VN = (LAS bf16*)(F.lds + SC_VN); LAS bf16* VS = (LAS bf16*)(F.lds + SC_VS);
    LAS float* EGl = (LAS float*)(F.lds + SC_EG); LAS float* EKl = (LAS float*)(F.lds + SC_EK);
    const int tid = F.tid, lane = F.lane, w = F.wave, fr = lane & 15, fq = lane >> 4, vt = w & 3, ih = w >> 2;
    for (int i = tid; i < 64 * 136 / 2; i += 512) ((LAS unsigned*)ST)[i] = 0u;
    f32x4 s[4];
#pragma unroll
    for (int q = 0; q < 4; ++q) s[q] = (f32x4){0.f, 0.f, 0.f, 0.f};
    const int fo72 = fr * 72 + 8 * fq, fo136 = fr * 136 + 8 * fq;
    for (int step = 0; step < 36; ++step) {
        const int n = (step < 4) ? (dir ? 3 - step : step) : (dir ? 39 - step : step);
        const bool outc = n >= 4;
        const size_t cb = (size_t)bh * 36 + n, cd = (size_t)(dir * 32 + bh) * 36 + n;
        {
            const bf16* kt = DKT + cb * 8192; const bf16* vtg = DVT + cb * 8192 + (size_t)vh * 4096; const bf16* qs = DQ + ((size_t)bh * TOK + 64 * n) * 128;
#pragma unroll
            for (int q = 0; q < 2; ++q) { const int p = tid + 512 * q; *(LAS v4u*)(KT + (p >> 3) * 72 + (p & 7) * 8) = *(const v4u*)(kt + p * 8);
                *(LAS v4u*)(QS + (p >> 4) * 136 + (p & 15) * 8) = *(const v4u*)(qs + p * 8); }
            *(LAS v4u*)(VT + (tid >> 3) * 72 + (tid & 7) * 8) = *(const v4u*)(vtg + tid * 8);
            *(LAS v4u*)(TU + (tid >> 3) * 72 + (tid & 7) * 8) = *(const v4u*)(TUg + cd * 4096 + tid * 8);
            *(LAS v4u*)(TW + (tid >> 3) * 72 + (tid & 7) * 8) = *(const v4u*)(TWg + cd * 4096 + tid * 8);
            if (outc) *(LAS v4u*)(QK + (tid >> 3) * 72 + (tid & 7) * 8) = *(const v4u*)(QKg + ((size_t)(dir * 32 + bh) * 32 + (n - 4)) * 4096 + tid * 8);
            if (tid < 64) EGl[tid] = EG[(size_t)(dir * 32 + bh) * TOK + 64 * n + tid];
            else if (tid < 128) EKl[tid - 64] = EK[(size_t)(dir * 32 + bh) * TOK + 64 * n + tid - 64];
        }
        const float glast = GL[cd];
        __syncthreads();
#pragma unroll
        for (int q = 0; q < 4; ++q) { const int dt = 4 * ih + q; const f32x4 c = mm2(KT + dt * 16 * 72 + fo72, TW + vt * 16 * 72 + fo72, (f32x4){0.f, 0.f, 0.f, 0.f});
            *(LAS u32x2*)(WM + (16 * vt + fr) * 136 + 16 * dt + 4 * fq) = pack4(c); }
        f32x4 um[2];
#pragma unroll
        for (int q = 0; q < 2; ++q) um[q] = mm2(TU + (2 * ih + q) * 16 * 72 + fo72, VT + vt * 16 * 72 + fo72, (f32x4){0.f, 0.f, 0.f, 0.f});
        __syncthreads();
        f32x4 qs[2];
#pragma unroll
        for (int q = 0; q < 2; ++q) { const int it2 = 2 * ih + q;
            const f32x4 ws = mm4(WM + it2 * 16 * 136 + fo136, ST + vt * 16 * 136 + fo136, (f32x4){0.f, 0.f, 0.f, 0.f});
            const f32x4 vn = um[q] - ws;
            qs[q] = (f32x4){0.f, 0.f, 0.f, 0.f};
            if (outc) qs[q] = mm4(QS + it2 * 16 * 136 + fo136, ST + vt * 16 * 136 + fo136, qs[q]);
            const f32x4 ek = *(const LAS f32x4*)(EKl + 16 * it2 + 4 * fq);
            *(LAS u32x2*)(VN + (16 * vt + fr) * 72 + 16 * it2 + 4 * fq) = pack4(vn);
            *(LAS u32x2*)(VS + (16 * vt + fr) * 72 + 16 * it2 + 4 * fq) = pack4(vn * ek); }
        __syncthreads();
        if (outc) {
#pragma unroll
            for (int q = 0; q < 2; ++q) { const int it2 = 2 * ih + q;
                f32x4 o = mm2(QK + it2 * 16 * 72 + fo72, VN + vt * 16 * 72 + fo72, (f32x4){0.f, 0.f, 0.f, 0.f});
                const f32x4 eg = *(const LAS f32x4*)(EGl + 16 * it2 + 4 * fq);
                o = o + eg * qs[q];
                float* op = DO + ((size_t)b * SEQL + 64 * (n - 4) + 16 * it2 + 4 * fq) * 512 + hh * 128 + vh * 64 + 16 * vt + fr;
#pragma unroll
                for (int r = 0; r < 4; ++r) op[(size_t)r * 512] = o[r]; }
        }
#pragma unroll
        for (int q = 0; q < 4; ++q) { const int dt = 4 * ih + q; s[q] = s[q] * glast;
            s[q] = mm2(KT + dt * 16 * 72 + fo72, VS + vt * 16 * 72 + fo72, s[q]);
            *(LAS u32x2*)(ST + (16 * vt + fr) * 136 + 16 * dt + 4 * fq) = pack4(s[q]); }
        __syncthreads();
    }
}
__device__ __forceinline__ void p5_phase(Frame& F, const bf16* TWg) {
    if (blockIdx.x < 128) dn_scan(F, blockIdx.x, TWg);
    const attn_body::bf16* PA = (const attn_body::bf16*)WSP(bf16, WS_PA); attn_body::bf16* Y = (attn_body::bf16*)WSP(bf16, WS_Y);
    for (;;) {
        __syncthreads();
        if (F.tid == 0) F.MISC[0] = __hip_atomic_fetch_add(F.ctl + CW_ATTNQ, 1u, RLX_AGENT);
        __syncthreads();
        const int u = (int)F.MISC[0];
        if (u >= 512) break;
        const int b = u >> 6, hq = (u >> 3) & 7, qb = u & 7;
        attn_body::attn_unit<8>(PA + ((size_t)b * TOK + CTXL + qb * 256) * 768 + hq * 64, PA + (size_t)b * TOK * 768 + 512 + (hq >> 2) * 64, PA + (size_t)b * TOK * 768 + 640 + (hq >> 2) * 64,
                                Y + ((size_t)b * SEQL + qb * 256) * 1024 + hq * 64, (char*)F.ldsg);
    }
    __syncthreads();
}

__device__ __forceinline__ void p6_phase(Frame& F, const float* o_norm_w_) {
    const float* DO = WSP(float, WS_DO); const bf16* PZ = WSP(bf16, WS_PZ); bf16* Y = WSP(bf16, WS_Y);
    const int lane = F.lane;
    for (int row = F.gw; row < NLAT; row += F.NGW) {
        const int b = row >> 11, t = row & 2047;
        const float* o0 = DO + (size_t)row * 512 + 8 * lane; const float* o1 = o0 + (size_t)NLAT * 512;
        const f32x4 a0 = *(const f32x4*)o0 + *(const f32x4*)o1, a1 = *(const f32x4*)(o0 + 4) + *(const f32x4*)(o1 + 4);
        float ss = (a0.x * a0.x + a0.y * a0.y) + (a0.z * a0.z + a0.w * a0.w) + (a1.x * a1.x + a1.y * a1.y) + (a1.z * a1.z + a1.w * a1.w);
        ss += __shfl_xor(ss, 1); ss += __shfl_xor(ss, 2); ss += __shfl_xor(ss, 4); ss += __shfl_xor(ss, 8);
        const float rstd = 1.0f / sqrtf(ss * (1.0f / 128.0f) + 1e-6f);
        const int ch = (8 * lane) & 127;
        const f32x4 w0 = *(const f32x4*)(o_norm_w_ + ch), w1 = *(const f32x4*)(o_norm_w_ + ch + 4);
        const v4u zr = *(const v4u*)(PZ + ((size_t)b * TOK + CTXL + t) * 512 + 8 * lane);
        const float z[8] = {bflo(zr.x), bfhi(zr.x), bflo(zr.y), bfhi(zr.y), bflo(zr.z), bfhi(zr.z), bflo(zr.w), bfhi(zr.w)};
        float y[8] = {a0.x * rstd * w0.x, a0.y * rstd * w0.y, a0.z * rstd * w0.z, a0.w * rstd * w0.w, a1.x * rstd * w1.x, a1.y * rstd * w1.y, a1.z * rstd * w1.z, a1.w * rstd * w1.w};
#pragma unroll
        for (int j = 0; j < 8; ++j) y[j] *= z[j] / (1.0f + __expf(-z[j]));
        v4u o; o.x = pk2(y[0], y[1]); o.y = pk2(y[2], y[3]); o.z = pk2(y[4], y[5]); o.w = pk2(y[6], y[7]);
        *(v4u*)(Y + (size_t)row * 1024 + 512 + 8 * lane) = o;
    }
}

__device__ __forceinline__ void p8_phase(Frame& F, const float* norm2_w_, const float* router_w_, const float* w_gate_, const float* w_up_, const float* w_down_) {
    LAS float* wt = (LAS float*)F.lds;
    for (int i = F.tid; i < 16384; i += 512) { const int k = i >> 4, e = i & 15; wt[e * 1024 + k] = router_w_[i]; }
    __syncthreads();
    const float* MOD = WSP(float, WS_MOD); bf16* H2 = WSP(bf16, WS_H2); float* AFF = WSP(float, WS_AFF);
    const int lane = F.lane;
    for (int row = F.gw; row < NLAT; row += F.NGW) {
        const int b = row >> 11, t = row & 2047;
        const float* src = F.out + (size_t)row * 1024; const float* mod = MOD + (size_t)b * 6144;
        f32x4 v[4]; float ss = 0.f;
#pragma unroll
        for (int j = 0; j < 4; ++j) { v[j] = *(const f32x4*)(src + 4 * lane + 256 * j); ss += (v[j].x * v[j].x + v[j].y * v[j].y) + (v[j].z * v[j].z + v[j].w * v[j].w); }
        const float rstd = 1.0f / sqrtf(wave_sum(ss) * (1.0f / 1024.0f) + 1e-6f);
        float acc[16];
#pragma unroll
        for (int e = 0; e < 16; ++e) acc[e] = 0.f;
#pragma unroll
        for (int j = 0; j < 4; ++j) { const int k = 4 * lane + 256 * j;
            const f32x4 nw = *(const f32x4*)(norm2_w_ + k), sh = *(const f32x4*)(mod + 3072 + k), sc = *(const f32x4*)(mod + 4096 + k);
            const f32x4 h = (v[j] * rstd) * nw * (sc + 1.0f) + sh;
            u32x2 w; w.x = pk2(h.x, h.y); w.y = pk2(h.z, h.w); *(u32x2*)(H2 + (size_t)row * 1024 + k) = w;
#pragma unroll
            for (int e = 0; e < 16; ++e) { const f32x4 w4 = *(const LAS f32x4*)(wt + e * 1024 + k); acc[e] += (h.x * w4.x + h.y * w4.y) + (h.z * w4.z + h.w * w4.w); }
            asm volatile("" ::: "memory"); }
        const float val = reduce16(acc, lane);
        float lg[16]; float mx = -3.0e38f;
#pragma unroll
        for (int e = 0; e < 16; ++e) { lg[e] = __shfl(val, e << 2); mx = fmaxf(mx, lg[e]); }
        float sum = 0.f;
#pragma unroll
        for (int e = 0; e < 16; ++e) { lg[e] = expf(lg[e] - mx); sum += lg[e]; }
        float mine = 0.f;
#pragma unroll
        for (int e = 0; e < 16; ++e) mine = (lane == e) ? lg[e] : mine;
        if (lane < 16) AFF[((size_t)b * 16 + lane) * 2048 + t] = mine / sum;
    }
    LAS float* scr = (LAS float*)(F.lds + 65536 + F.wave * 8448);
    bf16* WGU = WSP(bf16, WS_WGU); bf16* WD = WSP(bf16, WS_WD);
    for (int it = F.gw; it < 3 * 16 * 512; it += F.NGW) {
        const int ty = it / 8192, r = it % 8192, e = r >> 9, kb = (r & 511) >> 5, nb = r & 31, n0 = 32 * nb, k0 = 64 * kb;
        if (ty == 0) transpose_item(w_gate_ + (size_t)e * 1048576, 1024, k0, n0, WGU + ((size_t)e * 2048 + 256 * (n0 >> 7) + (n0 & 127)) * 1024 + k0, 1024, scr, F.lane);
        else if (ty == 1) transpose_item(w_up_ + (size_t)e * 1048576, 1024, k0, n0, WGU + ((size_t)e * 2048 + 256 * (n0 >> 7) + 128 + (n0 & 127)) * 1024 + k0, 1024, scr, F.lane);
        else transpose_item(w_down_ + (size_t)e * 1048576, 1024, k0, n0, WD + ((size_t)e * 1024 + n0) * 1024 + k0, 1024, scr, F.lane);
    }
}

__device__ __forceinline__ void p9_phase(Frame& F) {
    const float* AFF = WSP(float, WS_AFF); int* IDX = WSP(int, WS_IDX); float* GATE = WSP(float, WS_GATE); int* INV = WSP(int, WS_INV);
    LAS unsigned long long* keys = (LAS unsigned long long*)F.lds;
    for (int item = blockIdx.x; item < 256; item += F.G) {
        const int half = item & 1, be = item >> 1, b = be >> 4, e = be & 15;
        const float* a = AFF + (size_t)be * 2048;
        __syncthreads();
        for (int i = F.tid; i < 2048; i += 512) keys[i] = ((unsigned long long)__builtin_bit_cast(unsigned, a[i]) << 32) | (unsigned long long)(0xFFFFFFFFu - (unsigned)i);
        __syncthreads();
        const int i0 = half * 1024 + F.tid, i1 = i0 + 512;
        const unsigned long long k0 = keys[i0], k1 = keys[i1];
        int c0 = 0, c1 = 0;
#pragma unroll 4
        for (int j = 0; j < 2048; j += 2) { const unsigned long long ka = keys[j], kb = keys[j + 1];
            c0 += (ka > k0) + (kb > k0); c1 += (ka > k1) + (kb > k1); }
        if (c0 < 256) { IDX[be * 256 + c0] = i0; GATE[be * 256 + c0] = a[i0]; }
        if (c1 < 256) { IDX[be * 256 + c1] = i1; GATE[be * 256 + c1] = a[i1]; }
        INV[((size_t)b * 2048 + i0) * 16 + e] = (c0 < 256) ? c0 : -1;
        INV[((size_t)b * 2048 + i1) * 16 + e] = (c1 < 256) ? c1 : -1;
    }
    __syncthreads();
}

__device__ __forceinline__ void p10_phase(Frame& F) {
    const bf16* H2 = WSP(bf16, WS_H2); bf16* XG = WSP(bf16, WS_XG); const int* IDX = WSP(int, WS_IDX);
    for (int r = F.gw; r < 32768; r += F.NGW) {
        const int s = r & 255, eb = r >> 8, e = eb >> 3, b = eb & 7;
        const int tk = IDX[(b * 16 + e) * 256 + s];
        const v4u* src = (const v4u*)(H2 + ((size_t)b * 2048 + tk) * 1024) + 2 * F.lane; v4u* dst = (v4u*)(XG + (size_t)r * 1024) + 2 * F.lane;
        const v4u a = src[0], c = src[1]; dst[0] = a; dst[1] = c;
    }
}

__device__ __forceinline__ void p13_phase(Frame& F) {
    const bf16* YB = WSP(bf16, WS_YB); const int* INV = WSP(int, WS_INV); const float* MOD = WSP(float, WS_MOD);
    const int lane = F.lane;
    for (int row = F.gw; row < NLAT; row += F.NGW) {
        const int b = row >> 11;
        const int inv = (lane < 16) ? INV[(size_t)row * 16 + lane] : -1;
        unsigned long long mask = __ballot(inv >= 0);
        float acc[16];
#pragma unroll
        for (int j = 0; j < 16; ++j) acc[j] = 0.f;
        while (mask) { const int e = __builtin_ctzll(mask); mask &= mask - 1; const int slot = __shfl(inv, e);
            const v4u* yr = (const v4u*)(YB + ((size_t)(e * 8 + b) * 256 + slot) * 1024 + 16 * lane);
            const v4u p = yr[0], q = yr[1];
            acc[0] += bflo(p.x); acc[1] += bfhi(p.x); acc[2] += bflo(p.y); acc[3] += bfhi(p.y); acc[4] += bflo(p.z); acc[5] += bfhi(p.z); acc[6] += bflo(p.w); acc[7] += bfhi(p.w);
            acc[8] += bflo(q.x); acc[9] += bfhi(q.x); acc[10] += bflo(q.y); acc[11] += bfhi(q.y); acc[12] += bflo(q.z); acc[13] += bfhi(q.z); acc[14] += bflo(q.w); acc[15] += bfhi(q.w); }
        float* op = F.out + (size_t)row * 1024 + 16 * lane; const float* g2 = MOD + (size_t)b * 6144 + 5120 + 16 * lane;
#pragma unroll
        for (int q = 0; q < 4; ++q) { const f32x4 xv = *(const f32x4*)(op + 4 * q), gv = *(const f32x4*)(g2 + 4 * q);
            *(f32x4*)(op + 4 * q) = xv + gv * (f32x4){acc[4 * q], acc[4 * q + 1], acc[4 * q + 2], acc[4 * q + 3]}; }
    }
}

struct Args { const float* in[20]; float* out; unsigned char* ws; int ph_lo, ph_hi; };
__global__ void __launch_bounds__(512, 2) hyb_fwd(Args args) {
    extern __shared__ __attribute__((aligned(16))) unsigned char lds[];
    Frame F;
    F.lds = (LAS unsigned char*)lds; F.ldsg = lds;
    F.MISC = (volatile LAS unsigned*)(F.lds + MISC_OFF);
    F.tid = threadIdx.x; F.lane = F.tid & 63; F.wave = __builtin_amdgcn_readfirstlane(F.tid >> 6);
    F.G = gridDim.x; F.gw = blockIdx.x * 8 + F.wave; F.NGW = F.G * 8;
    F.ws = args.ws; F.ctl = (gu32*)(args.ws + WS_CTL); F.out = args.out;
    for (int u = F.tid; u < (LDS_BYTES - 131072) / 4; u += 512) ((LAS unsigned*)(F.lds + 131072))[u] = 0u;
    __syncthreads();
    const int lo = args.ph_lo, hi = args.ph_hi;
    XcdBarrier bar; bar.bar = (unsigned*)(F.ctl + CW_BAR); bar.x = 0; bar.st = nullptr;
    if (hi - lo > 1) bar = xcd_barrier_post((unsigned*)(F.ctl + CW_BAR), F.MISC + 8);
    bf16* TW = (bf16*)args.out;
#define IN(k) (lo <= (k) && (k) < hi)
#ifndef PHMASK
#define PHMASK 0xFFFF
#endif
#define PHEN(k) (((PHMASK) >> (k)) & 1)
#define SEAM(k) do { if (IN(k) && IN((k) + 1)) xcd_barrier(bar); } while (0)
    if (IN(0) && PHEN(0)) p0_phase(F, args.in[1], args.in[3], args.in[4], args.in[5], args.in[8], args.in[15]);
    SEAM(0);
    if (IN(1) && PHEN(1)) p1_phase(F, args.in[0], args.in[2], args.in[6], args.in[8], args.in[12], args.in[13]);
    SEAM(1);
    if (IN(2) && PHEN(2)) { pg8::Gemm g{WSP(bf16, WS_XN), WSP(bf16, WS_WIN), MROWS, NIN, 1024}; pg8::SchedIn S{F.G, (int)blockIdx.x}; pg8::EpiIn E{WSP(bf16, WS_PA), WSP(bf16, WS_PD), WSP(bf16, WS_PZ)};
        pg8::gemm_phase<pg8::EpiIn, pg8::SchedIn, true, true>(F.lds, g, S, E); }
    SEAM(2);
    if (IN(3) && PHEN(3)) p3_phase(F, args.in[9], args.in[10], args.in[11]);
    SEAM(3);
    if (IN(4) && PHEN(4)) p4_phase(F, TW);
    SEAM(4);
    if (IN(5) && PHEN(5)) p5_phase(F, TW);
    SEAM(5);
    if (IN(6) && PHEN(6)) p6_phase(F, args.in[14]);
    SEAM(6);
    if (IN(7) && PHEN(7)) { pg8::Gemm g{WSP(bf16, WS_Y), WSP(bf16, WS_WOUT), NLAT, 1024, 1024}; pg8::StaticOrder S; S.init(NLAT, 1024, F.G, (int)blockIdx.x); pg8::EpiOut E{args.in[0], WSP(float, WS_MOD), F.out};
        pg8::gemm_phase<pg8::EpiOut, pg8::StaticOrder, false, true>(F.lds, g, S, E); }
    SEAM(7);
    if (IN(8) && PHEN(8)) p8_phase(F, args.in[7], args.in[16], args.in[17], args.in[18], args.in[19]);
    SEAM(8);
    if (IN(9) && PHEN(9)) p9_phase(F);
    SEAM(9);
    if (IN(10) && PHEN(10)) p10_phase(F);
    SEAM(10);
    if (IN(11) && PHEN(11)) { pg8::Gemm g{WSP(bf16, WS_XG), WSP(bf16, WS_WGU), 32768, 32768, 1024}; pg8::SchedExp<8> S{F.G, (int)blockIdx.x}; pg8::EpiGLU E{WSP(bf16, WS_HID)};
        pg8::gemm_phase<pg8::EpiGLU, pg8::SchedExp<8>, true, true>(F.lds, g, S, E); }
    SEAM(11);
    if (IN(12) && PHEN(12)) { pg8::Gemm g{WSP(bf16, WS_HID), WSP(bf16, WS_WD), 32768, 16384, 1024}; pg8::SchedExp<4> S{F.G, (int)blockIdx.x}; pg8::EpiDown E{WSP(bf16, WS_YB), WSP(float, WS_GATE)};
        pg8::gemm_phase<pg8::EpiDown, pg8::SchedExp<4>, true, true>(F.lds, g, S, E); }
    SEAM(12);
    if (IN(13) && PHEN(13)) p13_phase(F);
#undef IN
#undef SEAM
}

extern "C" void kernel_launch(void* const* d_in, const int* in_sizes, int n_in, void* d_out, int out_size, void* d_ws, size_t ws_size, hipStream_t stream) {
    static int grid = 0;
    if (grid == 0) {
        if (n_in != 20 || out_size != NLAT * 1024 || ws_size < WS_NEED) { fprintf(stderr, "kernel_launch: unexpected problem (n_in %d, out %d, ws %zu < %zu)\n", n_in, out_size, ws_size, (size_t)WS_NEED); grid = -1; return; }
        int dev = 0, cus = 0;
        if (hipGetDevice(&dev) != hipSuccess || hipDeviceGetAttribute(&cus, hipDeviceAttributeMultiprocessorCount, dev) != hipSuccess) { grid = -1; return; }
        if (hipFuncSetAttribute((const void*)hyb_fwd, hipFuncAttributeMaxDynamicSharedMemorySize, LDS_BYTES) != hipSuccess) { fprintf(stderr, "kernel_launch: hipFuncSetAttribute failed\n"); grid = -1; return; }
        (void)hipGetLastError();
        grid = 256;
        if (cus != 256) fprintf(stderr, "kernel_launch: device reports %d CUs; this kernel is built for 256\n", cus);
    }
    if (grid < 0) return;
    (void)hipMemsetAsync((char*)d_ws + WS_CTL, 0, CTL_ZERO_BYTES, stream);
    Args a{};
    for (int i = 0; i < 20; ++i) a.in[i] = (const float*)d_in[i];
    a.out = (float*)d_out; a.ws = (unsigned char*)d_ws;
#if MK_MULTI
    for (int p = 0; p <= NPHASE; ++p) { a.ph_lo = p; a.ph_hi = p + 1; hipLaunchKernelGGL(hyb_fwd, dim3(grid), dim3(512), LDS_BYTES, stream, a); }
#else
    a.ph_lo = 0; a.ph_hi = NPHASE + 1;
    hipLaunchKernelGGL(hyb_fwd, dim3(grid), dim3(512), LDS_BYTES, stream, a);
#endif
}
```

```cpp
#include <hip/hip_runtime.h>
#include <cstdio>
#include <cstdint>
namespace pg8 {
#define PG8_LAS __attribute__((address_space(3)))
typedef unsigned short bf16_t;
typedef short bf16x8 __attribute__((ext_vector_type(8)));
typedef float f32x4 __attribute__((ext_vector_type(4)));
typedef unsigned u32x4 __attribute__((ext_vector_type(4)));
constexpr int BM = 256, BK = 64, HALF = 128, HTB = HALF * BK * 2  , STAGE_BYTES = 8 * HTB, NXCD = 8, WGM = 8;

__host__ __device__ __forceinline__ int lds_byte(int r, int c) { const int st = (r >> 4) * 2 + (c >> 5), rr = r & 15, cc = c & 31, ob = rr * 64 + cc * 2; return st * 1024 + (ob ^ (((ob >> 9) & 1) << 5)); }
__host__ __device__ __forceinline__ void stage_rc(int b, int& R, int& C) { const int st = b / 1024, sb = b % 1024, swz = sb ^ (((sb >> 9) & 1) << 5); R = (st >> 1) * 16 + swz / 64; C = (st & 1) * 32 + (swz % 64) / 2; }
__host__ __device__ __forceinline__ int perm32(int rho) { const int n = rho >> 4, i = rho & 15; return 8 * (i >> 2) + 4 * n + (i & 3); }

struct Unit { int pm, pn; };
struct Gemm { const bf16_t* A; const bf16_t* Bt; int M, N, K; const int* arow; };

struct StaticOrder {
    int nM, nN, nwg, G, c;
    __host__ __device__ void init(int M, int N, int G_, int c_) { nM = M / BM; nN = N / BM; nwg = nM * nN; G = G_; c = c_; }
    __host__ __device__ bool next(int i, Unit& u) const {
        const long L = (long)i * G + c; if (L >= nwg) return false;
        int wgid = (int)L; { const int q = nwg / NXCD, r = nwg % NXCD, xcd = wgid % NXCD, off = wgid / NXCD; wgid = (xcd < r ? xcd * (q + 1) : r * (q + 1) + (xcd - r) * q) + off; }
        const int nig = WGM * nN, gid = wgid / nig, fm = gid * WGM, gsz = (nM - fm) < WGM ? (nM - fm) : WGM;
        u.pm = fm + ((wgid % nig) % gsz); u.pn = (wgid % nig) / gsz; return true;
    }
    __device__ __forceinline__ void a_ready(const Unit&) const {}
    __device__ __forceinline__ void done(const Unit&) const {}
};

__device__ __forceinline__ unsigned cvt_pk_bf16(float lo, float hi) { unsigned r; asm volatile("v_cvt_pk_bf16_f32 %0, %1, %2" : "=v"(r) : "v"(lo), "v"(hi)); return r; }
__device__ __forceinline__ float silu_f(float x) { return x * __builtin_amdgcn_rcpf(1.0f + __expf(-x)); }
struct EpiIn {
    static constexpr bool PERM = true, AFTER_DRAIN = false;
    bf16_t *PA, *PD, *PZ;
    __device__ __forceinline__ void operator()(const f32x4 (&acc)[2][2][4][2], const Unit& u, int wr, int wc, int fr, int fq) const {
        bf16_t* base; int ldc, colt;
        if (u.pn < 3) { base = PA; ldc = 768; colt = u.pn * 256; }
        else if (u.pn < 9) { base = PD; ldc = 1536; colt = (u.pn - 3) * 256; }
        else { base = PZ; ldc = 512; colt = (u.pn - 9) * 256; }
        const int row0 = u.pm * BM + wr * 64 + fr, col0 = colt + wc * 32 + 8 * fq;
#pragma unroll
        for (int ai = 0; ai < 2; ++ai)
#pragma unroll
            for (int m = 0; m < 4; ++m) { bf16_t* rowp = base + (size_t)(row0 + ai * HALF + m * 16) * ldc + col0;
#pragma unroll
                for (int bj = 0; bj < 2; ++bj) { const f32x4 v0 = acc[ai][bj][m][0], v1 = acc[ai][bj][m][1];
                    u32x4 w; w.x = cvt_pk_bf16(v0[0], v0[1]); w.y = cvt_pk_bf16(v0[2], v0[3]); w.z = cvt_pk_bf16(v1[0], v1[1]); w.w = cvt_pk_bf16(v1[2], v1[3]);
                    *(u32x4*)(rowp + bj * HALF) = w; } }
    }
};
struct EpiOut {
    static constexpr bool PERM = true, AFTER_DRAIN = false;
    const float* mod; bf16_t* YL;
    __device__ __forceinline__ void operator()(const f32x4 (&acc)[2][2][4][2], const Unit& u, int wr, int wc, int fr, int fq) const {
        const int row0 = u.pm * BM + wr * 64 + fr, col0 = u.pn * BM + wc * 32 + 8 * fq;
        const float* g1 = mod + (size_t)(u.pm >> 3) * 6144 + 2048;
        f32x4 gv[2][2];
#pragma unroll
        for (int bj = 0; bj < 2; ++bj)
#pragma unroll
            for (int n = 0; n < 2; ++n) gv[bj][n] = *(const f32x4*)(g1 + col0 + bj * HALF + 4 * n);
#pragma unroll
        for (int ai = 0; ai < 2; ++ai)
#pragma unroll
            for (int m = 0; m < 4; ++m) { bf16_t* rowp = YL + (size_t)(row0 + ai * HALF + m * 16) * 1024 + col0;
#pragma unroll
                for (int bj = 0; bj < 2; ++bj) { const f32x4 v0 = acc[ai][bj][m][0] * gv[bj][0], v1 = acc[ai][bj][m][1] * gv[bj][1];
                    u32x4 w; w.x = cvt_pk_bf16(v0[0], v0[1]); w.y = cvt_pk_bf16(v0[2], v0[3]); w.z = cvt_pk_bf16(v1[0], v1[1]); w.w = cvt_pk_bf16(v1[2], v1[3]);
                    *(u32x4*)(rowp + bj * HALF) = w; } }
    }
};
struct EpiGLU {
    static constexpr bool PERM = true, AFTER_DRAIN = false;
    bf16_t* HID;
    __device__ __forceinline__ void operator()(const f32x4 (&acc)[2][2][4][2], const Unit& u, int wr, int wc, int fr, int fq) const {
        const int row0 = u.pm * BM + wr * 64 + fr, col0 = (u.pn & 7) * 128 + wc * 32 + 8 * fq;
#pragma unroll
        for (int ai = 0; ai < 2; ++ai)
#pragma unroll
            for (int m = 0; m < 4; ++m) { bf16_t* rowp = HID + (size_t)(row0 + ai * HALF + m * 16) * 1024 + col0;
                float hv[8];
#pragma unroll
                for (int n = 0; n < 2; ++n)
#pragma unroll
                    for (int j = 0; j < 4; ++j) hv[n * 4 + j] = silu_f(acc[ai][0][m][n][j]) * acc[ai][1][m][n][j];
                u32x4 w; w.x = cvt_pk_bf16(hv[0], hv[1]); w.y = cvt_pk_bf16(hv[2], hv[3]); w.z = cvt_pk_bf16(hv[4], hv[5]); w.w = cvt_pk_bf16(hv[6], hv[7]);
                *(u32x4*)rowp = w; }
    }
};
struct EpiDown {
    static constexpr bool PERM = true, AFTER_DRAIN = false;
    bf16_t* Yb; const float* gatev;
    __device__ __forceinline__ void operator()(const f32x4 (&acc)[2][2][4][2], const Unit& u, int wr, int wc, int fr, int fq) const {
        const int e = u.pm >> 3, b = u.pm & 7;
        const int r0 = wr * 64 + fr, col0 = (u.pn & 3) * 256 + wc * 32 + 8 * fq;
        const float* gp = gatev + (size_t)(b * 16 + e) * 256;
#pragma unroll
        for (int ai = 0; ai < 2; ++ai)
#pragma unroll
            for (int m = 0; m < 4; ++m) { const int s = r0 + ai * HALF + m * 16; const float gt = gp[s];
                bf16_t* rowp = Yb + ((size_t)u.pm * BM + s) * 1024 + col0;
#pragma unroll
                for (int bj = 0; bj < 2; ++bj) { const f32x4 v0 = acc[ai][bj][m][0] * gt, v1 = acc[ai][bj][m][1] * gt;
                    u32x4 w; w.x = cvt_pk_bf16(v0[0], v0[1]); w.y = cvt_pk_bf16(v0[2], v0[3]); w.z = cvt_pk_bf16(v1[0], v1[1]); w.w = cvt_pk_bf16(v1[2], v1[3]);
                    *(u32x4*)(rowp + bj * HALF) = w; } }
    }
};
struct SchedIn {
    int G, c;
    __device__ __forceinline__ bool next(int i, Unit& u) const {
        const int L = i * G + c; if (L >= 760) return false;
        if (L < 704) { StaticOrder S; S.init(16384, 2816, G, c); Unit t; S.next(i, t); u.pm = (t.pm >> 3) * 9 + 1 + (t.pm & 7); u.pn = t.pn; }
        else { const int j = L - 704; u.pm = (j / 7) * 9; u.pn = 2 + (j % 7); }
        return true;
    }
    __device__ __forceinline__ void a_ready(const Unit&) const {}
    __device__ __forceinline__ void done(const Unit&) const {}
};
template <int NPN> struct SchedExp {
    int G, c;
    __device__ __forceinline__ bool next(int i, Unit& u) const {
        const int per = G >> 3, x = c & 7, loc = c >> 3;
        const int uidx = i * per + loc; if (uidx >= 2 * 8 * NPN) return false;
        const int e = x + 8 * (uidx / (8 * NPN)), w = uidx % (8 * NPN);
        u.pm = e * 8 + (w & 7); u.pn = e * NPN + (w >> 3); return true;
    }
    __device__ __forceinline__ void a_ready(const Unit&) const {}
    __device__ __forceinline__ void done(const Unit&) const {}
};
template <class Epi, class Sched, bool ALIGN_EPI = false, bool SP2 = false, bool GATHER = false>
__device__ __forceinline__ void gemm_phase(PG8_LAS unsigned char* lds, const Gemm g, const Sched& S, const Epi& E) {
    const int tid = threadIdx.x, wid = __builtin_amdgcn_readfirstlane(tid >> 6), lane = tid & 63, wr = wid >> 2, wc = wid & 3, fr = lane & 15, fq = lane >> 4;
    const int K = g.K, nt = K / BK;
    unsigned voffA[2], voffB[2];
#pragma unroll
    for (int i = 0; i < 2; ++i) { int R, C; stage_rc(tid * 16 + i * 8192, R, C); const int Rb = Epi::PERM ? ((R & ~31) + perm32(R & 31)) : R;
        voffA[i] = (unsigned)(R * K + C) * 2u; voffB[i] = (unsigned)(Rb * K + C) * 2u; }
    static_assert(!GATHER || SP2, "gather is wired into the SP2 loop only");
    unsigned gA[2][2] = {{0u, 0u}, {0u, 0u}}, gN[2][2] = {{0u, 0u}, {0u, 0u}}; int gR[2] = {0, 0}, gC[2] = {0, 0};
    if constexpr (GATHER) {
#pragma unroll
        for (int i = 0; i < 2; ++i) stage_rc(tid * 16 + i * 8192, gR[i], gC[i]); }
#define PG8_GLOAD(u, dst) do { _Pragma("unroll") for (int h_ = 0; h_ < 2; ++h_) _Pragma("unroll") for (int i_ = 0; i_ < 2; ++i_) \
        dst[h_][i_] = ((unsigned)g.arow[(u).pm * BM + h_ * HALF + gR[i_]] * (unsigned)K + (unsigned)gC[i_]) * 2u; } while (0)
    const size_t kstep = (size_t)(BK * 2);
    const size_t hstep = (size_t)HALF * K * 2;
    const size_t tstep = 2 * hstep;
    const unsigned ldsw = (unsigned)wid * 1024u;
    const int aoff = lds_byte(wr * 64 + fr, fq * 8), boff = lds_byte(wc * 32 + fr, fq * 8);
#define PG8_SA(b, h) (((b) * 2 + (h)) * HTB)
#define PG8_SB(b, h) ((4 + (b) * 2 + (h)) * HTB)
#define PG8_STAGE(bufoff, gbase, voff) do { _Pragma("unroll") for (int _i = 0; _i < 2; ++_i) \
        __builtin_amdgcn_global_load_lds((const unsigned*)((const char*)(gbase) + (voff)[_i]), (PG8_LAS unsigned*)(lds + (bufoff) + ldsw + _i * 8192), 16, 0, 0); } while (0)
#define PG8_LDA(dst, b, h) do { _Pragma("unroll") for (int m = 0; m < 4; ++m) _Pragma("unroll") for (int k = 0; k < 2; ++k) dst[m][k] = *(const PG8_LAS bf16x8*)(lds + PG8_SA(b, h) + aoff + m * 2048 + k * 1024); } while (0)
#define PG8_LDB(dst, b, h) do { _Pragma("unroll") for (int n = 0; n < 2; ++n) _Pragma("unroll") for (int k = 0; k < 2; ++k) dst[n][k] = *(const PG8_LAS bf16x8*)(lds + PG8_SB(b, h) + boff + n * 2048 + k * 1024); } while (0)
#define PG8_MMA(ai, bj, At, Bt) do { __builtin_amdgcn_s_setprio(1); _Pragma("unroll") for (int m = 0; m < 4; ++m) _Pragma("unroll") for (int n = 0; n < 2; ++n) _Pragma("unroll") for (int k = 0; k < 2; ++k) \
        acc[ai][bj][m][n] = __builtin_amdgcn_mfma_f32_16x16x32_bf16(Bt[n][k], At[m][k], acc[ai][bj][m][n], 0, 0, 0); __builtin_amdgcn_s_setprio(0); } while (0)
#define PG8_WAIT_V(n) asm volatile("s_waitcnt vmcnt(" #n ")" ::: "memory")
#define PG8_WAIT_L(n) asm volatile("s_waitcnt lgkmcnt(" #n ")" ::: "memory")
#define PG8_BAR __builtin_amdgcn_s_barrier()
#define PG8_SCHED __builtin_amdgcn_sched_barrier(0)
    Unit cur, nxt; int ui = 0;
    if (!S.next(0, cur)) return;
    f32x4 acc[2][2][4][2];
#pragma unroll
    for (int a = 0; a < 2; ++a)
#pragma unroll
        for (int b = 0; b < 2; ++b)
#pragma unroll
            for (int m = 0; m < 4; ++m)
#pragma unroll
                for (int n = 0; n < 2; ++n) acc[a][b][m][n] = (f32x4){0.f, 0.f, 0.f, 0.f};
    bf16x8 At[4][2], B0[2][2], B1[2][2];
    const char* cA = (const char*)g.A + (GATHER ? (size_t)0 : (size_t)cur.pm * tstep); const char* cB = (const char*)g.Bt + (size_t)cur.pn * tstep;
    S.a_ready(cur);
    if constexpr (GATHER) { PG8_GLOAD(cur, gA); }
    const size_t ahs = GATHER ? (size_t)0 : hstep;
    if constexpr (SP2) {
        PG8_STAGE(PG8_SB(0, 0), cB, voffB); PG8_STAGE(PG8_SB(0, 1), cB + hstep, voffB); PG8_STAGE(PG8_SA(0, 0), cA, (GATHER ? gA[0] : voffA)); PG8_STAGE(PG8_SA(0, 1), cA + ahs, (GATHER ? gA[1] : voffA));
        if (wr == 1) PG8_BAR;
        PG8_WAIT_V(2); PG8_BAR;
        PG8_STAGE(PG8_SB(1, 0), cB + kstep, voffB); PG8_STAGE(PG8_SA(1, 0), cA + kstep, (GATHER ? gA[0] : voffA)); PG8_STAGE(PG8_SB(1, 1), cB + hstep + kstep, voffB);
        PG8_WAIT_V(6); PG8_BAR;
    } else {
        PG8_STAGE(PG8_SB(0, 0), cB, voffB); PG8_STAGE(PG8_SA(0, 0), cA, voffA); PG8_STAGE(PG8_SB(0, 1), cB + hstep, voffB); PG8_STAGE(PG8_SA(0, 1), cA + hstep, voffA);
        if (wr == 1) PG8_BAR;
        PG8_WAIT_V(4); PG8_BAR;
        PG8_STAGE(PG8_SB(1, 0), cB + kstep, voffB); PG8_STAGE(PG8_SA(1, 0), cA + kstep, voffA); PG8_STAGE(PG8_SB(1, 1), cB + hstep + kstep, voffB);
        PG8_WAIT_V(6); PG8_BAR;
    }
    for (;;) {
        const bool has_next = S.next(ui + 1, nxt);
        const char* nA = GATHER ? cA : (has_next ? (const char*)g.A + (size_t)nxt.pm * tstep : cA);
        if constexpr (GATHER) { if (has_next) { PG8_GLOAD(nxt, gN); } else { gN[0][0] = gA[0][0]; gN[0][1] = gA[0][1]; gN[1][0] = gA[1][0]; gN[1][1] = gA[1][1]; } } const char* nB = has_next ? (const char*)g.Bt + (size_t)nxt.pn * tstep : cB;
        for (int t = 0; t < nt; t += 2) {
            const bool last = (t == nt - 2);
            const char* a1 = cA + (size_t)(t + 1) * kstep;
            const char* a2 = last ? nA : cA + (size_t)(t + 2) * kstep; const char* b2 = last ? nB : cB + (size_t)(t + 2) * kstep;
            const char* a3 = a2 + kstep; const char* b3 = b2 + kstep;
            if (last && has_next) S.a_ready(nxt);
            unsigned g2[2][2];
#pragma unroll
            for (int h_ = 0; h_ < 2; ++h_)
#pragma unroll
                for (int i_ = 0; i_ < 2; ++i_) g2[h_][i_] = last ? gN[h_][i_] : gA[h_][i_];
            if constexpr (SP2) {
            PG8_LDB(B0, 0, 0); PG8_LDB(B1, 0, 1); PG8_SCHED; PG8_LDA(At, 0, 0); PG8_STAGE(PG8_SA(1, 1), a1 + ahs, (GATHER ? gA[1] : voffA));
            PG8_WAIT_V(8); PG8_WAIT_L(0); PG8_BAR; PG8_MMA(0, 0, At, B0); PG8_MMA(0, 1, At, B1); PG8_BAR; PG8_SCHED;
            PG8_LDA(At, 0, 1); PG8_STAGE(PG8_SB(0, 0), b2, voffB); PG8_STAGE(PG8_SB(0, 1), b2 + hstep, voffB); PG8_STAGE(PG8_SA(0, 0), a2, (GATHER ? g2[0] : voffA));
            PG8_WAIT_V(8); PG8_WAIT_L(0); PG8_BAR; PG8_MMA(1, 0, At, B0); PG8_MMA(1, 1, At, B1); PG8_BAR; PG8_SCHED;
            PG8_LDB(B0, 1, 0); PG8_LDB(B1, 1, 1); PG8_SCHED; PG8_LDA(At, 1, 0); PG8_STAGE(PG8_SA(0, 1), a2 + ahs, (GATHER ? g2[1] : voffA));
            PG8_WAIT_V(8); PG8_WAIT_L(0); PG8_BAR; PG8_MMA(0, 0, At, B0); PG8_MMA(0, 1, At, B1); PG8_BAR; PG8_SCHED;
            PG8_LDA(At, 1, 1); PG8_STAGE(PG8_SB(1, 0), b3, voffB); PG8_STAGE(PG8_SB(1, 1), b3 + hstep, voffB); PG8_STAGE(PG8_SA(1, 0), a3, (GATHER ? g2[0] : voffA));
            PG8_WAIT_V(8); PG8_WAIT_L(0); PG8_BAR; PG8_MMA(1, 0, At, B0); PG8_MMA(1, 1, At, B1); PG8_BAR; PG8_SCHED;
            } else {
            PG8_LDB(B0, 0, 0); PG8_SCHED; PG8_LDA(At, 0, 0); PG8_STAGE(PG8_SA(1, 1), a1 + hstep, voffA);
            PG8_WAIT_L(8); PG8_BAR; PG8_WAIT_L(0); PG8_MMA(0, 0, At, B0); PG8_BAR; PG8_SCHED;
            PG8_LDB(B1, 0, 1); PG8_STAGE(PG8_SB(0, 0), b2, voffB);
            PG8_BAR; PG8_WAIT_L(0); PG8_MMA(0, 1, At, B1); PG8_BAR;
            PG8_LDA(At, 0, 1); PG8_STAGE(PG8_SA(0, 0), a2, voffA);
            PG8_BAR; PG8_WAIT_L(0); PG8_MMA(1, 0, At, B0); PG8_BAR; PG8_SCHED;
            PG8_STAGE(PG8_SB(0, 1), b2 + hstep, voffB);
            PG8_WAIT_V(6); PG8_BAR; PG8_MMA(1, 1, At, B1); PG8_BAR;
            PG8_LDB(B0, 1, 0); PG8_SCHED; PG8_LDA(At, 1, 0); PG8_STAGE(PG8_SA(0, 1), a2 + hstep, voffA);
            PG8_WAIT_L(8); PG8_BAR; PG8_WAIT_L(0); PG8_MMA(0, 0, At, B0); PG8_BAR; PG8_SCHED;
            PG8_LDB(B1, 1, 1); PG8_STAGE(PG8_SB(1, 0), b3, voffB);
            PG8_BAR; PG8_WAIT_L(0); PG8_MMA(0, 1, At, B1); PG8_BAR;
            PG8_LDA(At, 1, 1); PG8_STAGE(PG8_SA(1, 0), a3, voffA);
            PG8_BAR; PG8_WAIT_L(0); PG8_MMA(1, 0, At, B0); PG8_BAR; PG8_SCHED;
            PG8_STAGE(PG8_SB(1, 1), b3 + hstep, voffB);
            PG8_WAIT_V(6); PG8_BAR; PG8_MMA(1, 1, At, B1); PG8_BAR;
            }
        }
        if constexpr (ALIGN_EPI) { if (wr == 0) PG8_BAR; }
        if constexpr (!Epi::AFTER_DRAIN) { E(acc, cur, wr, wc, fr, fq); S.done(cur); }
        if (!has_next) break;
#pragma unroll
        for (int a = 0; a < 2; ++a)
#pragma unroll
            for (int b = 0; b < 2; ++b)
#pragma unroll
                for (int m = 0; m < 4; ++m)
#pragma unroll
                    for (int n = 0; n < 2; ++n) acc[a][b][m][n] = (f32x4){0.f, 0.f, 0.f, 0.f};
        cur = nxt; cA = nA; cB = nB; ++ui;
        if constexpr (GATHER) { gA[0][0] = gN[0][0]; gA[0][1] = gN[0][1]; gA[1][0] = gN[1][0]; gA[1][1] = gN[1][1]; }
        if constexpr (ALIGN_EPI) { if (wr == 1) PG8_BAR; }
    }
    PG8_WAIT_V(0);
    if constexpr (!ALIGN_EPI) { if (wr == 0) PG8_BAR; }
    PG8_BAR;
    if constexpr (Epi::AFTER_DRAIN) { E.fused(acc, cur, wr, wc, fr, fq, lds, wid, lane); S.done(cur); }
#undef PG8_GLOAD
#undef PG8_SA
#undef PG8_SB
#undef PG8_STAGE
#undef PG8_LDA
#undef PG8_LDB
#undef PG8_MMA
#undef PG8_WAIT_V
#undef PG8_WAIT_L
#undef PG8_BAR
#undef PG8_SCHED
}
}
#include <hip/hip_bf16.h>
#include <cmath>
namespace attn_body {
using bf16=__hip_bfloat16;
using bf16x8=__attribute__((ext_vector_type(8)))short;
using s16x4=__attribute__((ext_vector_type(4)))short;
using f32x16=__attribute__((ext_vector_type(16)))float;
using u32x4=__attribute__((ext_vector_type(4)))unsigned;
constexpr int D=64, QP=768, KVP=768, OP=1024, NTILES=36;
constexpr int NW=8,QBLK=32,QB=QBLK*NW,KVBLK=64;
constexpr int ATTN_UNIT_ROWS=QB;
__device__ __forceinline__ int crow(int r,int hi){return (r&3)+8*(r>>2)+4*hi;}
#define SBAR() __builtin_amdgcn_sched_barrier(0)

constexpr int NSLOT=3, SLOTB=8192;
constexpr int LDS_K=0, LDS_V=NSLOT*SLOTB, LDS_WS=2*NSLOT*SLOTB, LDS_OST=LDS_WS+NW*64*4, LDS_BYTES=LDS_OST+NW*4096;
constexpr float C2=0.125f*1.4426950408889634f;
__device__ __forceinline__ void glds16(const void*gsrc,unsigned lds_dst){unsigned keep;
  asm volatile("s_mov_b32 %0, m0\n\ts_mov_b32 m0, %2\n\ts_nop 0\n\tglobal_load_lds_dwordx4 %1, off\n\ts_mov_b32 m0, %0":"=&s"(keep):"v"(gsrc),"s"(lds_dst):"memory");}
__device__ __forceinline__ float max3f(float a,float b,float c){float r;asm("v_max3_f32 %0, %1, %2, %3":"=v"(r):"v"(a),"v"(b),"v"(c));return r;}
__device__ __forceinline__ float max2f(float a,float b){float r;asm("v_max_f32_e32 %0, %1, %2":"=v"(r):"v"(a),"v"(b));return r;}
__device__ __forceinline__ float fadd_s(float a,float b){float r;asm("v_add_f32_e32 %0, %1, %2":"=v"(r):"v"(a),"v"(b));return r;}
__device__ __forceinline__ float fsub_s(float a,float b){float r;asm("v_sub_f32_e32 %0, %1, %2":"=v"(r):"v"(a),"v"(b));return r;}
typedef float f32x2_t __attribute__((ext_vector_type(2))); typedef __bf16 bf16x2_t __attribute__((ext_vector_type(2)));
__device__ __forceinline__ unsigned cvtpk_s(float lo,float hi){f32x2_t v={lo,hi};bf16x2_t b=__builtin_convertvector(v,bf16x2_t);return __builtin_bit_cast(unsigned,b);}
#define WAIT_BAR(N) asm volatile("s_waitcnt vmcnt(" #N ") lgkmcnt(0)\n\ts_barrier":::"memory")

__device__ __forceinline__ void qkt(f32x16&p0,f32x16&p1,const char*Kslot,const bf16x8*qr,const f32x16&negm,int r32,int hi){
  const char*kb=Kslot+hi*1024+r32*16;
  #pragma unroll
  for(int d0=0;d0<4;++d0){
    const bf16x8 b0=*reinterpret_cast<const bf16x8*>(kb+d0*2048);
    const bf16x8 b1=*reinterpret_cast<const bf16x8*>(kb+d0*2048+512);
    if(d0==0){p0=__builtin_amdgcn_mfma_f32_32x32x16_bf16(b0,qr[0],negm,0,0,0);p1=__builtin_amdgcn_mfma_f32_32x32x16_bf16(b1,qr[0],negm,0,0,0);}
    else{p0=__builtin_amdgcn_mfma_f32_32x32x16_bf16(b0,qr[d0],p0,0,0,0);p1=__builtin_amdgcn_mfma_f32_32x32x16_bf16(b1,qr[d0],p1,0,0,0);}}
}
typedef __attribute__((address_space(3))) const char* lds_cptr;
typedef short v4i16_t __attribute__((ext_vector_type(4)));
__device__ __forceinline__ void kload8(bf16x8*kf,lds_cptr kp){
  kf[0]=*(const __attribute__((address_space(3))) bf16x8*)(kp);      kf[1]=*(const __attribute__((address_space(3))) bf16x8*)(kp+512);
  kf[2]=*(const __attribute__((address_space(3))) bf16x8*)(kp+2048); kf[3]=*(const __attribute__((address_space(3))) bf16x8*)(kp+2560);
  kf[4]=*(const __attribute__((address_space(3))) bf16x8*)(kp+4096); kf[5]=*(const __attribute__((address_space(3))) bf16x8*)(kp+4608);
  kf[6]=*(const __attribute__((address_space(3))) bf16x8*)(kp+6144); kf[7]=*(const __attribute__((address_space(3))) bf16x8*)(kp+6656);
}
__device__ __forceinline__ void kload2(bf16x8*kf,lds_cptr kp,int j){ kf[2*j]=*(const __attribute__((address_space(3))) bf16x8*)(kp+j*2048); kf[2*j+1]=*(const __attribute__((address_space(3))) bf16x8*)(kp+j*2048+512); }
__device__ __forceinline__ s16x4 vtr(lds_cptr p){ return __builtin_bit_cast(s16x4,__builtin_amdgcn_ds_read_tr16_b64_v4i16((__attribute__((address_space(3))) v4i16_t*)p)); }
__device__ __forceinline__ float rowmax(const f32x16&p0,const f32x16&p1){
  float a=max3f(p0[0],p0[1],p1[0]),b=max3f(p0[2],p0[3],p1[1]);a=max3f(a,p1[2],p1[3]);
  #pragma unroll
  for(int r=4;r<16;r+=4){a=max3f(a,p0[r],p0[r+1]);b=max3f(b,p0[r+2],p0[r+3]);a=max3f(a,p1[r],p1[r+1]);b=max3f(b,p1[r+2],p1[r+3]);}
  const float m=max2f(a,b);
  auto rr=__builtin_amdgcn_permlane32_swap(__float_as_uint(m),__float_as_uint(m),false,false);
  return max2f(__uint_as_float(rr[0]),__uint_as_float(rr[1]));
}
__device__ __forceinline__ void pv(f32x16*o,int vb,bf16x8 pa0,bf16x8 pa1,bf16x8 pa2,bf16x8 pa3){
  #pragma unroll
  for(int d0=0;d0<2;++d0){s16x4 lo[4],hi[4];
    #pragma unroll
    for(int ks=0;ks<4;++ks){
      asm volatile("ds_read_b64_tr_b16 %0,%1 offset:%c2":"=&v"(lo[ks]):"v"(vb),"i"(d0*4096+ks*1024):"memory");
      asm volatile("ds_read_b64_tr_b16 %0,%1 offset:%c2":"=&v"(hi[ks]):"v"(vb),"i"(d0*4096+ks*1024+512):"memory");}
    asm volatile("s_waitcnt lgkmcnt(0)":::"memory");SBAR();
    #define PK(k) (bf16x8){lo[k][0],lo[k][1],lo[k][2],lo[k][3],hi[k][0],hi[k][1],hi[k][2],hi[k][3]}
    o[d0]=__builtin_amdgcn_mfma_f32_32x32x16_bf16(pa0,PK(0),o[d0],0,0,0);
    o[d0]=__builtin_amdgcn_mfma_f32_32x32x16_bf16(pa1,PK(1),o[d0],0,0,0);
    o[d0]=__builtin_amdgcn_mfma_f32_32x32x16_bf16(pa2,PK(2),o[d0],0,0,0);
    o[d0]=__builtin_amdgcn_mfma_f32_32x32x16_bf16(pa3,PK(3),o[d0],0,0,0);
    #undef PK
  }
}

#ifndef ATTN_STORE16
#define ATTN_STORE16(p,v) (*(u32x4*)(p)=(v))
#endif
template<int THRL> __device__ __forceinline__ void attn_unit(const bf16*Qw0,const bf16*__restrict__ Kh,const bf16*__restrict__ Vh,bf16*Ow0,char*shm,const float*qnw,const float*RT,int tl0){
  const int tid=threadIdx.x,lane=tid&63,r32=lane&31,hi=lane>>5; const int wid=__builtin_amdgcn_readfirstlane(tid>>6);
  const bf16*Qw=Qw0+(long)wid*QBLK*QP;


  const unsigned lds0=(unsigned)(uintptr_t)shm;
  float*wsf=(float*)(shm+LDS_WS)+wid*64;
  const bf16*ksrc=Kh+(long)lane*KVP+wid*8;
  const bf16*vsrc=Vh+(long)(16*(wid&3)+(lane>>2))*KVP+(wid>>2)*32+(lane&3)*8;
  const unsigned kdst=lds0+LDS_K+wid*1024, vdst=lds0+LDS_V+wid*1024;
  #define DMA_K(t,slot) glds16(ksrc+(long)(t)*KVBLK*KVP,(unsigned)__builtin_amdgcn_readfirstlane(kdst+(slot)))
  #define DMA_V(t,slot) glds16(vsrc+(long)(t)*KVBLK*KVP,(unsigned)__builtin_amdgcn_readfirstlane(vdst+(slot)))
  const int vb0=(int)(lds0+LDS_V)+((lane>>4)&1)*32+(lane&3)*8+(4*hi+((lane&15)>>2))*64;
  const char*Kbase=shm+LDS_K; bf16x8 kf[8];
  const lds_cptr shm3=(lds_cptr)shm; const lds_cptr kp0=shm3+LDS_K+hi*1024+r32*16; const lds_cptr vp0=shm3+LDS_V+((lane>>4)&1)*32+(lane&3)*8+(4*hi+((lane&15)>>2))*64;
  constexpr int NT=NTILES;
  DMA_K(0,0);DMA_V(0,0);DMA_K(1,SLOTB);
  bf16x8 qr[4];
  #pragma unroll
  for(int d0=0;d0<4;++d0)qr[d0]=*reinterpret_cast<const bf16x8*>(&Qw[(long)r32*QP+d0*16+hi*8]);
  { float qf[4][8]; float ss=0.f;
    #pragma unroll
    for(int d0=0;d0<4;++d0){ const u32x4 w=__builtin_bit_cast(u32x4,qr[d0]);
      qf[d0][0]=__uint_as_float(w[0]<<16);qf[d0][1]=__uint_as_float(w[0]&0xffff0000u);qf[d0][2]=__uint_as_float(w[1]<<16);qf[d0][3]=__uint_as_float(w[1]&0xffff0000u);
      qf[d0][4]=__uint_as_float(w[2]<<16);qf[d0][5]=__uint_as_float(w[2]&0xffff0000u);qf[d0][6]=__uint_as_float(w[3]<<16);qf[d0][7]=__uint_as_float(w[3]&0xffff0000u);
      #pragma unroll
      for(int j=0;j<8;++j)ss+=qf[d0][j]*qf[d0][j]; }
    { auto rr=__builtin_amdgcn_permlane32_swap(__float_as_uint(ss),__float_as_uint(ss),false,false); ss=__uint_as_float(rr[0])+__uint_as_float(rr[1]); }
    const float rstd=__builtin_amdgcn_rsqf(ss*(1.0f/64.0f)+1e-6f);
    #pragma unroll
    for(int d0=0;d0<4;++d0){
      #pragma unroll
      for(int j=0;j<8;++j)qf[d0][j]*=rstd*qnw[d0*16+hi*8+j]; }
    const int tl=tl0+wid*QBLK+r32, prow=tl>>6, pcol=tl&63;
    #pragma unroll
    for(int a=0;a<2;++a){ const int pos=a?pcol:prow;
      #pragma unroll
      for(int j=0;j<8;++j){ const float cs=RT[2*(pos*16+hi*8+j)], sn=RT[2*(pos*16+hi*8+j)+1]; const float x1=qf[2*a][j], x2=qf[2*a+1][j];
        qf[2*a][j]=x1*cs-x2*sn; qf[2*a+1][j]=x2*cs+x1*sn; } }
    #pragma unroll
    for(int d0=0;d0<4;++d0){ u32x4 w;
      w[0]=cvtpk_s(qf[d0][0]*C2,qf[d0][1]*C2); w[1]=cvtpk_s(qf[d0][2]*C2,qf[d0][3]*C2); w[2]=cvtpk_s(qf[d0][4]*C2,qf[d0][5]*C2); w[3]=cvtpk_s(qf[d0][6]*C2,qf[d0][7]*C2);
      qr[d0]=__builtin_bit_cast(bf16x8,w); } }
  float mhat=0.f,l_reg=0.f;f32x16 o[2];o[0]=f32x16{};o[1]=f32x16{};f32x16 negm=f32x16{};asm volatile("":"+v"(negm));

  #define CMASK(P0,P1,t) do{}while(0)
  bool resc=false;
  #define START(P0,P1) do{ const float rm=rowmax(P0,P1); resc=false; \
    { const float dl=rm; mhat=fadd_s(mhat,dl); \
      _Pragma("unroll") for(int r=0;r<16;++r){P0[r]=fsub_s(P0[r],dl);P1[r]=fsub_s(P1[r],dl);} \
      _Pragma("unroll") for(int r=0;r<16;++r)negm[r]=-mhat; asm volatile("":"+v"(negm)); } \
    _Pragma("unroll") for(int r=0;r<16;++r)P0[r]=__builtin_amdgcn_exp2f(P0[r]); }while(0)
  #define RESC() do{ if(resc){ asm volatile("s_waitcnt lgkmcnt(0)":::"memory"); \
      _Pragma("unroll") for(int d_=0;d_<2;++d_) _Pragma("unroll") for(int r=0;r<16;++r)o[d_][r]*=wsf[crow(r,hi)]; } }while(0)
  f32x16 pA0,pA1,pB0,pB1;
  int sl_prev=0,sl_cur=0,sl_next=SLOTB;
  #define ROT() do{sl_prev=sl_cur;sl_cur=sl_next;sl_next=(sl_next==(NSLOT-1)*SLOTB)?0:sl_next+SLOTB;}while(0)
  DMA_K(2,2*SLOTB);
  WAIT_BAR(3);
  qkt(pA0,pA1,Kbase,qr,negm,r32,hi);asm volatile("s_nop 15\n\ts_nop 7":"+v"(pA0),"+v"(pA1));CMASK(pA0,pA1,0);
  START(pA0,pA1);
  _Pragma("unroll") for(int r=0;r<16;++r)pA1[r]=__builtin_amdgcn_exp2f(pA1[r]);
  WAIT_BAR(0);
  DMA_K(3,0);DMA_V(1,SLOTB);
  ROT();
  kload8(kf,kp0+sl_cur);
  WAIT_BAR(2);
  s16x4 vlo[8],vhi[8]; u32x4 pw0,pw1,pw2,pw3;
  #define PKW(P,B) cvtpk_s(P[B],P[B+1])
  #define PAF(k) __builtin_bit_cast(bf16x8,pw##k)
  #define VFR(i) (bf16x8){vlo[i][0],vlo[i][1],vlo[i][2],vlo[i][3],vhi[i][0],vhi[i][1],vhi[i][2],vhi[i][3]}
  #define PIN(x) asm volatile("":"+v"(x))
  #define MX3(a,b,c) __builtin_fmaxf(__builtin_fmaxf((a),(b)),(c))
  #define GAPA(MF,A0,A1,A2,A3,W0,W1,PW) do{ MF; sacc+=A0; sacc+=A1; sacc+=A2; sacc+=A3; PIN(sacc); W0; W1; PIN(PW); SBAR(); }while(0)
  #define EX(v) __builtin_amdgcn_exp2f(v)
  #define GAPB(MF,X,B) do{ MF; X[B]=EX(X[B]); X[B+1]=EX(X[B+1]); X[B+2]=EX(X[B+2]); X[B+3]=EX(X[B+3]); PIN(X); SBAR(); }while(0)
  #define VRD(i) do{ vlo[i]=vtr(vp_+(((i)>>2)*4096+((i)&3)*1024)); vhi[i]=vtr(vp_+(((i)>>2)*4096+((i)&3)*1024+512)); }while(0)
  #define KRD(G,j) do{ if(G){ kload2(kf,kp0+sl_next,j); SBAR(); } }while(0)
  #define STEP(C0,C1,P0,P1,t,GK,GV,GL) do{ SBAR(); \
    const lds_cptr vp_=vp0+sl_prev; \
    VRD(0); SBAR(); float sacc=(P0[0]+P0[1]); \
    GAPA(C0=__builtin_amdgcn_mfma_f32_32x32x16_bf16(kf[0],qr[0],negm,0,0,0), P0[2],P0[3],P0[4],P0[5],     pw0[0]=PKW(P0,0), pw0[1]=PKW(P0,2), pw0); \
    VRD(4); SBAR(); GAPA(C1=__builtin_amdgcn_mfma_f32_32x32x16_bf16(kf[1],qr[0],negm,0,0,0), P0[6],P0[7],P0[8],P0[9],     pw0[2]=PKW(P0,4), pw0[3]=PKW(P0,6), pw0); \
    VRD(1); SBAR(); GAPA(C0=__builtin_amdgcn_mfma_f32_32x32x16_bf16(kf[2],qr[1],C0,0,0,0),   P0[10],P0[11],P0[12],P0[13], pw1[0]=PKW(P0,8), pw1[1]=PKW(P0,10), pw1); \
    VRD(5); SBAR(); GAPA(C1=__builtin_amdgcn_mfma_f32_32x32x16_bf16(kf[3],qr[1],C1,0,0,0),   P0[14],P0[15],P1[0],P1[1],   pw1[2]=PKW(P0,12),pw1[3]=PKW(P0,14), pw1); \
    VRD(2); SBAR(); GAPA(C0=__builtin_amdgcn_mfma_f32_32x32x16_bf16(kf[4],qr[2],C0,0,0,0),   P1[2],P1[3],P1[4],P1[5],     pw2[0]=PKW(P1,0), pw2[1]=PKW(P1,2), pw2); \
    VRD(6); SBAR(); GAPA(C1=__builtin_amdgcn_mfma_f32_32x32x16_bf16(kf[5],qr[2],C1,0,0,0),   P1[6],P1[7],P1[8],P1[9],     pw2[2]=PKW(P1,4), pw2[3]=PKW(P1,6), pw2); \
    VRD(3); SBAR(); GAPA(C0=__builtin_amdgcn_mfma_f32_32x32x16_bf16(kf[6],qr[3],C0,0,0,0),   P1[10],P1[11],P1[12],P1[13], pw3[0]=PKW(P1,8), pw3[1]=PKW(P1,10), pw3); \
    VRD(7); SBAR(); GAPA(C1=__builtin_amdgcn_mfma_f32_32x32x16_bf16(kf[7],qr[3],C1,0,0,0),   P1[14],P1[15],0.f,0.f,       pw3[2]=PKW(P1,12),pw3[3]=PKW(P1,14), pw3); \
    l_reg+=sacc; \
    if(GK){DMA_K((t)+3,sl_cur);} if(GV){DMA_V((t)+1,sl_next);} \
    CMASK(C0,C1,t); \
    { float a=MX3(C0[0],C0[1],C1[0]),b=MX3(C0[2],C0[3],C1[1]); a=MX3(a,C1[2],C1[3]); \
      _Pragma("unroll") for(int r=4;r<16;r+=4){a=MX3(a,C0[r],C0[r+1]);b=MX3(b,C0[r+2],C0[r+3]);a=MX3(a,C1[r],C1[r+1]);b=MX3(b,C1[r+2],C1[r+3]);} \
      float rm=__builtin_fmaxf(a,b); { auto rr=__builtin_amdgcn_permlane32_swap(__float_as_uint(rm),__float_as_uint(rm),false,false); rm=__builtin_fmaxf(__uint_as_float(rr[0]),__uint_as_float(rr[1])); } \
      resc=false; \
      if(__builtin_expect(__any(rm>(float)THRL),0)){ const float dl=__builtin_fmaxf(rm,0.f); mhat+=dl; \
        _Pragma("unroll") for(int r=0;r<16;++r){C0[r]-=dl;C1[r]-=dl;} \
        _Pragma("unroll") for(int r=0;r<16;++r)negm[r]=-mhat; asm volatile("":"+v"(negm)); \
        const float f=__builtin_amdgcn_exp2f(-dl); l_reg*=f; if(hi==0)wsf[r32]=f; resc=true; } } \
    SBAR(); \
    GAPB(o[0]=__builtin_amdgcn_mfma_f32_32x32x16_bf16(PAF(0),VFR(0),o[0],0,0,0), C0,0); \
    GAPB(o[1]=__builtin_amdgcn_mfma_f32_32x32x16_bf16(PAF(0),VFR(4),o[1],0,0,0), C0,4); \
    KRD(GL,0); GAPB(o[0]=__builtin_amdgcn_mfma_f32_32x32x16_bf16(PAF(1),VFR(1),o[0],0,0,0), C0,8); \
    KRD(GL,1); GAPB(o[1]=__builtin_amdgcn_mfma_f32_32x32x16_bf16(PAF(1),VFR(5),o[1],0,0,0), C0,12); \
    KRD(GL,2); GAPB(o[0]=__builtin_amdgcn_mfma_f32_32x32x16_bf16(PAF(2),VFR(2),o[0],0,0,0), C1,0); \
    KRD(GL,3); GAPB(o[1]=__builtin_amdgcn_mfma_f32_32x32x16_bf16(PAF(2),VFR(6),o[1],0,0,0), C1,4); \
    GAPB(o[0]=__builtin_amdgcn_mfma_f32_32x32x16_bf16(PAF(3),VFR(3),o[0],0,0,0), C1,8); \
    GAPB(o[1]=__builtin_amdgcn_mfma_f32_32x32x16_bf16(PAF(3),VFR(7),o[1],0,0,0), C1,12); \
    }while(0)
  int t=1;
  #undef CMASK
  #define CMASK(P0,P1,t) do{}while(0)
  for(;t+5<NT;t+=2){
    STEP(pB0,pB1,pA0,pA1,t,true,true,true);     WAIT_BAR(2); RESC(); ROT();
    STEP(pA0,pA1,pB0,pB1,t+1,true,true,true);   WAIT_BAR(2); RESC(); ROT();
  }
  #undef CMASK
  #define CMASK(P0,P1,t) do{}while(0)
  #define ENDW(tt) do{ if((tt)+3<NT){WAIT_BAR(2);} else if((tt)+2<NT){WAIT_BAR(1);} else {WAIT_BAR(0);} }while(0)
  for(;t+1<NT;t+=2){
    STEP(pB0,pB1,pA0,pA1,t,(t+3<NT),(t+1<NT),(t+1<NT));       ENDW(t);   RESC(); ROT();
    STEP(pA0,pA1,pB0,pB1,t+1,(t+4<NT),(t+2<NT),(t+2<NT));     ENDW(t+1); RESC(); ROT();
  }
  STEP(pB0,pB1,pA0,pA1,NT-1,false,false,false); RESC();
  { float sacc=pB0[0]+pB0[1]; _Pragma("unroll") for(int r=2;r<16;++r)sacc+=pB0[r]; _Pragma("unroll") for(int r=0;r<16;++r)sacc+=pB1[r]; l_reg+=sacc;
    pw0=(u32x4){PKW(pB0,0),PKW(pB0,2),PKW(pB0,4),PKW(pB0,6)};pw1=(u32x4){PKW(pB0,8),PKW(pB0,10),PKW(pB0,12),PKW(pB0,14)};pw2=(u32x4){PKW(pB1,0),PKW(pB1,2),PKW(pB1,4),PKW(pB1,6)};pw3=(u32x4){PKW(pB1,8),PKW(pB1,10),PKW(pB1,12),PKW(pB1,14)};
    SBAR(); pv(o,vb0+sl_cur,PAF(0),PAF(1),PAF(2),PAF(3)); }
  #undef PKW
  #undef PAF
  #undef VFR
  #undef PIN
  #undef MX3
  #undef GAPA
  #undef GAPB
  #undef EX
  #undef VRD
  #undef KRD
  #undef STEP
  #undef ENDW
  {auto rr=__builtin_amdgcn_permlane32_swap(__float_as_uint(l_reg),__float_as_uint(l_reg),false,false);l_reg=__uint_as_float(rr[0])+__uint_as_float(rr[1]);}
  if(hi==0)wsf[32+r32]=l_reg;asm volatile("s_waitcnt lgkmcnt(0)":::"memory");
  float rli[16];
  #pragma unroll
  for(int r=0;r<16;++r)rli[r]=__builtin_amdgcn_rcpf(wsf[32+crow(r,hi)]);
  bf16*Ow=Ow0+(long)wid*QBLK*OP;
  { bf16*stg=(bf16*)(shm+LDS_OST)+wid*2048;
    #pragma unroll
    for(int r=0;r<16;++r){const int orow=crow(r,hi);
      #pragma unroll
      for(int d0=0;d0<2;++d0)stg[orow*64+d0*32+r32]=__float2bfloat16(o[d0][r]*rli[r]);}
    asm volatile("s_waitcnt lgkmcnt(0)":::"memory");
    #pragma unroll
    for(int i=0;i<4;++i){const int row=i*8+(lane>>3),ch=lane&7; const u32x4 v=*(const u32x4*)(stg+row*64+ch*8); ATTN_STORE16(Ow+(long)row*OP+ch*8,v);} }
  asm volatile("s_waitcnt lgkmcnt(0)\n\ts_barrier":::"memory");
  #undef DMA_K
  #undef DMA_V
  #undef CMASK
  #undef START
  #undef RESC
  #undef ROT
}
constexpr int ATTN_LDS_BYTES=LDS_BYTES;
#undef SBAR
#undef WAIT_BAR
}
#define GAS __attribute__((address_space(1)))
#define LAS __attribute__((address_space(3)))
typedef unsigned short bf16;
typedef unsigned v4u __attribute__((ext_vector_type(4)));
typedef float f32x4 __attribute__((ext_vector_type(4)));
typedef short bf16x8 __attribute__((ext_vector_type(8)));
typedef GAS unsigned gu32;
typedef GAS unsigned long long gu64;
#define RLX_AGENT __ATOMIC_RELAXED, __HIP_MEMORY_SCOPE_AGENT
#define LDS_WAIT() asm volatile("s_waitcnt lgkmcnt(0)" ::: "memory")
#define VM_WAIT() asm volatile("s_waitcnt vmcnt(0)" ::: "memory")
__device__ __forceinline__ unsigned long long rt() { return __builtin_amdgcn_s_memrealtime(); }
__device__ __forceinline__ unsigned f2bf(float f) { unsigned u = __builtin_bit_cast(unsigned, f); return (u + 0x7fffu + ((u >> 16) & 1u)) >> 16; }
__device__ __forceinline__ unsigned pk2(float lo, float hi) { return f2bf(lo) | (f2bf(hi) << 16); }

#define XB_TMO      128
#define XB_XCNT(j)  (256  + 64 * (j))
#define XB_XSUB(j)  (1280 + 64 * (j))
#define XB_XGEN(j)  (2304 + 64 * (j))
#define XB_TOP      3328
#define XB_TOPGEN   3392
#define XCD_BAR_WORDS 3456
#define XB_SPIN_CAP (1u << 18)

__device__ __forceinline__ unsigned xb_ld(unsigned* p)              { return __hip_atomic_load(p, __ATOMIC_RELAXED, __HIP_MEMORY_SCOPE_AGENT); }
__device__ __forceinline__ unsigned xb_add(unsigned* p, unsigned v) { return __hip_atomic_fetch_add(p, v, __ATOMIC_RELAXED, __HIP_MEMORY_SCOPE_AGENT); }
__device__ __forceinline__ unsigned xb_xcc_id() { return (unsigned)__builtin_amdgcn_s_getreg((3 << 11) | 20) & 0xFu; }
#define XB_SPIN(cond, bar) do { unsigned _sp = 0; while (cond) { __builtin_amdgcn_s_sleep(1); \
    if ((++_sp & 255u) == 0u) { if (xb_ld(&(bar)[XB_TMO])) break; if (_sp > XB_SPIN_CAP) { atomicAdd(&(bar)[XB_TMO], 1u); break; } } } } while (0)

struct XcdBarrier {
    unsigned* bar; unsigned x;
    volatile LAS unsigned* st;
};

__device__ __forceinline__ XcdBarrier xcd_barrier_post(unsigned* bar, volatile LAS unsigned* st) {
    XcdBarrier b; b.bar = bar; b.x = xb_xcc_id(); b.st = st;
    if (threadIdx.x == 0) (void)xb_add(&bar[XB_XCNT(b.x)], 1u);
    return b;
}
__device__ __forceinline__ void xcd_barrier_complete(unsigned* bar, unsigned x, unsigned& nloc, unsigned& nx) {
    const unsigned G = gridDim.x * gridDim.y * gridDim.z;
    unsigned sum, cnt, mine, sp = 0u;
    for (;;) {
        sum = 0u; cnt = 0u; mine = 0u;
#pragma unroll
        for (unsigned j = 0; j < 16; ++j) { const unsigned c = xb_ld(&bar[XB_XCNT(j)]); sum += c; cnt += (c > 0u) ? 1u : 0u; mine = (j == x) ? c : mine; }
        if (sum == G) break;
        __builtin_amdgcn_s_sleep(1);
        if ((++sp & 255u) == 0u) { if (xb_ld(&bar[XB_TMO])) break; if (sp > XB_SPIN_CAP) { atomicAdd(&bar[XB_TMO], 1u); break; } }
    }
    nloc = mine > 0u ? mine : 1u; nx = cnt > 0u ? cnt : 1u;
}

__device__ __forceinline__ void xcd_barrier(const XcdBarrier& b) {
    asm volatile("s_waitcnt vmcnt(0)" ::: "memory");
    __syncthreads();
    if (threadIdx.x == 0) {
        unsigned* bar = b.bar;
        __builtin_amdgcn_s_waitcnt(0);
        unsigned nloc = b.st[0], nx = b.st[1];
        if (nloc == 0u) { xcd_barrier_complete(bar, b.x, nloc, nx); b.st[0] = nloc; b.st[1] = nx; }
        const unsigned old = xb_add(&bar[XB_XSUB(b.x)], 1u);
        const unsigned gen = old / nloc;
        if (old + 1u == (gen + 1u) * nloc) {
            __builtin_amdgcn_fence(__ATOMIC_RELEASE, "agent");
            asm volatile("s_waitcnt vmcnt(0)" ::: "memory");
            const unsigned og = xb_add(&bar[XB_TOP], 1u);
            const unsigned tg = og / nx;
            if (og + 1u == (tg + 1u) * nx) xb_add(&bar[XB_TOPGEN], 1u);
            else XB_SPIN(xb_ld(&bar[XB_TOPGEN]) == tg, bar);
            __builtin_amdgcn_fence(__ATOMIC_ACQUIRE, "agent");
            xb_add(&bar[XB_XGEN(b.x)], 1u);
            asm volatile("s_waitcnt vmcnt(0)" ::: "memory");
        } else {
            XB_SPIN(xb_ld(&bar[XB_XGEN(b.x)]) == gen, bar);
            __builtin_amdgcn_fence(__ATOMIC_ACQUIRE, "agent");
            asm volatile("s_waitcnt vmcnt(0)" ::: "memory");
        }
    }
    __syncthreads();
}
constexpr int NB = 8, SEQL = 2048, CTXL = 256, TOK = 2304, DM_ = 1024, MROWS = NB * TOK, NLAT = NB * SEQL, INW = 2832, NIN = 2816;
constexpr int NPHASE = 9;
#ifndef REP_VAL
#define REP_VAL 1
#endif
#ifndef MK_MULTI
#define MK_MULTI 0
#endif
constexpr size_t MiB = 1u << 20;
constexpr size_t WS_CTL = 0, CTL_ZERO_BYTES = 65536;
constexpr size_t WS_MOD = 1 * MiB;
constexpr size_t WS_ROPE = WS_MOD + 256 * 1024;
constexpr size_t WS_G = 2 * MiB;
constexpr size_t WS_BETA = WS_G + 640 * 1024;
constexpr size_t WS_EG = WS_BETA + 640 * 1024;
constexpr size_t WS_EK = WS_EG + 640 * 1024;
constexpr size_t WS_GLAST = WS_EK + 640 * 1024;
constexpr size_t WS_AFF = 5 * MiB;
constexpr size_t WS_IDX = 6 * MiB;
constexpr size_t WS_GATE = WS_IDX + 256 * 1024;
constexpr size_t WS_XROW = WS_IDX + 512 * 1024;
constexpr size_t WS_INV = 7 * MiB;
constexpr size_t S1 = 8 * MiB;
constexpr size_t WS_XN = S1;
constexpr size_t WS_DQ = WS_XN, WS_DK = WS_XN + 18 * MiB;
constexpr size_t WS_PD = WS_XN + 36 * MiB;

constexpr size_t WS_DKT = WS_PD + 54 * MiB;
constexpr size_t WS_DVT = WS_DKT + 18 * MiB;
constexpr size_t WS_PA = WS_DVT + 18 * MiB;
constexpr size_t WS_PZ = WS_PA + 27 * MiB;
constexpr size_t WS_Y = WS_PZ + 18 * MiB;
constexpr size_t WS_DO = WS_Y + 32 * MiB;
constexpr size_t WS_WIN = WS_DO + 32 * MiB;
constexpr size_t WS_WOUT = WS_WIN + 6 * MiB;
constexpr size_t WS_WU2 = WS_WOUT + 2 * MiB;
constexpr size_t WS_QKD2 = WS_WU2 + 27 * MiB;
constexpr size_t WS_QKD = WS_QKD2;
constexpr size_t WS_END1 = WS_QKD2 + 16 * MiB;
constexpr size_t WS_WGU = S1;
constexpr size_t WS_YB = WS_WGU;
constexpr size_t WS_WD = WS_WGU + 64 * MiB;
constexpr size_t WS_H2 = WS_WD + 32 * MiB;
constexpr size_t WS_XG = WS_H2 + 32 * MiB;
constexpr size_t WS_HID = WS_XG + 64 * MiB;
constexpr size_t WS_END2 = WS_HID + 64 * MiB;
constexpr size_t WS_NEED = WS_END1 > WS_END2 ? WS_END1 : WS_END2;
constexpr int CW_TMO = 0, CW_CODE = 1, CW_ATTNQ = 64, CW_SCAN = 512, CW_P6Q = 576, CW_ROWS = 640, CW_CVQ = 704, CW_CHAIN = 768, CW_BAR = 4096;
constexpr int LDS_BYTES = 147456;
constexpr int MISC_OFF = 146944;

typedef unsigned u32x2 __attribute__((ext_vector_type(2)));
__device__ __forceinline__ float bf2f(unsigned short h) { return __builtin_bit_cast(float, (unsigned)h << 16); }
__device__ __forceinline__ float bflo(unsigned w) { return __builtin_bit_cast(float, w << 16); }
__device__ __forceinline__ float bfhi(unsigned w) { return __builtin_bit_cast(float, w & 0xffff0000u); }
__device__ __forceinline__ float wave_sum(float v) {
    int x = __builtin_bit_cast(int, v);
#define WS_STEP(ctrl, rmask) do { const int t_ = __builtin_amdgcn_update_dpp(0, x, (ctrl), (rmask), 0xf, false); x = __builtin_bit_cast(int, __builtin_bit_cast(float, x) + __builtin_bit_cast(float, t_)); } while (0)
    WS_STEP(0xB1, 0xf);
    WS_STEP(0x4E, 0xf);
    WS_STEP(0x141, 0xf);
    WS_STEP(0x140, 0xf);
    WS_STEP(0x142, 0xa);
    WS_STEP(0x143, 0xc);
#undef WS_STEP
    return __builtin_bit_cast(float, __builtin_amdgcn_readlane(x, 63));
}
__device__ __forceinline__ float dpp_xor1(float v) { return __builtin_bit_cast(float, __builtin_amdgcn_update_dpp(0, __builtin_bit_cast(int, v), 0xB1, 0xf, 0xf, false)); }
__device__ __forceinline__ float dpp_xor2(float v) { return __builtin_bit_cast(float, __builtin_amdgcn_update_dpp(0, __builtin_bit_cast(int, v), 0x4E, 0xf, 0xf, false)); }
__device__ __forceinline__ float row16_sum(float v) {
    v += dpp_xor1(v); v += dpp_xor2(v);
    v += __builtin_bit_cast(float, __builtin_amdgcn_update_dpp(0, __builtin_bit_cast(int, v), 0x141, 0xf, 0xf, false));
    v += __builtin_bit_cast(float, __builtin_amdgcn_update_dpp(0, __builtin_bit_cast(int, v), 0x140, 0xf, 0xf, false));
    return v;
}
__device__ __forceinline__ float reduce16(const float (&a)[16], int lane) {
    float b8[8], b4[4], b2[2];
#pragma unroll
    for (int e = 0; e < 8; ++e) { const float send = (lane & 32) ? a[e] : a[e + 8], keep = (lane & 32) ? a[e + 8] : a[e]; b8[e] = keep + __shfl_xor(send, 32); }
#pragma unroll
    for (int e = 0; e < 4; ++e) { const float send = (lane & 16) ? b8[e] : b8[e + 4], keep = (lane & 16) ? b8[e + 4] : b8[e]; b4[e] = keep + __shfl_xor(send, 16); }
#pragma unroll
    for (int e = 0; e < 2; ++e) { const float send = (lane & 8) ? b4[e] : b4[e + 2], keep = (lane & 8) ? b4[e + 2] : b4[e]; b2[e] = keep + __shfl_xor(send, 8); }
    const float send = (lane & 4) ? b2[0] : b2[1], keep = (lane & 4) ? b2[1] : b2[0];
    float r = keep + __shfl_xor(send, 4);
    r += dpp_xor2(r); r += dpp_xor1(r);
    return r;
}

typedef float f32x2_t __attribute__((ext_vector_type(2))); typedef __bf16 bf16x2_t __attribute__((ext_vector_type(2)));
typedef float f32x16 __attribute__((ext_vector_type(16)));
__device__ __forceinline__ unsigned cvtpk(float lo, float hi) { f32x2_t v = {lo, hi}; bf16x2_t b = __builtin_convertvector(v, bf16x2_t); return __builtin_bit_cast(unsigned, b); }
__device__ __forceinline__ int perm16(int p) { return 8 * ((p >> 2) & 1) + 4 * ((p >> 3) & 1) + (p & 3); }
struct Frame {
    LAS unsigned char* lds; unsigned char* ldsg;
    volatile LAS unsigned* MISC;
    gu32* ctl;
    int tid, lane, wave, G, gw, NGW;
    float* out; unsigned char* ws;
};
#define WSP(T, off) ((T*)(F.ws + (off)))
__device__ __forceinline__ unsigned char* wu_group(Frame& F, int g) { return g < 6 ? F.ws + WS_PD + (size_t)g * 9 * MiB : g < 13 ? (unsigned char*)F.out + (size_t)(g - 6) * 9 * MiB : F.ws + WS_WU2 + (size_t)(g - 13) * 9 * MiB; }

__device__ __forceinline__ void transpose_item(const float* W, int ldw, int k0, int n0, bf16* dst, int K, LAS float* scr, int lane) {
    f32x4 ld[8];
#pragma unroll
    for (int i = 0; i < 8; ++i) ld[i] = *(const f32x4*)(W + (size_t)(k0 + 8 * i + (lane >> 3)) * ldw + n0 + 4 * (lane & 7));
#pragma unroll
    for (int i = 0; i < 8; ++i) { LAS float* d = scr + (8 * i + (lane >> 3)) * 33 + 4 * (lane & 7); d[0] = ld[i].x; d[1] = ld[i].y; d[2] = ld[i].z; d[3] = ld[i].w; }
    LDS_WAIT(); asm volatile("" ::: "memory");
    const int c = lane & 7;
#pragma unroll
    for (int j = 0; j < 4; ++j) { const int n = (lane >> 3) + 8 * j; const LAS float* s = scr + (8 * c) * 33 + n;
        v4u o; o.x = pk2(s[0 * 33], s[1 * 33]); o.y = pk2(s[2 * 33], s[3 * 33]); o.z = pk2(s[4 * 33], s[5 * 33]); o.w = pk2(s[6 * 33], s[7 * 33]);
        *(GAS v4u*)(dst + (size_t)n * K + 8 * c) = o; }
    LDS_WAIT(); asm volatile("" ::: "memory");
}
__device__ __forceinline__ void p0_phase(Frame& F, const float* c_, const float* c_ctx_, const float* w_mod_, const float* b_mod_, const float* w_in_, const float* w_out_) {
    float* MOD = WSP(float, WS_MOD);
    if (blockIdx.x < 192) {
        LAS float* sc = (LAS float*)F.lds;
        LAS float* red = (LAS float*)(F.lds + 36864);
        for (int i = F.tid; i < 9 * 1024; i += 512) { const int r = i >> 10, k = i & 1023; const float v = (r < 8) ? c_[r * 1024 + k] : c_ctx_[k]; sc[i] = v / (1.0f + expf(-v)); }
        __syncthreads();
        const int col = F.tid & 31, kg = F.tid >> 5, n0 = blockIdx.x * 32;
        float acc[9];
#pragma unroll
        for (int r = 0; r < 9; ++r) acc[r] = 0.f;
        const float* wp = w_mod_ + (size_t)kg * 6144 + n0 + col;
#pragma unroll 8
        for (int i = 0; i < 64; ++i) { const float w = wp[(size_t)i * 16 * 6144]; const int k = kg + 16 * i;
#pragma unroll
            for (int r = 0; r < 9; ++r) acc[r] += sc[r * 1024 + k] * w; }
#pragma unroll
        for (int r = 0; r < 9; ++r) red[(kg * 9 + r) * 32 + col] = acc[r];
        __syncthreads();
        if (F.tid < 288) { const int r = F.tid >> 5, cc = F.tid & 31; float s = 0.f;
#pragma unroll
            for (int g2 = 0; g2 < 16; ++g2) s += red[(g2 * 9 + r) * 32 + cc];
            MOD[r * 6144 + n0 + cc] = s + b_mod_[n0 + cc]; }
        __syncthreads();
    } else if (blockIdx.x == 200) {
        float* RT = WSP(float, WS_ROPE);
        for (int i = F.tid; i < 1024; i += 512) { const int pos = i >> 4, fi = i & 15; const float fr = powf(10000.0f, -(float)fi / 16.0f); const float ang = (float)pos * fr;
            RT[2 * i] = cosf(ang); RT[2 * i + 1] = sinf(ang); }
    }
    LAS float* scr = (LAS float*)(F.lds + 57344 + F.wave * 8448);
    bf16* WinT = WSP(bf16, WS_WIN); bf16* WoutT = WSP(bf16, WS_WOUT);
    constexpr int I_IN = 16 * 88, I_OUT = 16 * 32;
    for (int it = F.gw; it < I_IN + I_OUT; it += F.NGW) {
        if (it < I_IN) { const int kb = it / 88, nb = it % 88; transpose_item(w_in_, INW, 64 * kb, 32 * nb, WinT + (size_t)(32 * nb) * 1024 + 64 * kb, 1024, scr, F.lane); }
        else { const int r = it - I_IN, kb = r / 32, nb = r % 32; transpose_item(w_out_, 1024, 64 * kb, 32 * nb, WoutT + (size_t)(32 * nb) * 1024 + 64 * kb, 1024, scr, F.lane); }
    }
}

__device__ __forceinline__ float softplus_f(float x) { return fmaxf(x, 0.f) + __logf(1.0f + __expf(-fabsf(x))); }
__device__ __forceinline__ void p1_row(const f32x4 (&wr0)[32], const f32x4 (&v)[4], int row, int lane, const LAS float* wt, const LAS float* nwl, const LAS float* mdl, bf16* XN, float* Gg, float* Bt, float cA, float cB) {
    const int b = row / TOK, t = row - b * TOK;
    const LAS float* mod = mdl + (t < CTXL ? 8 : b) * 2048;
    float ss = 0.f;
#pragma unroll
    for (int j = 0; j < 4; ++j) ss += (v[j].x * v[j].x + v[j].y * v[j].y) + (v[j].z * v[j].z + v[j].w * v[j].w);
    const float rstd = __builtin_amdgcn_rsqf(wave_sum(ss) * (1.0f / 1024.0f) + 1e-6f);
    f32x4 acc4[4];
#pragma unroll
    for (int e = 0; e < 4; ++e) acc4[e] = (f32x4){0.f, 0.f, 0.f, 0.f};
#pragma unroll
    for (int j = 0; j < 4; ++j) { const int k = 4 * lane + 256 * j;
        const f32x4 nw = *(const LAS f32x4*)(nwl + k), sh = *(const LAS f32x4*)(mod + k), sc = *(const LAS f32x4*)(mod + 1024 + k);
        const f32x4 h = (v[j] * rstd) * nw * (sc + 1.0f) + sh;
        u32x2 w; w.x = cvtpk(h.x, h.y); w.y = cvtpk(h.z, h.w); *(u32x2*)(XN + (size_t)row * 1024 + k) = w;
#pragma unroll
        for (int c = 0; c < 4; ++c) { const float hk = h[c];
            if (j < 2) {
#pragma unroll
                for (int e4 = 0; e4 < 4; ++e4) acc4[e4] += wr0[j * 16 + c * 4 + e4] * hk;
            } else { const LAS f32x4* wp = (const LAS f32x4*)(wt + ((c + 4 * j) * 256 + lane) * 4);
#pragma unroll
                for (int e4 = 0; e4 < 4; ++e4) acc4[e4] += wp[e4 * 64] * hk; } }
        asm volatile("" ::: "memory"); }
    float acc[16];
#pragma unroll
    for (int e = 0; e < 16; ++e) acc[e] = acc4[e >> 2][e & 3];
    const float val = reduce16(acc, lane);
    if ((lane & 3) == 0) { const int e = lane >> 2;
        if (e < 8) { const int dir = e >> 2, hh = e & 3; Bt[(size_t)((dir * 8 + b) * 4 + hh) * TOK + t] = __builtin_amdgcn_rcpf(1.0f + __expf(-val)); }
        else { const int e2 = e - 8, dir = e2 >> 2, hh = e2 & 3; Gg[(size_t)((dir * 8 + b) * 4 + hh) * TOK + t] = cA * softplus_f(val + cB); } }
}
__device__ __forceinline__ void p1_phase(Frame& F, const float* x_, const float* ctx_, const float* norm1_w_, const float* w_in_, const float* a_log_, const float* dt_bias_, int rep) {
    LAS float* wt = (LAS float*)F.lds;
    LAS float* nwl = wt + 16384;
    LAS float* mdl = nwl + 1024;
    const float* MOD = WSP(float, WS_MOD); bf16* XN = WSP(bf16, WS_XN); float* Gg = WSP(float, WS_G); float* Bt = WSP(float, WS_BETA);
    {
        f32x4 tw[8], tm[9], tn;
#pragma unroll
        for (int q = 0; q < 8; ++q) { const int idx = F.tid + 512 * q, k = idx >> 2, e4 = idx & 3; tw[q] = *(const f32x4*)(w_in_ + (size_t)k * INW + NIN + 4 * e4); }
#pragma unroll
        for (int q = 0; q < 9; ++q) { const int idx = F.tid + 512 * q; tm[q] = *(const f32x4*)(MOD + (size_t)(idx >> 9) * 6144 + (idx & 511) * 4); }
        tn = *(const f32x4*)(norm1_w_ + 4 * (F.tid & 255));
#pragma unroll
        for (int q = 0; q < 8; ++q) { const int idx = F.tid + 512 * q, k = idx >> 2, e4 = idx & 3; *(LAS f32x4*)(wt + ((((k & 3) + 4 * (k >> 8)) * 4 + e4) * 64 + ((k & 255) >> 2)) * 4) = tw[q]; }
#pragma unroll
        for (int q = 0; q < 9; ++q) { const int idx = F.tid + 512 * q; *(LAS f32x4*)(mdl + (idx >> 9) * 2048 + (idx & 511) * 4) = tm[q]; }
        if (F.tid < 256) *(LAS f32x4*)(nwl + 4 * F.tid) = tn;
    }
    const int lane = F.lane;
    float cA = 0.f, cB = 0.f;
    { const int e = lane >> 2; if (e >= 8) { cA = -expf(a_log_[e - 8]); cB = dt_bias_[e - 8]; } }
#define P1_SRC(row) ((((row) % TOK) < CTXL) ? ctx_ + (size_t)(((row) / TOK) * CTXL + ((row) % TOK)) * 1024 : x_ + (size_t)(((row) / TOK) * SEQL + ((row) % TOK) - CTXL) * 1024)
#define P1_LOAD(P, row) do { const float* s_ = P1_SRC(row); _Pragma("unroll") for (int j_ = 0; j_ < 4; ++j_) P[j_] = *(const f32x4*)(s_ + 4 * lane + 256 * j_); } while (0)
    f32x4 P0[4], P1[4];
    const int r0 = F.gw, st = F.NGW;
    if (r0 < MROWS) P1_LOAD(P0, r0);
    if (r0 + st < MROWS) P1_LOAD(P1, r0 + st);
    __syncthreads();
    f32x4 wr0[32];
#pragma unroll
    for (int q = 0; q < 32; ++q) wr0[q] = *(const LAS f32x4*)(wt + ((q >> 2) * 256 + (q & 3) * 64 + lane) * 4);
    for (int row = r0; row < MROWS; row += 2 * st) {
        { f32x4 v[4];
#pragma unroll
          for (int j = 0; j < 4; ++j) v[j] = P0[j];
          if (row + 2 * st < MROWS) P1_LOAD(P0, row + 2 * st);
          p1_row(wr0, v, row, lane, wt, nwl, mdl, XN, Gg, Bt, cA, cB); }
        if (row + st < MROWS) { f32x4 v[4];
#pragma unroll
          for (int j = 0; j < 4; ++j) v[j] = P1[j];
          if (row + 3 * st < MROWS) P1_LOAD(P1, row + 3 * st);
          p1_row(wr0, v, row + st, lane, wt, nwl, mdl, XN, Gg, Bt, cA, cB); }
    }
#undef P1_SRC
#undef P1_LOAD
}

__device__ __forceinline__ void qk_prep8(float (&f)[8], const float* nw, bool rope, int prow, int pcol, const float* RT, int c, float scale) {
    float ss = 0.f;
#pragma unroll
    for (int j = 0; j < 8; ++j) ss += f[j] * f[j];
    ss += __shfl_xor(ss, 1); ss += __shfl_xor(ss, 2); ss += __shfl_xor(ss, 4);
    const float rstd = __builtin_amdgcn_rsqf(ss * (1.0f / 64.0f) + 1e-6f);
#pragma unroll
    for (int j = 0; j < 8; ++j) f[j] = f[j] * rstd * nw[8 * c + j];
    const int pos = (c & 4) ? pcol : prow;
#pragma unroll
    for (int j = 0; j < 8; ++j) { const float p = __shfl_xor(f[j], 2);
        if (rope) { const int fi = 8 * (c & 1) + j; const float cs = RT[2 * (pos * 16 + fi)], sn = RT[2 * (pos * 16 + fi) + 1]; f[j] = f[j] * cs + ((c & 2) ? p * sn : -p * sn); } }
#pragma unroll
    for (int j = 0; j < 8; ++j) f[j] *= scale;
}
#define CONV2(i, o0, o1) do { float a0_ = 0.f, a1_ = 0.f; _Pragma("unroll") for (int j_ = 0; j_ < 5; ++j_) { a0_ += bflo(raw[(i) + j_]) * w0[j_]; a1_ += bfhi(raw[(i) + j_]) * w1[j_]; } \
    o0 = a0_ * __builtin_amdgcn_rcpf(1.0f + __expf(-a0_)); o1 = a1_ * __builtin_amdgcn_rcpf(1.0f + __expf(-a1_)); } while (0)
template <int TY> __device__ __forceinline__ void conv_item(Frame& F, int it, const float* conv_w_) {
    const bf16* PD = WSP(bf16, WS_PD); bf16* DQ = WSP(bf16, WS_DQ); bf16* DK = WSP(bf16, WS_DK); bf16* DKT = WSP(bf16, WS_DKT); bf16* DVT = WSP(bf16, WS_DVT);
    LAS bf16* tile = (LAS bf16*)(F.lds + F.wave * 16640);
    const int lane = F.lane;
    const int hh = it & 3, bn = it / 12, n = bn % 36, b = bn / 36;
    const int t0 = 64 * n, lo = (n < 4) ? 0 : CTXL, hi = (n < 4) ? CTXL : TOK;
    const int col = TY * 512 + hh * 128 + 2 * lane;
    float w0[5], w1[5];
#pragma unroll
    for (int j = 0; j < 5; ++j) { w0[j] = conv_w_[j * 1536 + col]; w1[j] = conv_w_[j * 1536 + col + 1]; }
    const bf16* ub = PD + (size_t)(b * TOK) * 1536 + TY * 512 + hh * 128;
    const int lo2 = 2 * lane;
    unsigned raw[68];
#pragma unroll
    for (int i = 0; i < 68; ++i) { const int tt = t0 - 2 + i; const bool ok = (tt >= lo) && (tt < hi); const bf16* rp = ub + (size_t)__builtin_amdgcn_readfirstlane(ok ? tt : t0) * 1536; const unsigned vv = *(const unsigned*)(rp + lo2); raw[i] = ok ? vv : 0u; }
    const int dpos = ((2 * lane) & ~15) | perm16((2 * lane) & 15);
    float scl = 1.0f;
    if (TY < 2) {
        LAS float* sst = (LAS float*)tile;
#pragma unroll
        for (int i = 0; i < 64; ++i) { float a0, a1; CONV2(i, a0, a1); sst[i * 65 + lane] = a0 * a0 + a1 * a1; }
        LDS_WAIT(); asm volatile("" ::: "memory");
        float tot = 0.f;
#pragma unroll
        for (int j = 0; j < 64; ++j) tot += sst[lane * 65 + j];
        LDS_WAIT(); asm volatile("" ::: "memory");
        scl = ((TY == 0) ? 0.08838834764831845f : 1.0f) * __builtin_amdgcn_rsqf(tot + 1e-6f);
    }
#pragma unroll
    for (int i = 0; i < 64; ++i) {
        float a0, a1; CONV2(i, a0, a1);
        if (TY < 2) { const float sc = __builtin_bit_cast(float, __builtin_amdgcn_readlane(__builtin_bit_cast(int, scl), i)); a0 *= sc; a1 *= sc; }
        const unsigned pk = cvtpk(a0, a1);
        if (TY == 0) *(unsigned*)(DQ + ((size_t)(b * 4 + hh) * TOK + t0 + i) * 128 + dpos) = pk;
        if (TY == 1) *(unsigned*)(DK + ((size_t)(b * 4 + hh) * TOK + t0 + i) * 128 + dpos) = pk;
        if (TY >= 1) *(LAS unsigned*)(tile + i * 130 + 2 * lane) = pk;
    }
    if (TY >= 1) {
        LDS_WAIT(); asm volatile("" ::: "memory");
        bf16* dst = (TY == 1 ? DKT : DVT) + (size_t)((b * 4 + hh) * 36 + n) * 8192;
#pragma unroll 4
        for (int q = 0; q < 16; ++q) { const int ch = q * 8 + (lane >> 3), j0 = 8 * (lane & 7); const LAS bf16* s = tile + ((j0 & ~15) + 4 * ((j0 >> 3) & 1)) * 130 + ch;
            v4u o; o.x = (unsigned)s[0] | ((unsigned)s[130] << 16); o.y = (unsigned)s[260] | ((unsigned)s[390] << 16); o.z = (unsigned)s[8 * 130] | ((unsigned)s[9 * 130] << 16); o.w = (unsigned)s[10 * 130] | ((unsigned)s[11 * 130] << 16);
            *(v4u*)(dst + ch * 64 + j0) = o; }
        LDS_WAIT(); asm volatile("" ::: "memory");
    }
}
__device__ __forceinline__ void p3_phase(Frame& F, const float* q_norm_w_, const float* k_norm_w_, const float* conv_w_, int rep) {
    bf16* PA = WSP(bf16, WS_PA); const float* RT = WSP(float, WS_ROPE);
    const int lane = F.lane;
    if (rep == 0 || rep == 2) {
        bf16* PAo = (rep == 2) ? WSP(bf16, WS_DO) : PA;
        LAS float* rtl = (LAS float*)(F.lds + 133120);
        for (int i = F.tid; i < 2048; i += 512) rtl[i] = RT[i];
        __syncthreads();
        for (int idx = blockIdx.x * 512 + F.tid; idx < MROWS * 2; idx += F.G * 512) {
            const int row = idx >> 1, hs = 8 + (idx & 1); const int b_ = row / TOK, t_ = row - b_ * TOK; const bool lat = t_ >= CTXL; const int tl = t_ - CTXL, prow = tl >> 6, pcol = tl & 63;
            bf16* p = PA + (size_t)row * 768 + (hs < 8 ? hs * 64 : 512 + (hs - 8) * 64);
            const float* nw = (hs < 8) ? q_norm_w_ : k_norm_w_;
            float f[64]; float ss = 0.f;
#pragma unroll
            for (int q = 0; q < 8; ++q) { const v4u raw = *(const v4u*)(p + 8 * q);
                f[8 * q] = bflo(raw.x); f[8 * q + 1] = bfhi(raw.x); f[8 * q + 2] = bflo(raw.y); f[8 * q + 3] = bfhi(raw.y); f[8 * q + 4] = bflo(raw.z); f[8 * q + 5] = bfhi(raw.z); f[8 * q + 6] = bflo(raw.w); f[8 * q + 7] = bfhi(raw.w); }
#pragma unroll
            for (int d = 0; d < 64; ++d) ss += f[d] * f[d];
            const float rstd = __builtin_amdgcn_rsqf(ss * (1.0f / 64.0f) + 1e-6f);
#pragma unroll
            for (int q = 0; q < 16; ++q) { const f32x4 w4 = *(const f32x4*)(nw + 4 * q); f[4 * q] *= rstd * w4.x; f[4 * q + 1] *= rstd * w4.y; f[4 * q + 2] *= rstd * w4.z; f[4 * q + 3] *= rstd * w4.w; }
            if (lat) {
#pragma unroll
                for (int a = 0; a < 2; ++a) { const int pos = a ? pcol : prow;
#pragma unroll
                    for (int fi = 0; fi < 16; ++fi) { const f32x2_t cs = *(const LAS f32x2_t*)(rtl + 2 * (pos * 16 + fi)); const float x1 = f[32 * a + fi], x2 = f[32 * a + 16 + fi];
                        f[32 * a + fi] = x1 * cs.x - x2 * cs.y; f[32 * a + 16 + fi] = x2 * cs.x + x1 * cs.y; } }
            }
            const float sc = (hs < 8) ? attn_body::C2 : 1.0f;
#pragma unroll
            for (int q = 0; q < 8; ++q) { v4u o; o.x = cvtpk(f[8 * q] * sc, f[8 * q + 1] * sc); o.y = cvtpk(f[8 * q + 2] * sc, f[8 * q + 3] * sc); o.z = cvtpk(f[8 * q + 4] * sc, f[8 * q + 5] * sc); o.w = cvtpk(f[8 * q + 6] * sc, f[8 * q + 7] * sc);
                *(v4u*)(PAo + (p - PA) + 8 * q) = o; }
        }
    }
    if (rep == 2) return;
    __syncthreads();
    for (int it = F.gw; it < NB * 36 * 12; it += F.NGW) {
        const int ty = (it >> 2) % 3;
        if (ty == 0) conv_item<0>(F, it, conv_w_); else if (ty == 1) conv_item<1>(F, it, conv_w_); else conv_item<2>(F, it, conv_w_);
    }
}

__device__ __forceinline__ f32x4 bmm16(const LAS float* A, const LAS float* B, f32x4 acc, int fr, int fq) {
#pragma unroll
    for (int s = 0; s < 4; ++s) acc = __builtin_amdgcn_mfma_f32_16x16x4f32(A[fr * 68 + 4 * s + fq], B[(4 * s + fq) * 68 + fr], acc, 0, 0, 0);
    return acc;
}
__device__ __forceinline__ void p4_phase(Frame& F) {
    const bf16* DQ = WSP(bf16, WS_DQ); const bf16* DK = WSP(bf16, WS_DK); const bf16* DKT = WSP(bf16, WS_DKT); const bf16* DVT = WSP(bf16, WS_DVT);
    const float* Gg = WSP(float, WS_G); const float* Bt = WSP(float, WS_BETA);
    bf16* QKD = WSP(bf16, WS_QKD);
    float* EG = WSP(float, WS_EG); float* EK = WSP(float, WS_EK); float* GL = WSP(float, WS_GLAST);
    LAS float* M = (LAS float*)(F.lds + F.wave * 17920);
    LAS float* gcv = M + 64 * 68;
    LAS float* btv = gcv + 64;
    const int lane = F.lane, fr = lane & 15, fq = lane >> 4;
    for (int task = F.gw; task < NB * 4 * 36 * 2; task += F.NGW) {
        int dir, n, bh;
        if (task < 2048) { dir = task & 1; n = 4 + ((task >> 1) & 31); bh = task >> 6; }
        else { const int t2 = task - 2048; dir = t2 & 1; n = (t2 >> 1) & 3; bh = t2 >> 3; }
        const int b = bh >> 2, hh = bh & 3;
        const size_t tokbase = (size_t)bh * TOK + 64 * n;
        const bf16* Kc = DK + tokbase * 128; const bf16* Qc = DQ + tokbase * 128;
        const size_t gbase = (size_t)(dir * 32 + bh) * TOK + 64 * n;
        const int rl = dir ? 63 - lane : lane;
        const float gl = Gg[gbase + rl], bl = Bt[gbase + rl];
        float gc = gl;
#pragma unroll
        for (int o = 1; o < 64; o <<= 1) { const float u = __shfl_up(gc, o); if (lane >= o) gc += u; }
        gcv[lane] = gc; btv[lane] = bl;
        const bool outc = n >= 4;
        LDS_WAIT(); asm volatile("" ::: "memory");
        bf16* qkd = QKD + ((size_t)(dir * 32 + bh) * 32 + (n - 4)) * 4096;
        bf16x8 kf[4][4], qfn[4];
#pragma unroll
        for (int rt = 0; rt < 4; ++rt) { const int i = 16 * rt + fr, ro = dir ? 63 - i : i;
#pragma unroll
            for (int ks = 0; ks < 4; ++ks) kf[rt][ks] = *(const bf16x8*)(Kc + ro * 128 + 32 * ks + 8 * fq); }
        { const int ro = dir ? 63 - fr : fr;
#pragma unroll
          for (int ks = 0; ks < 4; ++ks) qfn[ks] = *(const bf16x8*)(Qc + ro * 128 + 32 * ks + 8 * fq); }
#pragma unroll
        for (int rt = 0; rt < 4; ++rt) {
            bf16x8 qfr[4];
#pragma unroll
            for (int ks = 0; ks < 4; ++ks) qfr[ks] = qfn[ks];
            if (rt < 3) { const int i = 16 * (rt + 1) + fr, ro = dir ? 63 - i : i;
#pragma unroll
                for (int ks = 0; ks < 4; ++ks) qfn[ks] = *(const bf16x8*)(Qc + ro * 128 + 32 * ks + 8 * fq); }
#pragma unroll
            for (int ct = 0; ct < 4; ++ct) {
                const int iq = 16 * rt + fr, ioq = dir ? 63 - iq : iq;
                const int j0 = 16 * ct + 4 * fq, jo0 = dir ? 60 - j0 : j0;
                bf16* qdst = qkd + ioq * 64 + (jo0 & ~15) + perm16(jo0 & 15);
                if (ct > rt) { if (outc) *(u32x2*)qdst = (u32x2){0u, 0u}; continue; }
                f32x4 a = {0.f, 0.f, 0.f, 0.f}, q = {0.f, 0.f, 0.f, 0.f};
#pragma unroll
                for (int ks = 0; ks < 4; ++ks) { a = __builtin_amdgcn_mfma_f32_16x16x32_bf16(kf[rt][ks], kf[ct][ks], a, 0, 0, 0); if (outc) q = __builtin_amdgcn_mfma_f32_16x16x32_bf16(kf[ct][ks], qfr[ks], q, 0, 0, 0); }
                const int j = 16 * ct + fr; const float gj = gcv[j];
#pragma unroll
                for (int r = 0; r < 4; ++r) { const int i = 16 * rt + 4 * fq + r; const float dec = __expf(fminf(gcv[i] - gj, 0.f));
                    M[i * 68 + j] = (i > j) ? btv[i] * a[r] * dec : 0.f; }
                if (outc) { const float gi = gcv[iq]; float qv[4];
#pragma unroll
                    for (int r = 0; r < 4; ++r) { const int jj = j0 + r; qv[r] = (iq >= jj) ? q[r] * __expf(fminf(gi - gcv[jj], 0.f)) : 0.f; }
                    u32x2 w; if (dir) { w.x = cvtpk(qv[3], qv[2]); w.y = cvtpk(qv[1], qv[0]); } else { w.x = cvtpk(qv[0], qv[1]); w.y = cvtpk(qv[2], qv[3]); }
                    *(u32x2*)qdst = w; }
            }
        }
        LDS_WAIT(); asm volatile("" ::: "memory");
        {
            const int blk = fq, c = fr;
            float t[16];
            t[0] = (c == 0) ? 1.f : 0.f;
#pragma unroll
            for (int i = 1; i < 16; ++i) {
                const LAS float* rowp = M + (16 * blk + i) * 68 + 16 * blk;
                float acc = 0.f;
#pragma unroll
                for (int j4 = 0; j4 < (i + 3) / 4; ++j4) { const f32x4 av = *(const LAS f32x4*)(rowp + 4 * j4);
#pragma unroll
                    for (int jj = 0; jj < 4; ++jj) if (4 * j4 + jj < i) acc = fmaf(av[jj], t[4 * j4 + jj], acc); }
                t[i] = (c < i) ? -acc : ((c == i) ? 1.f : 0.f);
            }
            LDS_WAIT(); asm volatile("" ::: "memory");
#pragma unroll
            for (int i = 0; i < 16; ++i) M[(16 * blk + i) * 68 + 16 * blk + c] = t[i];
            LDS_WAIT(); asm volatile("" ::: "memory");
        }
#pragma unroll
        for (int k = 0; k < 3; ++k)
#pragma unroll
            for (int i = k + 1; i < 4; ++i) {
                f32x4 x = {0.f, 0.f, 0.f, 0.f};
#pragma unroll
                for (int j = k; j < i; ++j) x = bmm16(M + (16 * i) * 68 + 16 * j, M + (16 * j) * 68 + 16 * k, x, fr, fq);
                LAS float* scr = M + (16 * k) * 68 + 16 * i;
#pragma unroll
                for (int r = 0; r < 4; ++r) scr[(4 * fq + r) * 68 + fr] = x[r];
                LDS_WAIT(); asm volatile("" ::: "memory");
                f32x4 y = bmm16(M + (16 * i) * 68 + 16 * i, scr, (f32x4){0.f, 0.f, 0.f, 0.f}, fr, fq);
                LDS_WAIT(); asm volatile("" ::: "memory");
#pragma unroll
                for (int r = 0; r < 4; ++r) M[(16 * i + 4 * fq + r) * 68 + 16 * k + fr] = -y[r];
                LDS_WAIT(); asm volatile("" ::: "memory");
            }
        const float ej = __expf(gc);
        gcv[lane] = bl * ej;
        LDS_WAIT(); asm volatile("" ::: "memory");
        bf16x8 tuf[4][2], twf[4][2];
#pragma unroll
        for (int it = 0; it < 4; ++it) { const int io = 16 * it + fr, si = dir ? 63 - io : io;
#pragma unroll
            for (int ks = 0; ks < 2; ++ks) { unsigned pu[4], pw[4];
#pragma unroll
                for (int hf = 0; hf < 2; ++hf) { const int t0 = 32 * ks + 16 * (fq >> 1) + 4 * (fq & 1) + 8 * hf;
                    const int cb = dir ? 60 - t0 : t0;
                    const f32x4 tv = *(const LAS f32x4*)(M + si * 68 + cb), cu = *(const LAS f32x4*)(btv + cb), cw = *(const LAS f32x4*)(gcv + cb);
                    float u[4], w[4];
#pragma unroll
                    for (int e = 0; e < 4; ++e) { const int sc = cb + e; const float tt = (sc <= si) ? tv[e] : 0.f; u[e] = tt * cu[e]; w[e] = tt * cw[e]; }
                    if (dir) { pu[2 * hf] = cvtpk(u[3], u[2]); pu[2 * hf + 1] = cvtpk(u[1], u[0]); pw[2 * hf] = cvtpk(w[3], w[2]); pw[2 * hf + 1] = cvtpk(w[1], w[0]); }
                    else { pu[2 * hf] = cvtpk(u[0], u[1]); pu[2 * hf + 1] = cvtpk(u[2], u[3]); pw[2 * hf] = cvtpk(w[0], w[1]); pw[2 * hf + 1] = cvtpk(w[2], w[3]); } }
                tuf[it][ks] = __builtin_bit_cast(bf16x8, (v4u){pu[0], pu[1], pu[2], pu[3]}); twf[it][ks] = __builtin_bit_cast(bf16x8, (v4u){pw[0], pw[1], pw[2], pw[3]}); } }
        unsigned char* grp = wu_group(F, dir * 8 + b);
        bf16* WMg = (bf16*)(grp + (size_t)(hh * 36 + n) * 16384); bf16* UMg = (bf16*)(grp + 4608 * 1024 + (size_t)(hh * 36 + n) * 16384);
        const bf16* KTg = DKT + ((size_t)bh * 36 + n) * 8192; const bf16* VTg = DVT + ((size_t)bh * 36 + n) * 8192;
        {
#pragma unroll
          for (int d4 = 0; d4 < 8; d4 += 4) {
            bf16x8 ktf[4][2];
#pragma unroll
            for (int dt = 0; dt < 4; ++dt) { ktf[dt][0] = *(const bf16x8*)(KTg + (16 * (d4 + dt) + fr) * 64 + 8 * fq); ktf[dt][1] = *(const bf16x8*)(KTg + (16 * (d4 + dt) + fr) * 64 + 32 + 8 * fq); }
#pragma unroll
            for (int dq = 0; dq < 4; ++dq)
#pragma unroll
                for (int it = 0; it < 4; ++it) { const int dt = d4 + dq; f32x4 c = __builtin_amdgcn_mfma_f32_16x16x32_bf16(ktf[dq][0], twf[it][0], (f32x4){0.f, 0.f, 0.f, 0.f}, 0, 0, 0);
                    c = __builtin_amdgcn_mfma_f32_16x16x32_bf16(ktf[dq][1], twf[it][1], c, 0, 0, 0);
                    u32x2 w; w.x = cvtpk(c[0], c[1]); w.y = cvtpk(c[2], c[3]);
                    *(u32x2*)(WMg + (16 * it + fr) * 128 + 16 * dt + perm16(4 * fq)) = w; }
            asm volatile("" ::: "memory");
          }
        }
        {
#pragma unroll
          for (int v4 = 0; v4 < 8; v4 += 4) {
            bf16x8 vtf[4][2];
#pragma unroll
            for (int vt = 0; vt < 4; ++vt) { vtf[vt][0] = *(const bf16x8*)(VTg + (16 * (v4 + vt) + fr) * 64 + 8 * fq); vtf[vt][1] = *(const bf16x8*)(VTg + (16 * (v4 + vt) + fr) * 64 + 32 + 8 * fq); }
#pragma unroll
            for (int vq = 0; vq < 4; ++vq)
#pragma unroll
                for (int it = 0; it < 4; ++it) { const int vt = v4 + vq; f32x4 c = __builtin_amdgcn_mfma_f32_16x16x32_bf16(tuf[it][0], vtf[vq][0], (f32x4){0.f, 0.f, 0.f, 0.f}, 0, 0, 0);
                    c = __builtin_amdgcn_mfma_f32_16x16x32_bf16(tuf[it][1], vtf[vq][1], c, 0, 0, 0);
                    u32x2 w; w.x = cvtpk(c[0], c[1]); w.y = cvtpk(c[2], c[3]);
                    const int q = 2 * (it & 1) + (fq >> 1), h = fq & 1;
                    *(u32x2*)(UMg + (size_t)(((it >> 1) * 4 + (vt >> 1)) * 64 + 32 * h + 16 * (vt & 1) + fr) * 16 + 4 * q) = w; }
            asm volatile("" ::: "memory");
          }
        }
        const float glast = __shfl(gc, 63);
        EG[gbase + rl] = ej; EK[gbase + rl] = __expf(glast - gc);
        if (lane == 0) GL[(size_t)(dir * 32 + bh) * 36 + n] = __expf(glast);
        LDS_WAIT(); asm volatile("" ::: "memory");
    }
}

#define MFMA32(a, b, c) __builtin_amdgcn_mfma_f32_32x32x16_bf16((a), (b), (c), 0, 0, 0)
constexpr int SB_WQ = 0, SB_KT = 34816, SB_QK = 53248, SB_EG = 62464, SB_EK = 62720, SB_BYTES = 62976;
__device__ __forceinline__ bf16x8 pack8(const f32x16& x, int s) {
    v4u p; p.x = cvtpk(x[8 * s], x[8 * s + 1]); p.y = cvtpk(x[8 * s + 2], x[8 * s + 3]); p.z = cvtpk(x[8 * s + 4], x[8 * s + 5]); p.w = cvtpk(x[8 * s + 6], x[8 * s + 7]);
    return __builtin_bit_cast(bf16x8, p);
}
__device__ __forceinline__ void dn_scan(Frame& F, int chain) {
    const int dir = chain & 1, bh = chain >> 1, b = bh >> 2, hh = bh & 3;
    const bf16* DQ = WSP(bf16, WS_DQ); const bf16* DKT = WSP(bf16, WS_DKT); const bf16* QKg = WSP(bf16, WS_QKD);
    const float* EG = WSP(float, WS_EG); const float* EK = WSP(float, WS_EK); const float* GL = WSP(float, WS_GLAST);
    unsigned char* grp = wu_group(F, dir * 8 + b);
    const int tid = F.tid, lane = F.lane, w = F.wave;
#define SCAN_N(step) (((step) < 4) ? (dir ? 3 - (step) : (step)) : (dir ? 39 - (step) : (step)))
    if (w >= 4) {
        const int lt = tid - 256;
        for (int step = -1; step < 35; ++step) {
            const int n = SCAN_N(step + 1); const bool outc = n >= 4;
            LAS unsigned char* B = F.lds + ((step + 1) & 1) * SB_BYTES;
            const bf16* wm = (const bf16*)(grp + (size_t)(hh * 36 + n) * 16384);
            const bf16* qg = DQ + ((size_t)bh * TOK + 64 * n) * 128;
            const bf16* kt = DKT + ((size_t)bh * 36 + n) * 8192;
            const bf16* qk = QKg + ((size_t)(dir * 32 + bh) * 32 + (n - 4)) * 4096;
            v4u rw[4], rq[4], rk[4], rx[2]; float ev = 0.f;
#pragma unroll
            for (int q = 0; q < 4; ++q) { const int p = lt + 256 * q; rw[q] = *(const v4u*)(wm + p * 8); rk[q] = *(const v4u*)(kt + p * 8); if (outc) rq[q] = *(const v4u*)(qg + p * 8); }
            if (outc) {
#pragma unroll
                for (int q = 0; q < 2; ++q) rx[q] = *(const v4u*)(qk + (lt + 256 * q) * 8); }
            if (lt < 64) ev = EG[(size_t)(dir * 32 + bh) * TOK + 64 * n + lt]; else if (lt < 128) ev = EK[(size_t)(dir * 32 + bh) * TOK + 64 * n + lt - 64];
#pragma unroll
            for (int q = 0; q < 4; ++q) { const int p = lt + 256 * q;
                *(LAS v4u*)(B + SB_WQ + (p >> 4) * 272 + (p & 15) * 16) = rw[q];
                *(LAS v4u*)(B + SB_KT + (p >> 3) * 144 + (p & 7) * 16) = rk[q];
                if (outc) *(LAS v4u*)(B + SB_WQ + (64 + (p >> 4)) * 272 + (p & 15) * 16) = rq[q]; }
            if (outc) {
#pragma unroll
                for (int q = 0; q < 2; ++q) { const int p = lt + 256 * q; *(LAS v4u*)(B + SB_QK + (p >> 3) * 144 + (p & 7) * 16) = rx[q]; } }
            if (lt < 128) *(LAS float*)(B + SB_EG + lt * 4) = ev;
            asm volatile("s_waitcnt vmcnt(0) lgkmcnt(0)" ::: "memory");
            __builtin_amdgcn_s_barrier();
            asm volatile("" ::: "memory");
        }
    } else {
        const int r = lane & 31, h = lane >> 5, vs = w;
        bf16* DOb = WSP(bf16, WS_DO) + (size_t)dir * NLAT * 512;
        f32x16 sacc[4]; bf16x8 Sb[8];
#pragma unroll
        for (int q = 0; q < 4; ++q)
#pragma unroll
            for (int e = 0; e < 16; ++e) sacc[q][e] = 0.f;
#pragma unroll
        for (int q = 0; q < 8; ++q) Sb[q] = (bf16x8){0, 0, 0, 0, 0, 0, 0, 0};
        v4u umn[2][2]; float glast_n;
        { const int n0 = SCAN_N(0); const bf16* um = (const bf16*)(grp + 4608 * 1024 + (size_t)(hh * 36 + n0) * 16384);
#pragma unroll
          for (int it = 0; it < 2; ++it) { const v4u* up = (const v4u*)(um + (size_t)((it * 4 + vs) * 64 + lane) * 16); umn[it][0] = up[0]; umn[it][1] = up[1]; }
          glast_n = GL[(size_t)(dir * 32 + bh) * 36 + n0]; }
        for (int step = 0; step < 36; ++step) {
            const int n = SCAN_N(step); const bool outc = n >= 4;
            asm volatile("s_waitcnt lgkmcnt(0)" ::: "memory");
            __builtin_amdgcn_s_barrier();
            asm volatile("" ::: "memory");
            const LAS unsigned char* B = F.lds + (step & 1) * SB_BYTES;
            v4u um[2][2]; um[0][0] = umn[0][0]; um[0][1] = umn[0][1]; um[1][0] = umn[1][0]; um[1][1] = umn[1][1];
            const float glast = glast_n;
            if (step + 1 < 36) { const int n1 = SCAN_N(step + 1); const bf16* umg = (const bf16*)(grp + 4608 * 1024 + (size_t)(hh * 36 + n1) * 16384);
#pragma unroll
                for (int it = 0; it < 2; ++it) { const v4u* up = (const v4u*)(umg + (size_t)((it * 4 + vs) * 64 + lane) * 16); umn[it][0] = up[0]; umn[it][1] = up[1]; }
                glast_n = GL[(size_t)(dir * 32 + bh) * 36 + n1]; }
            bf16x8 Vnb[4], Vsb[4]; f32x16 oacc[2];
#pragma unroll
            for (int it = 0; it < 2; ++it) {
                f32x16 ws;
#pragma unroll
                for (int e = 0; e < 16; ++e) ws[e] = 0.f;
                const LAS unsigned char* ap = B + SB_WQ + (32 * it + r) * 272 + h * 16;
#pragma unroll
                for (int s = 0; s < 8; ++s) ws = MFMA32(*(const LAS bf16x8*)(ap + s * 32), Sb[s], ws);
                f32x16 vn, vsc;
#pragma unroll
                for (int q = 0; q < 2; ++q) { const v4u uu = um[it][q];
                    vn[8 * q + 0] = bflo(uu.x) - ws[8 * q + 0]; vn[8 * q + 1] = bfhi(uu.x) - ws[8 * q + 1]; vn[8 * q + 2] = bflo(uu.y) - ws[8 * q + 2]; vn[8 * q + 3] = bfhi(uu.y) - ws[8 * q + 3];
                    vn[8 * q + 4] = bflo(uu.z) - ws[8 * q + 4]; vn[8 * q + 5] = bfhi(uu.z) - ws[8 * q + 5]; vn[8 * q + 6] = bflo(uu.w) - ws[8 * q + 6]; vn[8 * q + 7] = bfhi(uu.w) - ws[8 * q + 7]; }
#pragma unroll
                for (int q = 0; q < 4; ++q) { const f32x4 ek = *(const LAS f32x4*)(B + SB_EK + (32 * it + 8 * q + 4 * h) * 4);
#pragma unroll
                    for (int e = 0; e < 4; ++e) vsc[4 * q + e] = vn[4 * q + e] * ek[e]; }
                Vnb[2 * it] = pack8(vn, 0); Vnb[2 * it + 1] = pack8(vn, 1); Vsb[2 * it] = pack8(vsc, 0); Vsb[2 * it + 1] = pack8(vsc, 1);
                if (outc) {
                    f32x16 qs;
#pragma unroll
                    for (int e = 0; e < 16; ++e) qs[e] = 0.f;
                    const LAS unsigned char* qp = B + SB_WQ + (64 + 32 * it + r) * 272 + h * 16;
#pragma unroll
                    for (int s = 0; s < 8; ++s) qs = MFMA32(*(const LAS bf16x8*)(qp + s * 32), Sb[s], qs);
#pragma unroll
                    for (int q = 0; q < 4; ++q) { const f32x4 eg = *(const LAS f32x4*)(B + SB_EG + (32 * it + 8 * q + 4 * h) * 4);
#pragma unroll
                        for (int e = 0; e < 4; ++e) oacc[it][4 * q + e] = qs[4 * q + e] * eg[e]; }
                }
            }
            if (outc) {
#pragma unroll
                for (int it = 0; it < 2; ++it) {
                    const LAS unsigned char* ap = B + SB_QK + (32 * it + r) * 144 + h * 16;
#pragma unroll
                    for (int s = 0; s < 4; ++s) oacc[it] = MFMA32(*(const LAS bf16x8*)(ap + s * 32), Vnb[s], oacc[it]);
                    bf16* op = DOb + ((size_t)b * SEQL + 64 * (n - 4) + 32 * it + 4 * h) * 512 + hh * 128 + 32 * vs + r;
#pragma unroll
                    for (int e = 0; e < 16; ++e) op[(size_t)((e & 3) + 8 * (e >> 2)) * 512] = (bf16)(cvtpk(oacc[it][e], 0.f) & 0xffffu);
                }
            }
#pragma unroll
            for (int dt = 0; dt < 4; ++dt) {
#pragma unroll
                for (int e = 0; e < 16; ++e) sacc[dt][e] *= glast;
                const LAS unsigned char* ap = B + SB_KT + (32 * dt + r) * 144 + h * 16;
#pragma unroll
                for (int s = 0; s < 4; ++s) sacc[dt] = MFMA32(*(const LAS bf16x8*)(ap + s * 32), Vsb[s], sacc[dt]);
                Sb[2 * dt] = pack8(sacc[dt], 0); Sb[2 * dt + 1] = pack8(sacc[dt], 1);
            }
        }
    }
#undef SCAN_N
    asm volatile("s_waitcnt vmcnt(0)" ::: "memory");
    __syncthreads();
    if (F.tid == 0) {
        __builtin_amdgcn_fence(__ATOMIC_RELEASE, "agent");
        asm volatile("s_waitcnt vmcnt(0)" ::: "memory");
        (void)__hip_atomic_fetch_add(F.ctl + CW_SCAN, 1u, RLX_AGENT);
    }
}
__device__ __forceinline__ void p6_phase(Frame& F, const float* o_norm_w_, const int rbeg, const int rend, const int rstep);
__device__ __forceinline__ void p5_phase(Frame& F, int rep, const float* qnw_, const float* o_norm_w_) {
    if (blockIdx.x >= 192 && rep != 2) {
        const int chain = (int)blockIdx.x - 192;
        if (F.tid == 0) { unsigned sp = 0u;
            while (__hip_atomic_load(F.ctl + CW_CHAIN + chain, RLX_AGENT) < 36u && ++sp < (1u << 22)) __builtin_amdgcn_s_sleep(4);
            __builtin_amdgcn_fence(__ATOMIC_ACQUIRE, "agent");
            asm volatile("s_waitcnt vmcnt(0)" ::: "memory"); }
        __syncthreads();
        dn_scan(F, chain);
    }
    if (rep == 1) return;
    const attn_body::bf16* PA = (const attn_body::bf16*)WSP(bf16, WS_PA); attn_body::bf16* Y = (attn_body::bf16*)WSP(bf16, WS_Y);
    for (;;) {
        __syncthreads();
        if (F.tid == 0) F.MISC[0] = __hip_atomic_fetch_add(F.ctl + CW_ATTNQ + 64 * rep, 1u, RLX_AGENT);
        __syncthreads();
        const int u = (int)F.MISC[0];
        if (u >= 512) break;
        const int b = u >> 6, hq = (u >> 3) & 7, qb = u & 7;
        attn_body::attn_unit<8>(PA + ((size_t)b * TOK + CTXL + qb * 256) * 768 + hq * 64, PA + (size_t)b * TOK * 768 + 512 + (hq >> 2) * 64, PA + (size_t)b * TOK * 768 + 640 + (hq >> 2) * 64,
                                Y + ((size_t)b * SEQL + qb * 256) * 1024 + hq * 64, (char*)F.ldsg, qnw_, WSP(float, WS_ROPE), qb * 256);
    }
    __syncthreads();
    if (rep != 0) return;
    if (F.tid == 0) { unsigned sp = 0u;
        while (__hip_atomic_load(F.ctl + CW_SCAN, RLX_AGENT) < 64u && ++sp < (1u << 22)) __builtin_amdgcn_s_sleep(4);
        __builtin_amdgcn_fence(__ATOMIC_ACQUIRE, "agent");
        asm volatile("s_waitcnt vmcnt(0)" ::: "memory"); }
    __syncthreads();
    for (;;) {
        __syncthreads();
        if (F.tid == 0) F.MISC[0] = __hip_atomic_fetch_add(F.ctl + CW_P6Q, 1u, RLX_AGENT);
        __syncthreads();
        const int c = (int)F.MISC[0];
        if (c >= NLAT / 64) break;
        p6_phase(F, o_norm_w_, c * 64 + F.wave, c * 64 + 64, 8);
    }
}


__device__ __forceinline__ void p6_phase(Frame& F, const float* o_norm_w_, const int rbeg, const int rend, const int rstep) {
    const bf16* DO = WSP(bf16, WS_DO); const bf16* PZ = WSP(bf16, WS_PZ); bf16* Y = WSP(bf16, WS_Y);
    const int lane = F.lane;
    const int ch = (8 * lane) & 127;
    const f32x4 w0 = *(const f32x4*)(o_norm_w_ + ch), w1 = *(const f32x4*)(o_norm_w_ + ch + 4);
    v4u nr0, nr1, nzr;
    if (rbeg < rend) { const int row = rbeg, b = row >> 11, t = row & 2047; nr0 = *(const v4u*)(DO + (size_t)row * 512 + 8 * lane); nr1 = *(const v4u*)(DO + (size_t)(NLAT + row) * 512 + 8 * lane);
        nzr = *(const v4u*)(PZ + ((size_t)b * TOK + CTXL + t) * 512 + 8 * lane); }
    for (int row = rbeg; row < rend; row += rstep) {
        const v4u r0 = nr0, r1 = nr1, zr = nzr;
        if (row + rstep < rend) { const int row2 = row + rstep, b = row2 >> 11, t = row2 & 2047; nr0 = *(const v4u*)(DO + (size_t)row2 * 512 + 8 * lane); nr1 = *(const v4u*)(DO + (size_t)(NLAT + row2) * 512 + 8 * lane);
            nzr = *(const v4u*)(PZ + ((size_t)b * TOK + CTXL + t) * 512 + 8 * lane); }
        const f32x4 a0 = {bflo(r0.x) + bflo(r1.x), bfhi(r0.x) + bfhi(r1.x), bflo(r0.y) + bflo(r1.y), bfhi(r0.y) + bfhi(r1.y)}, a1 = {bflo(r0.z) + bflo(r1.z), bfhi(r0.z) + bfhi(r1.z), bflo(r0.w) + bflo(r1.w), bfhi(r0.w) + bfhi(r1.w)};
        float ss = (a0.x * a0.x + a0.y * a0.y) + (a0.z * a0.z + a0.w * a0.w) + (a1.x * a1.x + a1.y * a1.y) + (a1.z * a1.z + a1.w * a1.w);
        ss = row16_sum(ss);
        const float rstd = __builtin_amdgcn_rsqf(ss * (1.0f / 128.0f) + 1e-6f);
        const float z[8] = {bflo(zr.x), bfhi(zr.x), bflo(zr.y), bfhi(zr.y), bflo(zr.z), bfhi(zr.z), bflo(zr.w), bfhi(zr.w)};
        float y[8] = {a0.x * rstd * w0.x, a0.y * rstd * w0.y, a0.z * rstd * w0.z, a0.w * rstd * w0.w, a1.x * rstd * w1.x, a1.y * rstd * w1.y, a1.z * rstd * w1.z, a1.w * rstd * w1.w};
#pragma unroll
        for (int j = 0; j < 8; ++j) y[j] *= z[j] / (1.0f + __expf(-z[j]));
        v4u o; o.x = pk2(y[0], y[1]); o.y = pk2(y[2], y[3]); o.z = pk2(y[4], y[5]); o.w = pk2(y[6], y[7]);
        *(v4u*)(Y + (size_t)row * 1024 + 512 + 8 * lane) = o;
    }
}

__device__ __forceinline__ void p9_phase(Frame& F);
__device__ __forceinline__ void p8_row(const f32x4 (&wr0)[16], const f32x4 (&v)[4], int row, int lane, const LAS float* wt, const LAS float* nwl, const LAS float* mdl, bf16* H2, float* AFF) {
    const int b = row >> 11, t = row & 2047;
    const LAS float* mod = mdl + b * 2048;
    float ss = 0.f;
#pragma unroll
    for (int j = 0; j < 4; ++j) ss += (v[j].x * v[j].x + v[j].y * v[j].y) + (v[j].z * v[j].z + v[j].w * v[j].w);
    const float rstd = __builtin_amdgcn_rsqf(wave_sum(ss) * (1.0f / 1024.0f) + 1e-6f);
    f32x4 acc4[4];
#pragma unroll
    for (int e = 0; e < 4; ++e) acc4[e] = (f32x4){0.f, 0.f, 0.f, 0.f};
#pragma unroll
    for (int j = 0; j < 4; ++j) { const int k = 4 * lane + 256 * j;
        const f32x4 nw = *(const LAS f32x4*)(nwl + k), sh = *(const LAS f32x4*)(mod + k), sc = *(const LAS f32x4*)(mod + 1024 + k);
        const f32x4 h = (v[j] * rstd) * nw * (sc + 1.0f) + sh;
        u32x2 w; w.x = cvtpk(h.x, h.y); w.y = cvtpk(h.z, h.w); *(u32x2*)(H2 + (size_t)row * 1024 + k) = w;
#pragma unroll
        for (int c = 0; c < 4; ++c) { const float hk = h[c];
            if (j < 1) {
#pragma unroll
                for (int e4 = 0; e4 < 4; ++e4) acc4[e4] += wr0[c * 4 + e4] * hk;
            } else { const LAS f32x4* wp = (const LAS f32x4*)(wt + ((c + 4 * j) * 256 + lane) * 4);
#pragma unroll
                for (int e4 = 0; e4 < 4; ++e4) acc4[e4] += wp[e4 * 64] * hk; } }
        asm volatile("" ::: "memory"); }
    float acc[16];
#pragma unroll
    for (int e = 0; e < 16; ++e) acc[e] = acc4[e >> 2][e & 3];
    const float val = reduce16(acc, lane);
    float lg[16]; float mx = -3.0e38f;
#pragma unroll
    for (int e = 0; e < 16; ++e) { lg[e] = __shfl(val, e << 2); mx = fmaxf(mx, lg[e]); }
    float sum = 0.f;
#pragma unroll
    for (int e = 0; e < 16; ++e) { lg[e] = __expf(lg[e] - mx); sum += lg[e]; }
    float mine = 0.f;
#pragma unroll
    for (int e = 0; e < 16; ++e) mine = (lane == e) ? lg[e] : mine;
    if (lane < 16) AFF[((size_t)b * 16 + lane) * 2048 + t] = mine / sum;
}
__device__ __forceinline__ void p8_phase(Frame& F, const float* norm2_w_, const float* router_w_, const float* w_gate_, const float* w_up_, const float* w_down_, const float* x_) {
    LAS float* wt = (LAS float*)F.lds;
    LAS float* nwl = wt + 16384;
    LAS float* mdl = nwl + 1024;
    const float* MOD = WSP(float, WS_MOD); bf16* H2 = WSP(bf16, WS_H2); float* AFF = WSP(float, WS_AFF);
    {
        f32x4 tw[8], tm[8], tn;
#pragma unroll
        for (int q = 0; q < 8; ++q) { const int idx = F.tid + 512 * q; tw[q] = *(const f32x4*)(router_w_ + 4 * idx); }
#pragma unroll
        for (int q = 0; q < 8; ++q) { const int idx = F.tid + 512 * q; tm[q] = *(const f32x4*)(MOD + (size_t)(idx >> 9) * 6144 + 3072 + (idx & 511) * 4); }
        tn = *(const f32x4*)(norm2_w_ + 4 * (F.tid & 255));
#pragma unroll
        for (int q = 0; q < 8; ++q) { const int idx = F.tid + 512 * q, k = idx >> 2, e4 = idx & 3; *(LAS f32x4*)(wt + ((((k & 3) + 4 * (k >> 8)) * 4 + e4) * 64 + ((k & 255) >> 2)) * 4) = tw[q]; }
#pragma unroll
        for (int q = 0; q < 8; ++q) { const int idx = F.tid + 512 * q; *(LAS f32x4*)(mdl + (idx >> 9) * 2048 + (idx & 511) * 4) = tm[q]; }
        if (F.tid < 256) *(LAS f32x4*)(nwl + 4 * F.tid) = tn;
    }
    const int lane = F.lane;
    const bf16* YL = WSP(bf16, WS_XG);
#define P8_LOAD(P, row) do { _Pragma("unroll") for (int j_ = 0; j_ < 4; ++j_) P[j_] = *(const f32x4*)(x_ + (size_t)(row) * 1024 + 4 * lane + 256 * j_); } while (0)
#define P8_LOADY(Y, row) do { _Pragma("unroll") for (int j_ = 0; j_ < 4; ++j_) Y[j_] = *(const u32x2*)(YL + (size_t)(row) * 1024 + 4 * lane + 256 * j_); } while (0)
#define P8_ADDY(v, Y) do { _Pragma("unroll") for (int j_ = 0; j_ < 4; ++j_) { v[j_].x += bflo(Y[j_].x); v[j_].y += bfhi(Y[j_].x); v[j_].z += bflo(Y[j_].y); v[j_].w += bfhi(Y[j_].y); } } while (0)
    {
        f32x4 P0[4], P1[4]; u32x2 Y0[4], Y1[4];
        const int r0 = F.gw, st = F.NGW;
        if (r0 < NLAT) { P8_LOAD(P0, r0); P8_LOADY(Y0, r0); }
        if (r0 + st < NLAT) { P8_LOAD(P1, r0 + st); P8_LOADY(Y1, r0 + st); }
        __syncthreads();
        f32x4 wr0[16];
#pragma unroll
        for (int q = 0; q < 16; ++q) wr0[q] = *(const LAS f32x4*)(wt + ((q >> 2) * 256 + (q & 3) * 64 + lane) * 4);
        for (int row = r0; row < NLAT; row += 2 * st) {
            { f32x4 v[4];
#pragma unroll
              for (int j = 0; j < 4; ++j) v[j] = P0[j];
              P8_ADDY(v, Y0);
              if (row + 2 * st < NLAT) { P8_LOAD(P0, row + 2 * st); P8_LOADY(Y0, row + 2 * st); }
              p8_row(wr0, v, row, lane, wt, nwl, mdl, H2, AFF); }
            if (row + st < NLAT) { f32x4 v[4];
#pragma unroll
              for (int j = 0; j < 4; ++j) v[j] = P1[j];
              P8_ADDY(v, Y1);
              if (row + 3 * st < NLAT) { P8_LOAD(P1, row + 3 * st); P8_LOADY(Y1, row + 3 * st); }
              p8_row(wr0, v, row + st, lane, wt, nwl, mdl, H2, AFF); }
        }
    }
#undef P8_LOAD
#undef P8_LOADY
#undef P8_ADDY
    asm volatile("s_waitcnt vmcnt(0)" ::: "memory");
    __syncthreads();
    if (F.tid == 0) {
        __builtin_amdgcn_fence(__ATOMIC_RELEASE, "agent");
        asm volatile("s_waitcnt vmcnt(0)" ::: "memory");
        (void)__hip_atomic_fetch_add(F.ctl + CW_ROWS, 1u, RLX_AGENT);
        if (blockIdx.x < 128) { unsigned sp = 0u;
            while (__hip_atomic_load(F.ctl + CW_ROWS, RLX_AGENT) < (unsigned)F.G && ++sp < (1u << 22)) __builtin_amdgcn_s_sleep(4);
            __builtin_amdgcn_fence(__ATOMIC_ACQUIRE, "agent");
            asm volatile("s_waitcnt vmcnt(0)" ::: "memory"); }
    }
    __syncthreads();
    if (blockIdx.x < 128) p9_phase(F);
    LAS float* scr = (LAS float*)(F.lds + 65536 + F.wave * 8448);
    bf16* WGU = WSP(bf16, WS_WGU); bf16* WD = WSP(bf16, WS_WD);
#ifndef P8_NOCONV
    {
        auto item_src = [&](int it, int& k0, int& n0, bf16*& dst) -> const float* {
            const int ty = it / 8192, r = it % 8192, e = r >> 9, kb = (r & 511) >> 5, nb = r & 31; n0 = 32 * nb; k0 = 64 * kb;
            if (ty == 0) { dst = WGU + ((size_t)e * 2048 + 256 * (n0 >> 7) + (n0 & 127)) * 1024 + k0; return w_gate_ + (size_t)e * 1048576; }
            if (ty == 1) { dst = WGU + ((size_t)e * 2048 + 256 * (n0 >> 7) + 128 + (n0 & 127)) * 1024 + k0; return w_up_ + (size_t)e * 1048576; }
            dst = WD + ((size_t)e * 1024 + n0) * 1024 + k0; return w_down_ + (size_t)e * 1048576; };
        constexpr int NIT = 3 * 16 * 512;
        f32x4 lA[8], lB[8]; const int st = 1;
#define CV_LOAD(L, it_) do { int k_, n_; bf16* d_; const float* W_ = item_src((it_), k_, n_, d_); _Pragma("unroll") for (int i_ = 0; i_ < 8; ++i_) L[i_] = *(const f32x4*)(W_ + (size_t)(k_ + 8 * i_ + (F.lane >> 3)) * 1024 + n_ + 4 * (F.lane & 7)); } while (0)
#define CV_ITEM(L, it_, more_) do { int k0, n0; bf16* dst; (void)item_src((it_), k0, n0, dst); \
            _Pragma("unroll") for (int i_ = 0; i_ < 8; ++i_) { LAS float* d = scr + (8 * i_ + (F.lane >> 3)) * 33 + 4 * (F.lane & 7); d[0] = L[i_].x; d[1] = L[i_].y; d[2] = L[i_].z; d[3] = L[i_].w; } \
            if (more_) CV_LOAD(L, (it_) + 2 * st); \
            LDS_WAIT(); asm volatile("" ::: "memory"); \
            const int c = F.lane & 7; \
            _Pragma("unroll") for (int j = 0; j < 4; ++j) { const int n = (F.lane >> 3) + 8 * j; const LAS float* sp = scr + (8 * c) * 33 + n; \
                v4u o; o.x = cvtpk(sp[0 * 33], sp[1 * 33]); o.y = cvtpk(sp[2 * 33], sp[3 * 33]); o.z = cvtpk(sp[4 * 33], sp[5 * 33]); o.w = cvtpk(sp[6 * 33], sp[7 * 33]); \
                *(GAS v4u*)(dst + (size_t)n * 1024 + 8 * c) = o; } \
            LDS_WAIT(); asm volatile("" ::: "memory"); } while (0)
        const int cnt = (F.gw < 1024) ? 10 : 14, it0 = (F.gw < 1024) ? F.gw * 10 : 10240 + (F.gw - 1024) * 14;
        CV_LOAD(lA, it0); CV_LOAD(lB, it0 + 1);
        for (int q = 0; q < cnt; q += 2) {
            CV_ITEM(lA, it0 + q, q + 2 < cnt);
            CV_ITEM(lB, it0 + q + 1, q + 3 < cnt);
        }
#undef CV_LOAD
#undef CV_ITEM
    }
#endif
}

__device__ __forceinline__ void p9_phase(Frame& F) {
    const float* AFF = WSP(float, WS_AFF); int* IDX = WSP(int, WS_IDX); float* GATE = WSP(float, WS_GATE); int* INV = WSP(int, WS_INV);
    int* XROW = WSP(int, WS_XROW);
    LAS unsigned long long* keys = (LAS unsigned long long*)F.lds;
    for (int be = blockIdx.x; be < 128; be += F.G) {
        const int b = be >> 4, e = be & 15;
        const float* a = AFF + (size_t)be * 2048;
        __syncthreads();
        { float av[4];
#pragma unroll
          for (int q = 0; q < 4; ++q) av[q] = a[F.tid + 512 * q];
#pragma unroll
          for (int q = 0; q < 4; ++q) { const int i = F.tid + 512 * q; keys[i] = ((unsigned long long)__builtin_bit_cast(unsigned, av[q]) << 32) | (unsigned long long)(0xFFFFFFFFu - (unsigned)i); } }
        __syncthreads();
        for (int k = 2; k <= 2048; k <<= 1)
            for (int j = k >> 1; j > 0; j >>= 1) {
#pragma unroll
                for (int q = 0; q < 2; ++q) { const int p = F.tid + 512 * q; const int i = ((p & ~(j - 1)) << 1) | (p & (j - 1)), ix = i | j;
                    const unsigned long long x = keys[i], y = keys[ix]; const bool desc = (i & k) == 0;
                    if ((x < y) == desc) { keys[i] = y; keys[ix] = x; } }
                __syncthreads();
            }
        for (int p = F.tid; p < 2048; p += 512) { const unsigned long long kk = keys[p]; const int tok = (int)(0xFFFFFFFFu - (unsigned)(kk & 0xFFFFFFFFull));
                if (p < 256) { IDX[be * 256 + p] = tok; GATE[be * 256 + p] = __builtin_bit_cast(float, (unsigned)(kk >> 32)); XROW[(e * 8 + b) * 256 + p] = b * 2048 + tok; }
                INV[((size_t)b * 2048 + tok) * 16 + e] = (p < 256) ? p : -1; }
    }
    __syncthreads();
}

#define ACC16(p, q) do { acc[0] += bflo(p.x); acc[1] += bfhi(p.x); acc[2] += bflo(p.y); acc[3] += bfhi(p.y); acc[4] += bflo(p.z); acc[5] += bfhi(p.z); acc[6] += bflo(p.w); acc[7] += bfhi(p.w); \
    acc[8] += bflo(q.x); acc[9] += bfhi(q.x); acc[10] += bflo(q.y); acc[11] += bfhi(q.y); acc[12] += bflo(q.z); acc[13] += bfhi(q.z); acc[14] += bflo(q.w); acc[15] += bfhi(q.w); } while (0)
__device__ __forceinline__ void p13_phase(Frame& F, int rep, const float* x_) {
    const bf16* YB = WSP(bf16, WS_YB); const int* INV = WSP(int, WS_INV); const float* MOD = WSP(float, WS_MOD);
    const int lane = F.lane;
    const bf16* YL = WSP(bf16, WS_XG);
    int ninv = -1; f32x4 nx[4]; v4u ny0 = {0u, 0u, 0u, 0u}, ny1 = ny0;
    if (F.gw < NLAT) { ninv = (lane < 16) ? INV[(size_t)F.gw * 16 + lane] : -1;
#pragma unroll
        for (int q = 0; q < 4; ++q) nx[q] = *(const f32x4*)(x_ + (size_t)F.gw * 1024 + 16 * lane + 4 * q);
        { const v4u* yp = (const v4u*)(YL + (size_t)F.gw * 1024 + 16 * lane); ny0 = yp[0]; ny1 = yp[1]; } }
    for (int row = F.gw; row < NLAT; row += F.NGW) {
        const int b = row >> 11;
        const int inv = ninv; f32x4 xv4[4];
#pragma unroll
        for (int q = 0; q < 4; ++q) xv4[q] = nx[q];
        { const v4u y0 = ny0, y1 = ny1;
          xv4[0] += (f32x4){bflo(y0.x), bfhi(y0.x), bflo(y0.y), bfhi(y0.y)}; xv4[1] += (f32x4){bflo(y0.z), bfhi(y0.z), bflo(y0.w), bfhi(y0.w)};
          xv4[2] += (f32x4){bflo(y1.x), bfhi(y1.x), bflo(y1.y), bfhi(y1.y)}; xv4[3] += (f32x4){bflo(y1.z), bfhi(y1.z), bflo(y1.w), bfhi(y1.w)}; }
        const unsigned long long mask = __ballot(inv >= 0);
        const unsigned long long m1 = mask & (mask - 1), m2 = m1 & (m1 - 1);
        v4u p0 = {0u, 0u, 0u, 0u}, q0 = p0, p1 = p0, q1 = p0;
        if (mask) { const int e = __builtin_ctzll(mask); const int slot = __shfl(inv, e); const v4u* yr = (const v4u*)(YB + ((size_t)(e * 8 + b) * 256 + slot) * 1024 + 16 * lane); p0 = yr[0]; q0 = yr[1]; }
        if (m1) { const int e = __builtin_ctzll(m1); const int slot = __shfl(inv, e); const v4u* yr = (const v4u*)(YB + ((size_t)(e * 8 + b) * 256 + slot) * 1024 + 16 * lane); p1 = yr[0]; q1 = yr[1]; }
        const float* g2 = MOD + (size_t)b * 6144 + 5120 + 16 * lane;
        f32x4 gv[4];
#pragma unroll
        for (int q = 0; q < 4; ++q) gv[q] = *(const f32x4*)(g2 + 4 * q);
        if (row + F.NGW < NLAT) { ninv = (lane < 16) ? INV[(size_t)(row + F.NGW) * 16 + lane] : -1;
#pragma unroll
            for (int q = 0; q < 4; ++q) nx[q] = *(const f32x4*)(x_ + (size_t)(row + F.NGW) * 1024 + 16 * lane + 4 * q);
            { const v4u* yp = (const v4u*)(YL + (size_t)(row + F.NGW) * 1024 + 16 * lane); ny0 = yp[0]; ny1 = yp[1]; } }
        float acc[16];
#pragma unroll
        for (int j = 0; j < 16; ++j) acc[j] = 0.f;
        ACC16(p0, q0); ACC16(p1, q1);
        unsigned long long mm = m2;
        while (mm) { const int e = __builtin_ctzll(mm); mm &= mm - 1; const int slot = __shfl(inv, e);
            const v4u* yr = (const v4u*)(YB + ((size_t)(e * 8 + b) * 256 + slot) * 1024 + 16 * lane);
            const v4u p = yr[0], q = yr[1]; ACC16(p, q); }
        float* op = F.out + (size_t)row * 1024 + 16 * lane;
#pragma unroll
        for (int q = 0; q < 4; ++q) *(f32x4*)(op + 4 * q) = xv4[q] + gv[q] * (f32x4){acc[4 * q], acc[4 * q + 1], acc[4 * q + 2], acc[4 * q + 3]};
    }
}
#undef ACC16

struct Args { const float* in[20]; float* out; unsigned char* ws; int ph_lo, ph_hi, rep, pad; };
__global__ void __launch_bounds__(512, 2) hyb_fwd(Args args) {
    extern __shared__ __attribute__((aligned(16))) unsigned char lds[];
    Frame F;
    F.lds = (LAS unsigned char*)lds; F.ldsg = lds;
    F.MISC = (volatile LAS unsigned*)(F.lds + MISC_OFF);
    F.tid = threadIdx.x; F.lane = F.tid & 63; F.wave = __builtin_amdgcn_readfirstlane(F.tid >> 6);
    F.G = gridDim.x; F.gw = blockIdx.x * 8 + F.wave; F.NGW = F.G * 8;
    F.ws = args.ws; F.ctl = (gu32*)(args.ws + WS_CTL); F.out = args.out;
    for (int u = F.tid; u < (LDS_BYTES - 131072) / 4; u += 512) ((LAS unsigned*)(F.lds + 131072))[u] = 0u;
    __syncthreads();
    const int lo = args.ph_lo, hi = args.ph_hi;
    XcdBarrier bar; bar.bar = (unsigned*)(F.ctl + CW_BAR); bar.x = 0; bar.st = nullptr;
    if (hi - lo > 1) bar = xcd_barrier_post((unsigned*)(F.ctl + CW_BAR), F.MISC + 8);
#define IN(k) (lo <= (k) && (k) < hi)
#ifndef PHMASK
#define PHMASK 0xFFFF
#endif
#define PHEN(k) (((PHMASK) >> (k)) & 1)
#define SEAM(k) do { if (IN(k) && IN((k) + 1)) xcd_barrier(bar); } while (0)
    if (IN(0) && PHEN(0)) p0_phase(F, args.in[1], args.in[3], args.in[4], args.in[5], args.in[8], args.in[15]);
    SEAM(0);
    if (IN(1) && PHEN(1)) p1_phase(F, args.in[0], args.in[2], args.in[6], args.in[8], args.in[12], args.in[13], args.rep);
    SEAM(1);
    if (IN(2) && PHEN(2)) { pg8::Gemm g{WSP(bf16, WS_XN), WSP(bf16, WS_WIN), MROWS, NIN, 1024, nullptr}; pg8::SchedIn S{F.G, (int)blockIdx.x}; pg8::EpiIn E{WSP(bf16, WS_PA), WSP(bf16, WS_PD), WSP(bf16, WS_PZ)};
        pg8::gemm_phase<pg8::EpiIn, pg8::SchedIn, true, true>(F.lds, g, S, E); }
    SEAM(2);
    if (IN(3) && PHEN(3)) p3_phase(F, args.in[9], args.in[10], args.in[11], args.rep);
    SEAM(3);
    if (IN(4) && PHEN(4)) {
        if (args.rep == 0) {
            p4_phase(F);
            asm volatile("s_waitcnt vmcnt(0)" ::: "memory");
            __syncthreads();
            if (F.tid == 0) { __builtin_amdgcn_fence(__ATOMIC_RELEASE, "agent"); asm volatile("s_waitcnt vmcnt(0)" ::: "memory"); }
            __syncthreads();
            if (F.tid < 16) { const int gw = (int)blockIdx.x * 8 + (F.tid & 7);
                if (F.tid < 8) (void)__hip_atomic_fetch_add(F.ctl + CW_CHAIN + (gw >> 6) * 2 + (gw & 1), 1u, RLX_AGENT);
                else if (gw < 256) (void)__hip_atomic_fetch_add(F.ctl + CW_CHAIN + (gw >> 3) * 2 + (gw & 1), 1u, RLX_AGENT); }
        }
        __syncthreads(); p5_phase(F, args.rep, args.in[9], args.in[14]); }
    SEAM(4);
    if (IN(5) && PHEN(5)) { pg8::Gemm g{WSP(bf16, WS_Y), WSP(bf16, WS_WOUT), NLAT, 1024, 1024, nullptr}; pg8::StaticOrder S; S.init(NLAT, 1024, F.G, (int)blockIdx.x); pg8::EpiOut E{WSP(float, WS_MOD), WSP(bf16, WS_XG)};
        pg8::gemm_phase<pg8::EpiOut, pg8::StaticOrder, false, true>(F.lds, g, S, E); }
    SEAM(5);
    if (IN(6) && PHEN(6)) p8_phase(F, args.in[7], args.in[16], args.in[17], args.in[18], args.in[19], args.in[0]);
    SEAM(6);
    if (IN(7) && PHEN(7)) { pg8::Gemm g{WSP(bf16, WS_H2), WSP(bf16, WS_WGU), 32768, 32768, 1024, WSP(int, WS_XROW)}; pg8::SchedExp<8> S{F.G, (int)blockIdx.x}; pg8::EpiGLU E{WSP(bf16, WS_HID)};
        pg8::gemm_phase<pg8::EpiGLU, pg8::SchedExp<8>, true, true, true>(F.lds, g, S, E); }
    SEAM(7);
    if (IN(8) && PHEN(8)) { pg8::Gemm g{WSP(bf16, WS_HID), WSP(bf16, WS_WD), 32768, 16384, 1024, nullptr}; pg8::SchedExp<4> S{F.G, (int)blockIdx.x}; pg8::EpiDown E{WSP(bf16, WS_YB), WSP(float, WS_GATE)};
        pg8::gemm_phase<pg8::EpiDown, pg8::SchedExp<4>, true, true>(F.lds, g, S, E); }
    SEAM(8);
    if (IN(9) && PHEN(9)) p13_phase(F, args.rep, args.in[0]);
#undef IN
#undef SEAM
}

extern "C" void kernel_launch(void* const* d_in, const int* in_sizes, int n_in, void* d_out, int out_size, void* d_ws, size_t ws_size, hipStream_t stream) {
    static int grid = 0;
    if (grid == 0) {
        if (n_in != 20 || out_size != NLAT * 1024 || ws_size < WS_NEED) { fprintf(stderr, "kernel_launch: unexpected problem (n_in %d, out %d, ws %zu < %zu)\n", n_in, out_size, ws_size, (size_t)WS_NEED); grid = -1; return; }
        int dev = 0, cus = 0;
        if (hipGetDevice(&dev) != hipSuccess || hipDeviceGetAttribute(&cus, hipDeviceAttributeMultiprocessorCount, dev) != hipSuccess) { grid = -1; return; }
        if (hipFuncSetAttribute((const void*)hyb_fwd, hipFuncAttributeMaxDynamicSharedMemorySize, LDS_BYTES) != hipSuccess) { fprintf(stderr, "kernel_launch: hipFuncSetAttribute failed\n"); grid = -1; return; }
        (void)hipGetLastError();
        grid = 256;
        if (cus != 256) fprintf(stderr, "kernel_launch: device reports %d CUs; this kernel is built for 256\n", cus);
    }
    if (grid < 0) return;
    (void)hipMemsetAsync((char*)d_ws + WS_CTL, 0, CTL_ZERO_BYTES, stream);
    Args a{};
    for (int i = 0; i < 20; ++i) a.in[i] = (const float*)d_in[i];
    a.out = (float*)d_out; a.ws = (unsigned char*)d_ws;
#if MK_MULTI
    for (int p = 0; p <= NPHASE; ++p) { a.ph_lo = p; a.ph_hi = p + 1; a.rep = 0; hipLaunchKernelGGL(hyb_fwd, dim3(grid), dim3(512), LDS_BYTES, stream, a);
#ifdef REP_PHASE
        if (p == REP_PHASE) { a.rep = REP_VAL; hipLaunchKernelGGL(hyb_fwd, dim3(grid), dim3(512), LDS_BYTES, stream, a); }
#endif
    }
#else
    a.ph_lo = 0; a.ph_hi = NPHASE + 1;
    hipLaunchKernelGGL(hyb_fwd, dim3(grid), dim3(512), LDS_BYTES, stream, a);
#endif
}
```

```cpp
#include <hip/hip_runtime.h>
#include <cstdio>
#include <cstdint>
namespace pg8 {
#define PG8_LAS __attribute__((address_space(3)))
typedef unsigned short bf16_t;
typedef short bf16x8 __attribute__((ext_vector_type(8)));
typedef float f32x4 __attribute__((ext_vector_type(4)));
typedef unsigned u32x4 __attribute__((ext_vector_type(4)));
constexpr int BM = 256, BK = 64, HALF = 128, HTB = HALF * BK * 2  , STAGE_BYTES = 8 * HTB, NXCD = 8, WGM = 8;

__host__ __device__ __forceinline__ int lds_byte(int r, int c) { const int st = (r >> 4) * 2 + (c >> 5), rr = r & 15, cc = c & 31, ob = rr * 64 + cc * 2; return st * 1024 + (ob ^ (((ob >> 9) & 1) << 5)); }
__host__ __device__ __forceinline__ void stage_rc(int b, int& R, int& C) { const int st = b / 1024, sb = b % 1024, swz = sb ^ (((sb >> 9) & 1) << 5); R = (st >> 1) * 16 + swz / 64; C = (st & 1) * 32 + (swz % 64) / 2; }
__host__ __device__ __forceinline__ int perm32(int rho) { const int n = rho >> 4, i = rho & 15; return 8 * (i >> 2) + 4 * n + (i & 3); }

struct Unit { int pm, pn; };
struct Gemm { const bf16_t* A; const bf16_t* Bt; int M, N, K; const int* arow; };

struct StaticOrder {
    int nM, nN, nwg, G, c;
    __host__ __device__ void init(int M, int N, int G_, int c_) { nM = M / BM; nN = N / BM; nwg = nM * nN; G = G_; c = c_; }
    __host__ __device__ bool next(int i, Unit& u) const {
        const long L = (long)i * G + c; if (L >= nwg) return false;
        int wgid = (int)L; { const int q = nwg / NXCD, r = nwg % NXCD, xcd = wgid % NXCD, off = wgid / NXCD; wgid = (xcd < r ? xcd * (q + 1) : r * (q + 1) + (xcd - r) * q) + off; }
        const int nig = WGM * nN, gid = wgid / nig, fm = gid * WGM, gsz = (nM - fm) < WGM ? (nM - fm) : WGM;
        u.pm = fm + ((wgid % nig) % gsz); u.pn = (wgid % nig) / gsz; return true;
    }
    __device__ __forceinline__ void a_ready(const Unit&) const {}
    __device__ __forceinline__ void done(const Unit&) const {}
};

__device__ __forceinline__ unsigned cvt_pk_bf16(float lo, float hi) { unsigned r; asm volatile("v_cvt_pk_bf16_f32 %0, %1, %2" : "=v"(r) : "v"(lo), "v"(hi)); return r; }
__device__ __forceinline__ float silu_f(float x) { return x * __builtin_amdgcn_rcpf(1.0f + __expf(-x)); }
struct EpiIn {
    static constexpr bool PERM = true, AFTER_DRAIN = false;
    bf16_t *PA, *PD, *PZ;
    __device__ __forceinline__ void operator()(const f32x4 (&acc)[2][2][4][2], const Unit& u, int wr, int wc, int fr, int fq) const {
        bf16_t* base; int ldc, colt;
        if (u.pn < 3) { base = PA; ldc = 768; colt = u.pn * 256; }
        else if (u.pn < 9) { base = PD; ldc = 1536; colt = (u.pn - 3) * 256; }
        else { base = PZ; ldc = 512; colt = (u.pn - 9) * 256; }
        const int row0 = u.pm * BM + wr * 64 + fr, col0 = colt + wc * 32 + 8 * fq;
#pragma unroll
        for (int ai = 0; ai < 2; ++ai)
#pragma unroll
            for (int m = 0; m < 4; ++m) { bf16_t* rowp = base + (size_t)(row0 + ai * HALF + m * 16) * ldc + col0;
#pragma unroll
                for (int bj = 0; bj < 2; ++bj) { const f32x4 v0 = acc[ai][bj][m][0], v1 = acc[ai][bj][m][1];
                    u32x4 w; w.x = cvt_pk_bf16(v0[0], v0[1]); w.y = cvt_pk_bf16(v0[2], v0[3]); w.z = cvt_pk_bf16(v1[0], v1[1]); w.w = cvt_pk_bf16(v1[2], v1[3]);
                    *(u32x4*)(rowp + bj * HALF) = w; } }
    }
};
struct EpiOut {
    static constexpr bool PERM = true, AFTER_DRAIN = false;
    const float* mod; bf16_t* YL;
    __device__ __forceinline__ void operator()(const f32x4 (&acc)[2][2][4][2], const Unit& u, int wr, int wc, int fr, int fq) const {
        const int row0 = u.pm * BM + wr * 64 + fr, col0 = u.pn * BM + wc * 32 + 8 * fq;
        const float* g1 = mod + (size_t)(u.pm >> 3) * 6144 + 2048;
        f32x4 gv[2][2];
#pragma unroll
        for (int bj = 0; bj < 2; ++bj)
#pragma unroll
            for (int n = 0; n < 2; ++n) gv[bj][n] = *(const f32x4*)(g1 + col0 + bj * HALF + 4 * n);
#pragma unroll
        for (int ai = 0; ai < 2; ++ai)
#pragma unroll
            for (int m = 0; m < 4; ++m) { bf16_t* rowp = YL + (size_t)(row0 + ai * HALF + m * 16) * 1024 + col0;
#pragma unroll
                for (int bj = 0; bj < 2; ++bj) { const f32x4 v0 = acc[ai][bj][m][0] * gv[bj][0], v1 = acc[ai][bj][m][1] * gv[bj][1];
                    u32x4 w; w.x = cvt_pk_bf16(v0[0], v0[1]); w.y = cvt_pk_bf16(v0[2], v0[3]); w.z = cvt_pk_bf16(v1[0], v1[1]); w.w = cvt_pk_bf16(v1[2], v1[3]);
                    *(u32x4*)(rowp + bj * HALF) = w; } }
    }
};
struct EpiGLU {
    static constexpr bool PERM = true, AFTER_DRAIN = false;
    bf16_t* HID;
    __device__ __forceinline__ void operator()(const f32x4 (&acc)[2][2][4][2], const Unit& u, int wr, int wc, int fr, int fq) const {
        const int row0 = u.pm * BM + wr * 64 + fr, col0 = (u.pn & 7) * 128 + wc * 32 + 8 * fq;
#pragma unroll
        for (int ai = 0; ai < 2; ++ai)
#pragma unroll
            for (int m = 0; m < 4; ++m) { bf16_t* rowp = HID + (size_t)(row0 + ai * HALF + m * 16) * 1024 + col0;
                float hv[8];
#pragma unroll
                for (int n = 0; n < 2; ++n)
#pragma unroll
                    for (int j = 0; j < 4; ++j) hv[n * 4 + j] = silu_f(acc[ai][0][m][n][j]) * acc[ai][1][m][n][j];
                u32x4 w; w.x = cvt_pk_bf16(hv[0], hv[1]); w.y = cvt_pk_bf16(hv[2], hv[3]); w.z = cvt_pk_bf16(hv[4], hv[5]); w.w = cvt_pk_bf16(hv[6], hv[7]);
                *(u32x4*)rowp = w; }
    }
};
struct EpiDown {
    static constexpr bool PERM = true, AFTER_DRAIN = false;
    bf16_t* Yb; const float* gatev;
    __device__ __forceinline__ void operator()(const f32x4 (&acc)[2][2][4][2], const Unit& u, int wr, int wc, int fr, int fq) const {
        const int e = u.pm >> 3, b = u.pm & 7;
        const int r0 = wr * 64 + fr, col0 = (u.pn & 3) * 256 + wc * 32 + 8 * fq;
        const float* gp = gatev + (size_t)(b * 16 + e) * 256;
#pragma unroll
        for (int ai = 0; ai < 2; ++ai)
#pragma unroll
            for (int m = 0; m < 4; ++m) { const int s = r0 + ai * HALF + m * 16; const float gt = gp[s];
                bf16_t* rowp = Yb + ((size_t)u.pm * BM + s) * 1024 + col0;
#pragma unroll
                for (int bj = 0; bj < 2; ++bj) { const f32x4 v0 = acc[ai][bj][m][0] * gt, v1 = acc[ai][bj][m][1] * gt;
                    u32x4 w; w.x = cvt_pk_bf16(v0[0], v0[1]); w.y = cvt_pk_bf16(v0[2], v0[3]); w.z = cvt_pk_bf16(v1[0], v1[1]); w.w = cvt_pk_bf16(v1[2], v1[3]);
                    *(u32x4*)(rowp + bj * HALF) = w; } }
    }
};
struct SchedIn {
    int G, c;
    __device__ __forceinline__ bool next(int i, Unit& u) const {
        const int L = i * G + c; if (L >= 760) return false;
        if (L < 704) { StaticOrder S; S.init(16384, 2816, G, c); Unit t; S.next(i, t); u.pm = (t.pm >> 3) * 9 + 1 + (t.pm & 7); u.pn = t.pn; }
        else { const int j = L - 704; u.pm = (j / 7) * 9; u.pn = 2 + (j % 7); }
        return true;
    }
    __device__ __forceinline__ void a_ready(const Unit&) const {}
    __device__ __forceinline__ void done(const Unit&) const {}
};
template <int NPN> struct SchedExp {
    int G, c;
    __device__ __forceinline__ bool next(int i, Unit& u) const {
        const int per = G >> 3, x = c & 7, loc = c >> 3;
        const int uidx = i * per + loc; if (uidx >= 2 * 8 * NPN) return false;
        const int e = x + 8 * (uidx / (8 * NPN)), w = uidx % (8 * NPN);
        u.pm = e * 8 + (w & 7); u.pn = e * NPN + (w >> 3); return true;
    }
    __device__ __forceinline__ void a_ready(const Unit&) const {}
    __device__ __forceinline__ void done(const Unit&) const {}
};
template <class Epi, class Sched, bool ALIGN_EPI = false, bool SP2 = false, bool GATHER = false>
__device__ __forceinline__ void gemm_phase(PG8_LAS unsigned char* lds, const Gemm g, const Sched& S, const Epi& E) {
    const int tid = threadIdx.x, wid = __builtin_amdgcn_readfirstlane(tid >> 6), lane = tid & 63, wr = wid >> 2, wc = wid & 3, fr = lane & 15, fq = lane >> 4;
    const int K = g.K, nt = K / BK;
    unsigned voffA[2], voffB[2];
#pragma unroll
    for (int i = 0; i < 2; ++i) { int R, C; stage_rc(tid * 16 + i * 8192, R, C); const int Rb = Epi::PERM ? ((R & ~31) + perm32(R & 31)) : R;
        voffA[i] = (unsigned)(R * K + C) * 2u; voffB[i] = (unsigned)(Rb * K + C) * 2u; }
    static_assert(!GATHER || SP2, "gather is wired into the SP2 loop only");
    unsigned gA[2][2] = {{0u, 0u}, {0u, 0u}}, gN[2][2] = {{0u, 0u}, {0u, 0u}}; int gR[2] = {0, 0}, gC[2] = {0, 0};
    if constexpr (GATHER) {
#pragma unroll
        for (int i = 0; i < 2; ++i) stage_rc(tid * 16 + i * 8192, gR[i], gC[i]); }
#define PG8_GLOAD(u, dst) do { _Pragma("unroll") for (int h_ = 0; h_ < 2; ++h_) _Pragma("unroll") for (int i_ = 0; i_ < 2; ++i_) \
        dst[h_][i_] = ((unsigned)g.arow[(u).pm * BM + h_ * HALF + gR[i_]] * (unsigned)K + (unsigned)gC[i_]) * 2u; } while (0)
    const size_t kstep = (size_t)(BK * 2);
    const size_t hstep = (size_t)HALF * K * 2;
    const size_t tstep = 2 * hstep;
    const unsigned ldsw = (unsigned)wid * 1024u;
    const int aoff = lds_byte(wr * 64 + fr, fq * 8), boff = lds_byte(wc * 32 + fr, fq * 8);
#define PG8_SA(b, h) (((b) * 2 + (h)) * HTB)
#define PG8_SB(b, h) ((4 + (b) * 2 + (h)) * HTB)
#define PG8_STAGE(bufoff, gbase, voff) do { _Pragma("unroll") for (int _i = 0; _i < 2; ++_i) \
        __builtin_amdgcn_global_load_lds((const unsigned*)((const char*)(gbase) + (voff)[_i]), (PG8_LAS unsigned*)(lds + (bufoff) + ldsw + _i * 8192), 16, 0, 0); } while (0)
#define PG8_LDA(dst, b, h) do { _Pragma("unroll") for (int m = 0; m < 4; ++m) _Pragma("unroll") for (int k = 0; k < 2; ++k) dst[m][k] = *(const PG8_LAS bf16x8*)(lds + PG8_SA(b, h) + aoff + m * 2048 + k * 1024); } while (0)
#define PG8_LDB(dst, b, h) do { _Pragma("unroll") for (int n = 0; n < 2; ++n) _Pragma("unroll") for (int k = 0; k < 2; ++k) dst[n][k] = *(const PG8_LAS bf16x8*)(lds + PG8_SB(b, h) + boff + n * 2048 + k * 1024); } while (0)
#define PG8_MMA(ai, bj, At, Bt) do { __builtin_amdgcn_s_setprio(1); _Pragma("unroll") for (int m = 0; m < 4; ++m) _Pragma("unroll") for (int n = 0; n < 2; ++n) _Pragma("unroll") for (int k = 0; k < 2; ++k) \
        acc[ai][bj][m][n] = __builtin_amdgcn_mfma_f32_16x16x32_bf16(Bt[n][k], At[m][k], acc[ai][bj][m][n], 0, 0, 0); __builtin_amdgcn_s_setprio(0); } while (0)
#define PG8_WAIT_V(n) asm volatile("s_waitcnt vmcnt(" #n ")" ::: "memory")
#define PG8_WAIT_L(n) asm volatile("s_waitcnt lgkmcnt(" #n ")" ::: "memory")
#define PG8_BAR __builtin_amdgcn_s_barrier()
#define PG8_SCHED __builtin_amdgcn_sched_barrier(0)
    Unit cur, nxt; int ui = 0;
    if (!S.next(0, cur)) return;
    f32x4 acc[2][2][4][2];
#pragma unroll
    for (int a = 0; a < 2; ++a)
#pragma unroll
        for (int b = 0; b < 2; ++b)
#pragma unroll
            for (int m = 0; m < 4; ++m)
#pragma unroll
                for (int n = 0; n < 2; ++n) acc[a][b][m][n] = (f32x4){0.f, 0.f, 0.f, 0.f};
    bf16x8 At[4][2], B0[2][2], B1[2][2];
    const char* cA = (const char*)g.A + (GATHER ? (size_t)0 : (size_t)cur.pm * tstep); const char* cB = (const char*)g.Bt + (size_t)cur.pn * tstep;
    S.a_ready(cur);
    if constexpr (GATHER) { PG8_GLOAD(cur, gA); }
    const size_t ahs = GATHER ? (size_t)0 : hstep;
    if constexpr (SP2) {
        PG8_STAGE(PG8_SB(0, 0), cB, voffB); PG8_STAGE(PG8_SB(0, 1), cB + hstep, voffB); PG8_STAGE(PG8_SA(0, 0), cA, (GATHER ? gA[0] : voffA)); PG8_STAGE(PG8_SA(0, 1), cA + ahs, (GATHER ? gA[1] : voffA));
        if (wr == 1) PG8_BAR;
        PG8_WAIT_V(2); PG8_BAR;
        PG8_STAGE(PG8_SB(1, 0), cB + kstep, voffB); PG8_STAGE(PG8_SA(1, 0), cA + kstep, (GATHER ? gA[0] : voffA)); PG8_STAGE(PG8_SB(1, 1), cB + hstep + kstep, voffB);
        PG8_WAIT_V(6); PG8_BAR;
    } else {
        PG8_STAGE(PG8_SB(0, 0), cB, voffB); PG8_STAGE(PG8_SA(0, 0), cA, voffA); PG8_STAGE(PG8_SB(0, 1), cB + hstep, voffB); PG8_STAGE(PG8_SA(0, 1), cA + hstep, voffA);
        if (wr == 1) PG8_BAR;
        PG8_WAIT_V(4); PG8_BAR;
        PG8_STAGE(PG8_SB(1, 0), cB + kstep, voffB); PG8_STAGE(PG8_SA(1, 0), cA + kstep, voffA); PG8_STAGE(PG8_SB(1, 1), cB + hstep + kstep, voffB);
        PG8_WAIT_V(6); PG8_BAR;
    }
    for (;;) {
        const bool has_next = S.next(ui + 1, nxt);
        const char* nA = GATHER ? cA : (has_next ? (const char*)g.A + (size_t)nxt.pm * tstep : cA);
        if constexpr (GATHER) { if (has_next) { PG8_GLOAD(nxt, gN); } else { gN[0][0] = gA[0][0]; gN[0][1] = gA[0][1]; gN[1][0] = gA[1][0]; gN[1][1] = gA[1][1]; } } const char* nB = has_next ? (const char*)g.Bt + (size_t)nxt.pn * tstep : cB;
        for (int t = 0; t < nt; t += 2) {
            const bool last = (t == nt - 2);
            const char* a1 = cA + (size_t)(t + 1) * kstep;
            const char* a2 = last ? nA : cA + (size_t)(t + 2) * kstep; const char* b2 = last ? nB : cB + (size_t)(t + 2) * kstep;
            const char* a3 = a2 + kstep; const char* b3 = b2 + kstep;
            if (last && has_next) S.a_ready(nxt);
            unsigned g2[2][2];
#pragma unroll
            for (int h_ = 0; h_ < 2; ++h_)
#pragma unroll
                for (int i_ = 0; i_ < 2; ++i_) g2[h_][i_] = last ? gN[h_][i_] : gA[h_][i_];
            if constexpr (SP2) {
            PG8_LDB(B0, 0, 0); PG8_LDB(B1, 0, 1); PG8_SCHED; PG8_LDA(At, 0, 0); PG8_STAGE(PG8_SA(1, 1), a1 + ahs, (GATHER ? gA[1] : voffA));
            PG8_WAIT_V(8); PG8_WAIT_L(0); PG8_BAR; PG8_MMA(0, 0, At, B0); PG8_MMA(0, 1, At, B1); PG8_BAR; PG8_SCHED;
            PG8_LDA(At, 0, 1); PG8_STAGE(PG8_SB(0, 0), b2, voffB); PG8_STAGE(PG8_SB(0, 1), b2 + hstep, voffB); PG8_STAGE(PG8_SA(0, 0), a2, (GATHER ? g2[0] : voffA));
            PG8_WAIT_V(8); PG8_WAIT_L(0); PG8_BAR; PG8_MMA(1, 0, At, B0); PG8_MMA(1, 1, At, B1); PG8_BAR; PG8_SCHED;
            PG8_LDB(B0, 1, 0); PG8_LDB(B1, 1, 1); PG8_SCHED; PG8_LDA(At, 1, 0); PG8_STAGE(PG8_SA(0, 1), a2 + ahs, (GATHER ? g2[1] : voffA));
            PG8_WAIT_V(8); PG8_WAIT_L(0); PG8_BAR; PG8_MMA(0, 0, At, B0); PG8_MMA(0, 1, At, B1); PG8_BAR; PG8_SCHED;
            PG8_LDA(At, 1, 1); PG8_STAGE(PG8_SB(1, 0), b3, voffB); PG8_STAGE(PG8_SB(1, 1), b3 + hstep, voffB); PG8_STAGE(PG8_SA(1, 0), a3, (GATHER ? g2[0] : voffA));
            PG8_WAIT_V(8); PG8_WAIT_L(0); PG8_BAR; PG8_MMA(1, 0, At, B0); PG8_MMA(1, 1, At, B1); PG8_BAR; PG8_SCHED;
            } else {
            PG8_LDB(B0, 0, 0); PG8_SCHED; PG8_LDA(At, 0, 0); PG8_STAGE(PG8_SA(1, 1), a1 + hstep, voffA);
            PG8_WAIT_L(8); PG8_BAR; PG8_WAIT_L(0); PG8_MMA(0, 0, At, B0); PG8_BAR; PG8_SCHED;
            PG8_LDB(B1, 0, 1); PG8_STAGE(PG8_SB(0, 0), b2, voffB);
            PG8_BAR; PG8_WAIT_L(0); PG8_MMA(0, 1, At, B1); PG8_BAR;
            PG8_LDA(At, 0, 1); PG8_STAGE(PG8_SA(0, 0), a2, voffA);
            PG8_BAR; PG8_WAIT_L(0); PG8_MMA(1, 0, At, B0); PG8_BAR; PG8_SCHED;
            PG8_STAGE(PG8_SB(0, 1), b2 + hstep, voffB);
            PG8_WAIT_V(6); PG8_BAR; PG8_MMA(1, 1, At, B1); PG8_BAR;
            PG8_LDB(B0, 1, 0); PG8_SCHED; PG8_LDA(At, 1, 0); PG8_STAGE(PG8_SA(0, 1), a2 + hstep, voffA);
            PG8_WAIT_L(8); PG8_BAR; PG8_WAIT_L(0); PG8_MMA(0, 0, At, B0); PG8_BAR; PG8_SCHED;
            PG8_LDB(B1, 1, 1); PG8_STAGE(PG8_SB(1, 0), b3, voffB);
            PG8_BAR; PG8_WAIT_L(0); PG8_MMA(0, 1, At, B1); PG8_BAR;
            PG8_LDA(At, 1, 1); PG8_STAGE(PG8_SA(1, 0), a3, voffA);
            PG8_BAR; PG8_WAIT_L(0); PG8_MMA(1, 0, At, B0); PG8_BAR; PG8_SCHED;
            PG8_STAGE(PG8_SB(1, 1), b3 + hstep, voffB);
            PG8_WAIT_V(6); PG8_BAR; PG8_MMA(1, 1, At, B1); PG8_BAR;
            }
        }
        if constexpr (ALIGN_EPI) { if (wr == 0) PG8_BAR; }
        if constexpr (!Epi::AFTER_DRAIN) { E(acc, cur, wr, wc, fr, fq); S.done(cur); }
        if (!has_next) break;
#pragma unroll
        for (int a = 0; a < 2; ++a)
#pragma unroll
            for (int b = 0; b < 2; ++b)
#pragma unroll
                for (int m = 0; m < 4; ++m)
#pragma unroll
                    for (int n = 0; n < 2; ++n) acc[a][b][m][n] = (f32x4){0.f, 0.f, 0.f, 0.f};
        cur = nxt; cA = nA; cB = nB; ++ui;
        if constexpr (GATHER) { gA[0][0] = gN[0][0]; gA[0][1] = gN[0][1]; gA[1][0] = gN[1][0]; gA[1][1] = gN[1][1]; }
        if constexpr (ALIGN_EPI) { if (wr == 1) PG8_BAR; }
    }
    PG8_WAIT_V(0);
    if constexpr (!ALIGN_EPI) { if (wr == 0) PG8_BAR; }
    PG8_BAR;
    if constexpr (Epi::AFTER_DRAIN) { E.fused(acc, cur, wr, wc, fr, fq, lds, wid, lane); S.done(cur); }
#undef PG8_GLOAD
#undef PG8_SA
#undef PG8_SB
#undef PG8_STAGE
#undef PG8_LDA
#undef PG8_LDB
#undef PG8_MMA
#undef PG8_WAIT_V
#undef PG8_WAIT_L
#undef PG8_BAR
#undef PG8_SCHED
}
}
#include <hip/hip_bf16.h>
#include <cmath>
namespace attn_body {
using bf16=__hip_bfloat16;
using bf16x8=__attribute__((ext_vector_type(8)))short;
using s16x4=__attribute__((ext_vector_type(4)))short;
using f32x16=__attribute__((ext_vector_type(16)))float;
using u32x4=__attribute__((ext_vector_type(4)))unsigned;
constexpr int D=64, QP=768, KVP=768, OP=1024, NTILES=36;
constexpr int NW=8,QBLK=32,QB=QBLK*NW,KVBLK=64;
constexpr int ATTN_UNIT_ROWS=QB;
__device__ __forceinline__ int crow(int r,int hi){return (r&3)+8*(r>>2)+4*hi;}
#define SBAR() __builtin_amdgcn_sched_barrier(0)

constexpr int NSLOT=3, SLOTB=8192;
constexpr int LDS_K=0, LDS_V=NSLOT*SLOTB, LDS_WS=2*NSLOT*SLOTB, LDS_OST=LDS_WS+NW*64*4, LDS_BYTES=LDS_OST+NW*4096;
constexpr float C2=0.125f*1.4426950408889634f;
__device__ __forceinline__ void glds16(const void*gsrc,unsigned lds_dst){unsigned keep;
  asm volatile("s_mov_b32 %0, m0\n\ts_mov_b32 m0, %2\n\ts_nop 0\n\tglobal_load_lds_dwordx4 %1, off\n\ts_mov_b32 m0, %0":"=&s"(keep):"v"(gsrc),"s"(lds_dst):"memory");}
__device__ __forceinline__ float max3f(float a,float b,float c){float r;asm("v_max3_f32 %0, %1, %2, %3":"=v"(r):"v"(a),"v"(b),"v"(c));return r;}
__device__ __forceinline__ float max2f(float a,float b){float r;asm("v_max_f32_e32 %0, %1, %2":"=v"(r):"v"(a),"v"(b));return r;}
__device__ __forceinline__ float fadd_s(float a,float b){float r;asm("v_add_f32_e32 %0, %1, %2":"=v"(r):"v"(a),"v"(b));return r;}
__device__ __forceinline__ float fsub_s(float a,float b){float r;asm("v_sub_f32_e32 %0, %1, %2":"=v"(r):"v"(a),"v"(b));return r;}
typedef float f32x2_t __attribute__((ext_vector_type(2))); typedef __bf16 bf16x2_t __attribute__((ext_vector_type(2)));
__device__ __forceinline__ unsigned cvtpk_s(float lo,float hi){f32x2_t v={lo,hi};bf16x2_t b=__builtin_convertvector(v,bf16x2_t);return __builtin_bit_cast(unsigned,b);}
#define WAIT_BAR(N) asm volatile("s_waitcnt vmcnt(" #N ") lgkmcnt(0)\n\ts_barrier":::"memory")

__device__ __forceinline__ void qkt(f32x16&p0,f32x16&p1,const char*Kslot,const bf16x8*qr,const f32x16&negm,int r32,int hi){
  const char*kb=Kslot+hi*1024+r32*16;
  #pragma unroll
  for(int d0=0;d0<4;++d0){
    const bf16x8 b0=*reinterpret_cast<const bf16x8*>(kb+d0*2048);
    const bf16x8 b1=*reinterpret_cast<const bf16x8*>(kb+d0*2048+512);
    if(d0==0){p0=__builtin_amdgcn_mfma_f32_32x32x16_bf16(b0,qr[0],negm,0,0,0);p1=__builtin_amdgcn_mfma_f32_32x32x16_bf16(b1,qr[0],negm,0,0,0);}
    else{p0=__builtin_amdgcn_mfma_f32_32x32x16_bf16(b0,qr[d0],p0,0,0,0);p1=__builtin_amdgcn_mfma_f32_32x32x16_bf16(b1,qr[d0],p1,0,0,0);}}
}
typedef __attribute__((address_space(3))) const char* lds_cptr;
typedef short v4i16_t __attribute__((ext_vector_type(4)));
__device__ __forceinline__ void kload8(bf16x8*kf,lds_cptr kp){
  kf[0]=*(const __attribute__((address_space(3))) bf16x8*)(kp);      kf[1]=*(const __attribute__((address_space(3))) bf16x8*)(kp+512);
  kf[2]=*(const __attribute__((address_space(3))) bf16x8*)(kp+2048); kf[3]=*(const __attribute__((address_space(3))) bf16x8*)(kp+2560);
  kf[4]=*(const __attribute__((address_space(3))) bf16x8*)(kp+4096); kf[5]=*(const __attribute__((address_space(3))) bf16x8*)(kp+4608);
  kf[6]=*(const __attribute__((address_space(3))) bf16x8*)(kp+6144); kf[7]=*(const __attribute__((address_space(3))) bf16x8*)(kp+6656);
}
__device__ __forceinline__ void kload2(bf16x8*kf,lds_cptr kp,int j){ kf[2*j]=*(const __attribute__((address_space(3))) bf16x8*)(kp+j*2048); kf[2*j+1]=*(const __attribute__((address_space(3))) bf16x8*)(kp+j*2048+512); }
__device__ __forceinline__ s16x4 vtr(lds_cptr p){ return __builtin_bit_cast(s16x4,__builtin_amdgcn_ds_read_tr16_b64_v4i16((__attribute__((address_space(3))) v4i16_t*)p)); }
__device__ __forceinline__ float rowmax(const f32x16&p0,const f32x16&p1){
  float a=max3f(p0[0],p0[1],p1[0]),b=max3f(p0[2],p0[3],p1[1]);a=max3f(a,p1[2],p1[3]);
  #pragma unroll
  for(int r=4;r<16;r+=4){a=max3f(a,p0[r],p0[r+1]);b=max3f(b,p0[r+2],p0[r+3]);a=max3f(a,p1[r],p1[r+1]);b=max3f(b,p1[r+2],p1[r+3]);}
  const float m=max2f(a,b);
  auto rr=__builtin_amdgcn_permlane32_swap(__float_as_uint(m),__float_as_uint(m),false,false);
  return max2f(__uint_as_float(rr[0]),__uint_as_float(rr[1]));
}
__device__ __forceinline__ void pv(f32x16*o,int vb,bf16x8 pa0,bf16x8 pa1,bf16x8 pa2,bf16x8 pa3){
  #pragma unroll
  for(int d0=0;d0<2;++d0){s16x4 lo[4],hi[4];
    #pragma unroll
    for(int ks=0;ks<4;++ks){
      asm volatile("ds_read_b64_tr_b16 %0,%1 offset:%c2":"=&v"(lo[ks]):"v"(vb),"i"(d0*4096+ks*1024):"memory");
      asm volatile("ds_read_b64_tr_b16 %0,%1 offset:%c2":"=&v"(hi[ks]):"v"(vb),"i"(d0*4096+ks*1024+512):"memory");}
    asm volatile("s_waitcnt lgkmcnt(0)":::"memory");SBAR();
    #define PK(k) (bf16x8){lo[k][0],lo[k][1],lo[k][2],lo[k][3],hi[k][0],hi[k][1],hi[k][2],hi[k][3]}
    o[d0]=__builtin_amdgcn_mfma_f32_32x32x16_bf16(pa0,PK(0),o[d0],0,0,0);
    o[d0]=__builtin_amdgcn_mfma_f32_32x32x16_bf16(pa1,PK(1),o[d0],0,0,0);
    o[d0]=__builtin_amdgcn_mfma_f32_32x32x16_bf16(pa2,PK(2),o[d0],0,0,0);
    o[d0]=__builtin_amdgcn_mfma_f32_32x32x16_bf16(pa3,PK(3),o[d0],0,0,0);
    #undef PK
  }
}

#ifndef ATTN_STORE16
#define ATTN_STORE16(p,v) (*(u32x4*)(p)=(v))
#endif
template<int THRL> __device__ __forceinline__ void attn_unit(const bf16*Qw0,const bf16*__restrict__ Kh,const bf16*__restrict__ Vh,bf16*Ow0,char*shm,const float*qnw,const float*RT,int tl0){
  const int tid=threadIdx.x,lane=tid&63,r32=lane&31,hi=lane>>5; const int wid=__builtin_amdgcn_readfirstlane(tid>>6);
  const bf16*Qw=Qw0+(long)wid*QBLK*QP;


  const unsigned lds0=(unsigned)(uintptr_t)shm;
  float*wsf=(float*)(shm+LDS_WS)+wid*64;
  const bf16*ksrc=Kh+(long)lane*KVP+wid*8;
  const bf16*vsrc=Vh+(long)(16*(wid&3)+(lane>>2))*KVP+(wid>>2)*32+(lane&3)*8;
  const unsigned kdst=lds0+LDS_K+wid*1024, vdst=lds0+LDS_V+wid*1024;
  #define DMA_K(t,slot) glds16(ksrc+(long)(t)*KVBLK*KVP,(unsigned)__builtin_amdgcn_readfirstlane(kdst+(slot)))
  #define DMA_V(t,slot) glds16(vsrc+(long)(t)*KVBLK*KVP,(unsigned)__builtin_amdgcn_readfirstlane(vdst+(slot)))
  const int vb0=(int)(lds0+LDS_V)+((lane>>4)&1)*32+(lane&3)*8+(4*hi+((lane&15)>>2))*64;
  const char*Kbase=shm+LDS_K; bf16x8 kf[8];
  const lds_cptr shm3=(lds_cptr)shm; const lds_cptr kp0=shm3+LDS_K+hi*1024+r32*16; const lds_cptr vp0=shm3+LDS_V+((lane>>4)&1)*32+(lane&3)*8+(4*hi+((lane&15)>>2))*64;
  constexpr int NT=NTILES;
  DMA_K(0,0);DMA_V(0,0);DMA_K(1,SLOTB);
  bf16x8 qr[4];
  #pragma unroll
  for(int d0=0;d0<4;++d0)qr[d0]=*reinterpret_cast<const bf16x8*>(&Qw[(long)r32*QP+d0*16+hi*8]);
  { float qf[4][8]; float ss=0.f;
    #pragma unroll
    for(int d0=0;d0<4;++d0){ const u32x4 w=__builtin_bit_cast(u32x4,qr[d0]);
      qf[d0][0]=__uint_as_float(w[0]<<16);qf[d0][1]=__uint_as_float(w[0]&0xffff0000u);qf[d0][2]=__uint_as_float(w[1]<<16);qf[d0][3]=__uint_as_float(w[1]&0xffff0000u);
      qf[d0][4]=__uint_as_float(w[2]<<16);qf[d0][5]=__uint_as_float(w[2]&0xffff0000u);qf[d0][6]=__uint_as_float(w[3]<<16);qf[d0][7]=__uint_as_float(w[3]&0xffff0000u);
      #pragma unroll
      for(int j=0;j<8;++j)ss+=qf[d0][j]*qf[d0][j]; }
    { auto rr=__builtin_amdgcn_permlane32_swap(__float_as_uint(ss),__float_as_uint(ss),false,false); ss=__uint_as_float(rr[0])+__uint_as_float(rr[1]); }
    const float rstd=__builtin_amdgcn_rsqf(ss*(1.0f/64.0f)+1e-6f);
    #pragma unroll
    for(int d0=0;d0<4;++d0){
      #pragma unroll
      for(int j=0;j<8;++j)qf[d0][j]*=rstd*qnw[d0*16+hi*8+j]; }
    const int tl=tl0+wid*QBLK+r32, prow=tl>>6, pcol=tl&63;
    #pragma unroll
    for(int a=0;a<2;++a){ const int pos=a?pcol:prow;
      #pragma unroll
      for(int j=0;j<8;++j){ const float cs=RT[2*(pos*16+hi*8+j)], sn=RT[2*(pos*16+hi*8+j)+1]; const float x1=qf[2*a][j], x2=qf[2*a+1][j];
        qf[2*a][j]=x1*cs-x2*sn; qf[2*a+1][j]=x2*cs+x1*sn; } }
    #pragma unroll
    for(int d0=0;d0<4;++d0){ u32x4 w;
      w[0]=cvtpk_s(qf[d0][0]*C2,qf[d0][1]*C2); w[1]=cvtpk_s(qf[d0][2]*C2,qf[d0][3]*C2); w[2]=cvtpk_s(qf[d0][4]*C2,qf[d0][5]*C2); w[3]=cvtpk_s(qf[d0][6]*C2,qf[d0][7]*C2);
      qr[d0]=__builtin_bit_cast(bf16x8,w); } }
  float mhat=0.f,l_reg=0.f;f32x16 o[2];o[0]=f32x16{};o[1]=f32x16{};f32x16 negm=f32x16{};asm volatile("":"+v"(negm));

  #define CMASK(P0,P1,t) do{}while(0)
  bool resc=false;
  #define START(P0,P1) do{ const float rm=rowmax(P0,P1); resc=false; \
    { const float dl=rm; mhat=fadd_s(mhat,dl); \
      _Pragma("unroll") for(int r=0;r<16;++r){P0[r]=fsub_s(P0[r],dl);P1[r]=fsub_s(P1[r],dl);} \
      _Pragma("unroll") for(int r=0;r<16;++r)negm[r]=-mhat; asm volatile("":"+v"(negm)); } \
    _Pragma("unroll") for(int r=0;r<16;++r)P0[r]=__builtin_amdgcn_exp2f(P0[r]); }while(0)
  #define RESC() do{ if(resc){ asm volatile("s_waitcnt lgkmcnt(0)":::"memory"); \
      _Pragma("unroll") for(int d_=0;d_<2;++d_) _Pragma("unroll") for(int r=0;r<16;++r)o[d_][r]*=wsf[crow(r,hi)]; } }while(0)
  f32x16 pA0,pA1,pB0,pB1;
  int sl_prev=0,sl_cur=0,sl_next=SLOTB;
  #define ROT() do{sl_prev=sl_cur;sl_cur=sl_next;sl_next=(sl_next==(NSLOT-1)*SLOTB)?0:sl_next+SLOTB;}while(0)
  DMA_K(2,2*SLOTB);
  WAIT_BAR(3);
  qkt(pA0,pA1,Kbase,qr,negm,r32,hi);asm volatile("s_nop 15\n\ts_nop 7":"+v"(pA0),"+v"(pA1));CMASK(pA0,pA1,0);
  START(pA0,pA1);
  _Pragma("unroll") for(int r=0;r<16;++r)pA1[r]=__builtin_amdgcn_exp2f(pA1[r]);
  WAIT_BAR(0);
  DMA_K(3,0);DMA_V(1,SLOTB);
  ROT();
  kload8(kf,kp0+sl_cur);
  WAIT_BAR(2);
  s16x4 vlo[8],vhi[8]; u32x4 pw0,pw1,pw2,pw3;
  #define PKW(P,B) cvtpk_s(P[B],P[B+1])
  #define PAF(k) __builtin_bit_cast(bf16x8,pw##k)
  #define VFR(i) (bf16x8){vlo[i][0],vlo[i][1],vlo[i][2],vlo[i][3],vhi[i][0],vhi[i][1],vhi[i][2],vhi[i][3]}
  #define PIN(x) asm volatile("":"+v"(x))
  #define MX3(a,b,c) __builtin_fmaxf(__builtin_fmaxf((a),(b)),(c))
  #define GAPA(MF,A0,A1,A2,A3,W0,W1,PW) do{ MF; sacc+=A0; sacc+=A1; sacc+=A2; sacc+=A3; PIN(sacc); W0; W1; PIN(PW); SBAR(); }while(0)
  #define EX(v) __builtin_amdgcn_exp2f(v)
  #define GAPB(MF,X,B) do{ MF; X[B]=EX(X[B]); X[B+1]=EX(X[B+1]); X[B+2]=EX(X[B+2]); X[B+3]=EX(X[B+3]); PIN(X); SBAR(); }while(0)
  #define VRD(i) do{ vlo[i]=vtr(vp_+(((i)>>2)*4096+((i)&3)*1024)); vhi[i]=vtr(vp_+(((i)>>2)*4096+((i)&3)*1024+512)); }while(0)
  #define KRD(G,j) do{ if(G){ kload2(kf,kp0+sl_next,j); SBAR(); } }while(0)
  #define STEP(C0,C1,P0,P1,t,GK,GV,GL) do{ SBAR(); \
    const lds_cptr vp_=vp0+sl_prev; \
    VRD(0); SBAR(); float sacc=(P0[0]+P0[1]); \
    GAPA(C0=__builtin_amdgcn_mfma_f32_32x32x16_bf16(kf[0],qr[0],negm,0,0,0), P0[2],P0[3],P0[4],P0[5],     pw0[0]=PKW(P0,0), pw0[1]=PKW(P0,2), pw0); \
    VRD(4); SBAR(); GAPA(C1=__builtin_amdgcn_mfma_f32_32x32x16_bf16(kf[1],qr[0],negm,0,0,0), P0[6],P0[7],P0[8],P0[9],     pw0[2]=PKW(P0,4), pw0[3]=PKW(P0,6), pw0); \
    VRD(1); SBAR(); GAPA(C0=__builtin_amdgcn_mfma_f32_32x32x16_bf16(kf[2],qr[1],C0,0,0,0),   P0[10],P0[11],P0[12],P0[13], pw1[0]=PKW(P0,8), pw1[1]=PKW(P0,10), pw1); \
    VRD(5); SBAR(); GAPA(C1=__builtin_amdgcn_mfma_f32_32x32x16_bf16(kf[3],qr[1],C1,0,0,0),   P0[14],P0[15],P1[0],P1[1],   pw1[2]=PKW(P0,12),pw1[3]=PKW(P0,14), pw1); \
    VRD(2); SBAR(); GAPA(C0=__builtin_amdgcn_mfma_f32_32x32x16_bf16(kf[4],qr[2],C0,0,0,0),   P1[2],P1[3],P1[4],P1[5],     pw2[0]=PKW(P1,0), pw2[1]=PKW(P1,2), pw2); \
    VRD(6); SBAR(); GAPA(C1=__builtin_amdgcn_mfma_f32_32x32x16_bf16(kf[5],qr[2],C1,0,0,0),   P1[6],P1[7],P1[8],P1[9],     pw2[2]=PKW(P1,4), pw2[3]=PKW(P1,6), pw2); \
    VRD(3); SBAR(); GAPA(C0=__builtin_amdgcn_mfma_f32_32x32x16_bf16(kf[6],qr[3],C0,0,0,0),   P1[10],P1[11],P1[12],P1[13], pw3[0]=PKW(P1,8), pw3[1]=PKW(P1,10), pw3); \
    VRD(7); SBAR(); GAPA(C1=__builtin_amdgcn_mfma_f32_32x32x16_bf16(kf[7],qr[3],C1,0,0,0),   P1[14],P1[15],0.f,0.f,       pw3[2]=PKW(P1,12),pw3[3]=PKW(P1,14), pw3); \
    l_reg+=sacc; \
    if(GK){DMA_K((t)+3,sl_cur);} if(GV){DMA_V((t)+1,sl_next);} \
    CMASK(C0,C1,t); \
    { float a=MX3(C0[0],C0[1],C1[0]),b=MX3(C0[2],C0[3],C1[1]); a=MX3(a,C1[2],C1[3]); \
      _Pragma("unroll") for(int r=4;r<16;r+=4){a=MX3(a,C0[r],C0[r+1]);b=MX3(b,C0[r+2],C0[r+3]);a=MX3(a,C1[r],C1[r+1]);b=MX3(b,C1[r+2],C1[r+3]);} \
      float rm=__builtin_fmaxf(a,b); { auto rr=__builtin_amdgcn_permlane32_swap(__float_as_uint(rm),__float_as_uint(rm),false,false); rm=__builtin_fmaxf(__uint_as_float(rr[0]),__uint_as_float(rr[1])); } \
      resc=false; \
      if(__builtin_expect(__any(rm>(float)THRL),0)){ const float dl=__builtin_fmaxf(rm,0.f); mhat+=dl; \
        _Pragma("unroll") for(int r=0;r<16;++r){C0[r]-=dl;C1[r]-=dl;} \
        _Pragma("unroll") for(int r=0;r<16;++r)negm[r]=-mhat; asm volatile("":"+v"(negm)); \
        const float f=__builtin_amdgcn_exp2f(-dl); l_reg*=f; if(hi==0)wsf[r32]=f; resc=true; } } \
    SBAR(); \
    GAPB(o[0]=__builtin_amdgcn_mfma_f32_32x32x16_bf16(PAF(0),VFR(0),o[0],0,0,0), C0,0); \
    GAPB(o[1]=__builtin_amdgcn_mfma_f32_32x32x16_bf16(PAF(0),VFR(4),o[1],0,0,0), C0,4); \
    KRD(GL,0); GAPB(o[0]=__builtin_amdgcn_mfma_f32_32x32x16_bf16(PAF(1),VFR(1),o[0],0,0,0), C0,8); \
    KRD(GL,1); GAPB(o[1]=__builtin_amdgcn_mfma_f32_32x32x16_bf16(PAF(1),VFR(5),o[1],0,0,0), C0,12); \
    KRD(GL,2); GAPB(o[0]=__builtin_amdgcn_mfma_f32_32x32x16_bf16(PAF(2),VFR(2),o[0],0,0,0), C1,0); \
    KRD(GL,3); GAPB(o[1]=__builtin_amdgcn_mfma_f32_32x32x16_bf16(PAF(2),VFR(6),o[1],0,0,0), C1,4); \
    GAPB(o[0]=__builtin_amdgcn_mfma_f32_32x32x16_bf16(PAF(3),VFR(3),o[0],0,0,0), C1,8); \
    GAPB(o[1]=__builtin_amdgcn_mfma_f32_32x32x16_bf16(PAF(3),VFR(7),o[1],0,0,0), C1,12); \
    }while(0)
  int t=1;
  #undef CMASK
  #define CMASK(P0,P1,t) do{}while(0)
  for(;t+5<NT;t+=2){
    STEP(pB0,pB1,pA0,pA1,t,true,true,true);     WAIT_BAR(2); RESC(); ROT();
    STEP(pA0,pA1,pB0,pB1,t+1,true,true,true);   WAIT_BAR(2); RESC(); ROT();
  }
  #undef CMASK
  #define CMASK(P0,P1,t) do{}while(0)
  #define ENDW(tt) do{ if((tt)+3<NT){WAIT_BAR(2);} else if((tt)+2<NT){WAIT_BAR(1);} else {WAIT_BAR(0);} }while(0)
  for(;t+1<NT;t+=2){
    STEP(pB0,pB1,pA0,pA1,t,(t+3<NT),(t+1<NT),(t+1<NT));       ENDW(t);   RESC(); ROT();
    STEP(pA0,pA1,pB0,pB1,t+1,(t+4<NT),(t+2<NT),(t+2<NT));     ENDW(t+1); RESC(); ROT();
  }
  STEP(pB0,pB1,pA0,pA1,NT-1,false,false,false); RESC();
  { float sacc=pB0[0]+pB0[1]; _Pragma("unroll") for(int r=2;r<16;++r)sacc+=pB0[r]; _Pragma("unroll") for(int r=0;r<16;++r)sacc+=pB1[r]; l_reg+=sacc;
    pw0=(u32x4){PKW(pB0,0),PKW(pB0,2),PKW(pB0,4),PKW(pB0,6)};pw1=(u32x4){PKW(pB0,8),PKW(pB0,10),PKW(pB0,12),PKW(pB0,14)};pw2=(u32x4){PKW(pB1,0),PKW(pB1,2),PKW(pB1,4),PKW(pB1,6)};pw3=(u32x4){PKW(pB1,8),PKW(pB1,10),PKW(pB1,12),PKW(pB1,14)};
    SBAR(); pv(o,vb0+sl_cur,PAF(0),PAF(1),PAF(2),PAF(3)); }
  #undef PKW
  #undef PAF
  #undef VFR
  #undef PIN
  #undef MX3
  #undef GAPA
  #undef GAPB
  #undef EX
  #undef VRD
  #undef KRD
  #undef STEP
  #undef ENDW
  {auto rr=__builtin_amdgcn_permlane32_swap(__float_as_uint(l_reg),__float_as_uint(l_reg),false,false);l_reg=__uint_as_float(rr[0])+__uint_as_float(rr[1]);}
  if(hi==0)wsf[32+r32]=l_reg;asm volatile("s_waitcnt lgkmcnt(0)":::"memory");
  float rli[16];
  #pragma unroll
  for(int r=0;r<16;++r)rli[r]=__builtin_amdgcn_rcpf(wsf[32+crow(r,hi)]);
  bf16*Ow=Ow0+(long)wid*QBLK*OP;
  { bf16*stg=(bf16*)(shm+LDS_OST)+wid*2048;
    #pragma unroll
    for(int r=0;r<16;++r){const int orow=crow(r,hi);
      #pragma unroll
      for(int d0=0;d0<2;++d0)stg[orow*64+d0*32+r32]=__float2bfloat16(o[d0][r]*rli[r]);}
    asm volatile("s_waitcnt lgkmcnt(0)":::"memory");
    #pragma unroll
    for(int i=0;i<4;++i){const int row=i*8+(lane>>3),ch=lane&7; const u32x4 v=*(const u32x4*)(stg+row*64+ch*8); ATTN_STORE16(Ow+(long)row*OP+ch*8,v);} }
  asm volatile("s_waitcnt lgkmcnt(0)\n\ts_barrier":::"memory");
  #undef DMA_K
  #undef DMA_V
  #undef CMASK
  #undef START
  #undef RESC
  #undef ROT
}
constexpr int ATTN_LDS_BYTES=LDS_BYTES;
#undef SBAR
#undef WAIT_BAR
}
#define GAS __attribute__((address_space(1)))
#define LAS __attribute__((address_space(3)))
typedef unsigned short bf16;
typedef unsigned v4u __attribute__((ext_vector_type(4)));
typedef float f32x4 __attribute__((ext_vector_type(4)));
typedef short bf16x8 __attribute__((ext_vector_type(8)));
typedef GAS unsigned gu32;
typedef GAS unsigned long long gu64;
#define RLX_AGENT __ATOMIC_RELAXED, __HIP_MEMORY_SCOPE_AGENT
#define LDS_WAIT() asm volatile("s_waitcnt lgkmcnt(0)" ::: "memory")
#define VM_WAIT() asm volatile("s_waitcnt vmcnt(0)" ::: "memory")
__device__ __forceinline__ unsigned long long rt() { return __builtin_amdgcn_s_memrealtime(); }
__device__ __forceinline__ unsigned f2bf(float f) { unsigned u = __builtin_bit_cast(unsigned, f); return (u + 0x7fffu + ((u >> 16) & 1u)) >> 16; }
__device__ __forceinline__ unsigned pk2(float lo, float hi) { return f2bf(lo) | (f2bf(hi) << 16); }

#define XB_TMO      128
#define XB_XCNT(j)  (256  + 64 * (j))
#define XB_XSUB(j)  (1280 + 64 * (j))
#define XB_XGEN(j)  (2304 + 64 * (j))
#define XB_TOP      3328
#define XB_TOPGEN   3392
#define XCD_BAR_WORDS 3456
#define XB_SPIN_CAP (1u << 18)

__device__ __forceinline__ unsigned xb_ld(unsigned* p)              { return __hip_atomic_load(p, __ATOMIC_RELAXED, __HIP_MEMORY_SCOPE_AGENT); }
__device__ __forceinline__ unsigned xb_add(unsigned* p, unsigned v) { return __hip_atomic_fetch_add(p, v, __ATOMIC_RELAXED, __HIP_MEMORY_SCOPE_AGENT); }
__device__ __forceinline__ unsigned xb_xcc_id() { return (unsigned)__builtin_amdgcn_s_getreg((3 << 11) | 20) & 0xFu; }
#define XB_SPIN(cond, bar) do { unsigned _sp = 0; while (cond) { __builtin_amdgcn_s_sleep(1); \
    if ((++_sp & 255u) == 0u) { if (xb_ld(&(bar)[XB_TMO])) break; if (_sp > XB_SPIN_CAP) { atomicAdd(&(bar)[XB_TMO], 1u); break; } } } } while (0)

struct XcdBarrier {
    unsigned* bar; unsigned x;
    volatile LAS unsigned* st;
};

__device__ __forceinline__ XcdBarrier xcd_barrier_post(unsigned* bar, volatile LAS unsigned* st) {
    XcdBarrier b; b.bar = bar; b.x = xb_xcc_id(); b.st = st;
    if (threadIdx.x == 0) (void)xb_add(&bar[XB_XCNT(b.x)], 1u);
    return b;
}
__device__ __forceinline__ void xcd_barrier_complete(unsigned* bar, unsigned x, unsigned& nloc, unsigned& nx) {
    const unsigned G = gridDim.x * gridDim.y * gridDim.z;
    unsigned sum, cnt, mine, sp = 0u;
    for (;;) {
        sum = 0u; cnt = 0u; mine = 0u;
#pragma unroll
        for (unsigned j = 0; j < 16; ++j) { const unsigned c = xb_ld(&bar[XB_XCNT(j)]); sum += c; cnt += (c > 0u) ? 1u : 0u; mine = (j == x) ? c : mine; }
        if (sum == G) break;
        __builtin_amdgcn_s_sleep(1);
        if ((++sp & 255u) == 0u) { if (xb_ld(&bar[XB_TMO])) break; if (sp > XB_SPIN_CAP) { atomicAdd(&bar[XB_TMO], 1u); break; } }
    }
    nloc = mine > 0u ? mine : 1u; nx = cnt > 0u ? cnt : 1u;
}

__device__ __forceinline__ void xcd_barrier(const XcdBarrier& b) {
    asm volatile("s_waitcnt vmcnt(0)" ::: "memory");
    __syncthreads();
    if (threadIdx.x == 0) {
        unsigned* bar = b.bar;
        __builtin_amdgcn_s_waitcnt(0);
        unsigned nloc = b.st[0], nx = b.st[1];
        if (nloc == 0u) { xcd_barrier_complete(bar, b.x, nloc, nx); b.st[0] = nloc; b.st[1] = nx; }
        const unsigned old = xb_add(&bar[XB_XSUB(b.x)], 1u);
        const unsigned gen = old / nloc;
        if (old + 1u == (gen + 1u) * nloc) {
            __builtin_amdgcn_fence(__ATOMIC_RELEASE, "agent");
            asm volatile("s_waitcnt vmcnt(0)" ::: "memory");
            const unsigned og = xb_add(&bar[XB_TOP], 1u);
            const unsigned tg = og / nx;
            if (og + 1u == (tg + 1u) * nx) xb_add(&bar[XB_TOPGEN], 1u);
            else XB_SPIN(xb_ld(&bar[XB_TOPGEN]) == tg, bar);
            __builtin_amdgcn_fence(__ATOMIC_ACQUIRE, "agent");
            xb_add(&bar[XB_XGEN(b.x)], 1u);
            asm volatile("s_waitcnt vmcnt(0)" ::: "memory");
        } else {
            XB_SPIN(xb_ld(&bar[XB_XGEN(b.x)]) == gen, bar);
            __builtin_amdgcn_fence(__ATOMIC_ACQUIRE, "agent");
            asm volatile("s_waitcnt vmcnt(0)" ::: "memory");
        }
    }
    __syncthreads();
}
constexpr int NB = 8, SEQL = 2048, CTXL = 256, TOK = 2304, DM_ = 1024, MROWS = NB * TOK, NLAT = NB * SEQL, INW = 2832, NIN = 2816;
constexpr int NPHASE = 9;
#ifndef REP_VAL
#define REP_VAL 1
#endif
#ifndef MK_MULTI
#define MK_MULTI 0
#endif
constexpr size_t MiB = 1u << 20;
constexpr size_t WS_CTL = 0, CTL_ZERO_BYTES = 65536;
constexpr size_t WS_MOD = 1 * MiB;
constexpr size_t WS_ROPE = WS_MOD + 256 * 1024;
constexpr size_t WS_G = 2 * MiB;
constexpr size_t WS_BETA = WS_G + 640 * 1024;
constexpr size_t WS_EG = WS_BETA + 640 * 1024;
constexpr size_t WS_EK = WS_EG + 640 * 1024;
constexpr size_t WS_GLAST = WS_EK + 640 * 1024;
constexpr size_t WS_AFF = 5 * MiB;
constexpr size_t WS_IDX = 6 * MiB;
constexpr size_t WS_GATE = WS_IDX + 256 * 1024;
constexpr size_t WS_XROW = WS_IDX + 512 * 1024;
constexpr size_t WS_INV = 7 * MiB;
constexpr size_t S1 = 8 * MiB;
constexpr size_t WS_XN = S1;
constexpr size_t WS_DQ = WS_XN, WS_DK = WS_XN + 18 * MiB;
constexpr size_t WS_PD = WS_XN + 36 * MiB;

constexpr size_t WS_DKT = WS_PD + 54 * MiB;
constexpr size_t WS_DVT = WS_DKT + 18 * MiB;
constexpr size_t WS_PA = WS_DVT + 18 * MiB;
constexpr size_t WS_PZ = WS_PA + 27 * MiB;
constexpr size_t WS_Y = WS_PZ + 18 * MiB;
constexpr size_t WS_DO = WS_Y + 32 * MiB;
constexpr size_t WS_WIN = WS_DO + 32 * MiB;
constexpr size_t WS_WOUT = WS_WIN + 6 * MiB;
constexpr size_t WS_WU2 = WS_WOUT + 2 * MiB;
constexpr size_t WS_QKD2 = WS_WU2 + 27 * MiB;
constexpr size_t WS_QKD = WS_QKD2;
constexpr size_t WS_END1 = WS_QKD2 + 16 * MiB;
constexpr size_t WS_WGU = S1;
constexpr size_t WS_YB = WS_WGU;
constexpr size_t WS_WD = WS_WGU + 64 * MiB;
constexpr size_t WS_H2 = WS_WD + 32 * MiB;
constexpr size_t WS_XG = WS_H2 + 32 * MiB;
constexpr size_t WS_HID = WS_XG + 64 * MiB;
constexpr size_t WS_END2 = WS_HID + 64 * MiB;
constexpr size_t WS_NEED = WS_END1 > WS_END2 ? WS_END1 : WS_END2;
constexpr int CW_TMO = 0, CW_CODE = 1, CW_ATTNQ = 64, CW_SCAN = 512, CW_P6Q = 576, CW_ROWS = 640, CW_CVQ = 704, CW_CHAIN = 768, CW_BAR = 4096;
constexpr int LDS_BYTES = 147456;
constexpr int MISC_OFF = 146944;

typedef unsigned u32x2 __attribute__((ext_vector_type(2)));
__device__ __forceinline__ float bf2f(unsigned short h) { return __builtin_bit_cast(float, (unsigned)h << 16); }
__device__ __forceinline__ float bflo(unsigned w) { return __builtin_bit_cast(float, w << 16); }
__device__ __forceinline__ float bfhi(unsigned w) { return __builtin_bit_cast(float, w & 0xffff0000u); }
__device__ __forceinline__ float wave_sum(float v) {
    int x = __builtin_bit_cast(int, v);
#define WS_STEP(ctrl, rmask) do { const int t_ = __builtin_amdgcn_update_dpp(0, x, (ctrl), (rmask), 0xf, false); x = __builtin_bit_cast(int, __builtin_bit_cast(float, x) + __builtin_bit_cast(float, t_)); } while (0)
    WS_STEP(0xB1, 0xf);
    WS_STEP(0x4E, 0xf);
    WS_STEP(0x141, 0xf);
    WS_STEP(0x140, 0xf);
    WS_STEP(0x142, 0xa);
    WS_STEP(0x143, 0xc);
#undef WS_STEP
    return __builtin_bit_cast(float, __builtin_amdgcn_readlane(x, 63));
}
__device__ __forceinline__ float dpp_xor1(float v) { return __builtin_bit_cast(float, __builtin_amdgcn_update_dpp(0, __builtin_bit_cast(int, v), 0xB1, 0xf, 0xf, false)); }
__device__ __forceinline__ float dpp_xor2(float v) { return __builtin_bit_cast(float, __builtin_amdgcn_update_dpp(0, __builtin_bit_cast(int, v), 0x4E, 0xf, 0xf, false)); }
__device__ __forceinline__ float row16_sum(float v) {
    v += dpp_xor1(v); v += dpp_xor2(v);
    v += __builtin_bit_cast(float, __builtin_amdgcn_update_dpp(0, __builtin_bit_cast(int, v), 0x141, 0xf, 0xf, false));
    v += __builtin_bit_cast(float, __builtin_amdgcn_update_dpp(0, __builtin_bit_cast(int, v), 0x140, 0xf, 0xf, false));
    return v;
}
__device__ __forceinline__ float reduce16(const float (&a)[16], int lane) {
    float b8[8], b4[4], b2[2];
#pragma unroll
    for (int e = 0; e < 8; ++e) { const float send = (lane & 32) ? a[e] : a[e + 8], keep = (lane & 32) ? a[e + 8] : a[e]; b8[e] = keep + __shfl_xor(send, 32); }
#pragma unroll
    for (int e = 0; e < 4; ++e) { const float send = (lane & 16) ? b8[e] : b8[e + 4], keep = (lane & 16) ? b8[e + 4] : b8[e]; b4[e] = keep + __shfl_xor(send, 16); }
#pragma unroll
    for (int e = 0; e < 2; ++e) { const float send = (lane & 8) ? b4[e] : b4[e + 2], keep = (lane & 8) ? b4[e + 2] : b4[e]; b2[e] = keep + __shfl_xor(send, 8); }
    const float send = (lane & 4) ? b2[0] : b2[1], keep = (lane & 4) ? b2[1] : b2[0];
    float r = keep + __shfl_xor(send, 4);
    r += dpp_xor2(r); r += dpp_xor1(r);
    return r;
}

typedef float f32x2_t __attribute__((ext_vector_type(2))); typedef __bf16 bf16x2_t __attribute__((ext_vector_type(2)));
typedef float f32x16 __attribute__((ext_vector_type(16)));
__device__ __forceinline__ unsigned cvtpk(float lo, float hi) { f32x2_t v = {lo, hi}; bf16x2_t b = __builtin_convertvector(v, bf16x2_t); return __builtin_bit_cast(unsigned, b); }
__device__ __forceinline__ int perm16(int p) { return 8 * ((p >> 2) & 1) + 4 * ((p >> 3) & 1) + (p & 3); }
struct Frame {
    LAS unsigned char* lds; unsigned char* ldsg;
    volatile LAS unsigned* MISC;
    gu32* ctl;
    int tid, lane, wave, G, gw, NGW;
    float* out; unsigned char* ws;
};
#define WSP(T, off) ((T*)(F.ws + (off)))
__device__ __forceinline__ unsigned char* wu_group(Frame& F, int g) { return g < 6 ? F.ws + WS_PD + (size_t)g * 9 * MiB : g < 13 ? (unsigned char*)F.out + (size_t)(g - 6) * 9 * MiB : F.ws + WS_WU2 + (size_t)(g - 13) * 9 * MiB; }

__device__ __forceinline__ void transpose_item(const float* W, int ldw, int k0, int n0, bf16* dst, int K, LAS float* scr, int lane) {
    f32x4 ld[8];
#pragma unroll
    for (int i = 0; i < 8; ++i) ld[i] = __builtin_nontemporal_load((const f32x4*)(W + (size_t)(k0 + 8 * i + (lane >> 3)) * ldw + n0 + 4 * (lane & 7)));
#pragma unroll
    for (int i = 0; i < 8; ++i) { LAS float* d = scr + (8 * i + (lane >> 3)) * 33 + 4 * (lane & 7); d[0] = ld[i].x; d[1] = ld[i].y; d[2] = ld[i].z; d[3] = ld[i].w; }
    LDS_WAIT(); asm volatile("" ::: "memory");
    const int c = lane & 7;
#pragma unroll
    for (int j = 0; j < 4; ++j) { const int n = (lane >> 3) + 8 * j; const LAS float* s = scr + (8 * c) * 33 + n;
        v4u o; o.x = pk2(s[0 * 33], s[1 * 33]); o.y = pk2(s[2 * 33], s[3 * 33]); o.z = pk2(s[4 * 33], s[5 * 33]); o.w = pk2(s[6 * 33], s[7 * 33]);
        *(GAS v4u*)(dst + (size_t)n * K + 8 * c) = o; }
    LDS_WAIT(); asm volatile("" ::: "memory");
}
__device__ __forceinline__ void p0_phase(Frame& F, const float* c_, const float* c_ctx_, const float* w_mod_, const float* b_mod_, const float* w_in_, const float* w_out_) {
    float* MOD = WSP(float, WS_MOD);
    if (blockIdx.x < 192) {
        LAS float* sc = (LAS float*)F.lds;
        LAS float* red = (LAS float*)(F.lds + 36864);
        for (int i = F.tid; i < 9 * 1024; i += 512) { const int r = i >> 10, k = i & 1023; const float v = (r < 8) ? c_[r * 1024 + k] : c_ctx_[k]; sc[i] = v / (1.0f + expf(-v)); }
        __syncthreads();
        const int col = F.tid & 31, kg = F.tid >> 5, n0 = blockIdx.x * 32;
        float acc[9];
#pragma unroll
        for (int r = 0; r < 9; ++r) acc[r] = 0.f;
        const float* wp = w_mod_ + (size_t)kg * 6144 + n0 + col;
#pragma unroll 8
        for (int i = 0; i < 64; ++i) { const float w = __builtin_nontemporal_load(wp + (size_t)i * 16 * 6144); const int k = kg + 16 * i;
#pragma unroll
            for (int r = 0; r < 9; ++r) acc[r] += sc[r * 1024 + k] * w; }
#pragma unroll
        for (int r = 0; r < 9; ++r) red[(kg * 9 + r) * 32 + col] = acc[r];
        __syncthreads();
        if (F.tid < 288) { const int r = F.tid >> 5, cc = F.tid & 31; float s = 0.f;
#pragma unroll
            for (int g2 = 0; g2 < 16; ++g2) s += red[(g2 * 9 + r) * 32 + cc];
            MOD[r * 6144 + n0 + cc] = s + b_mod_[n0 + cc]; }
        __syncthreads();
    } else if (blockIdx.x == 200) {
        float* RT = WSP(float, WS_ROPE);
        for (int i = F.tid; i < 1024; i += 512) { const int pos = i >> 4, fi = i & 15; const float fr = powf(10000.0f, -(float)fi / 16.0f); const float ang = (float)pos * fr;
            RT[2 * i] = cosf(ang); RT[2 * i + 1] = sinf(ang); }
    }
    LAS float* scr = (LAS float*)(F.lds + 57344 + F.wave * 8448);
    bf16* WinT = WSP(bf16, WS_WIN); bf16* WoutT = WSP(bf16, WS_WOUT);
    constexpr int I_IN = 16 * 88, I_OUT = 16 * 32;
    for (int it = F.gw; it < I_IN + I_OUT; it += F.NGW) {
        if (it < I_IN) { const int kb = it / 88, nb = it % 88; transpose_item(w_in_, INW, 64 * kb, 32 * nb, WinT + (size_t)(32 * nb) * 1024 + 64 * kb, 1024, scr, F.lane); }
        else { const int r = it - I_IN, kb = r / 32, nb = r % 32; transpose_item(w_out_, 1024, 64 * kb, 32 * nb, WoutT + (size_t)(32 * nb) * 1024 + 64 * kb, 1024, scr, F.lane); }
    }
}

__device__ __forceinline__ float softplus_f(float x) { return fmaxf(x, 0.f) + __logf(1.0f + __expf(-fabsf(x))); }
__device__ __forceinline__ void p1_row(const f32x4 (&wr0)[32], const f32x4 (&v)[4], int row, int lane, const LAS float* wt, const LAS float* nwl, const LAS float* mdl, bf16* XN, float* Gg, float* Bt, float cA, float cB) {
    const int b = row / TOK, t = row - b * TOK;
    const LAS float* mod = mdl + (t < CTXL ? 8 : b) * 2048;
    float ss = 0.f;
#pragma unroll
    for (int j = 0; j < 4; ++j) ss += (v[j].x * v[j].x + v[j].y * v[j].y) + (v[j].z * v[j].z + v[j].w * v[j].w);
    const float rstd = __builtin_amdgcn_rsqf(wave_sum(ss) * (1.0f / 1024.0f) + 1e-6f);
    f32x4 acc4[4];
#pragma unroll
    for (int e = 0; e < 4; ++e) acc4[e] = (f32x4){0.f, 0.f, 0.f, 0.f};
#pragma unroll
    for (int j = 0; j < 4; ++j) { const int k = 4 * lane + 256 * j;
        const f32x4 nw = *(const LAS f32x4*)(nwl + k), sh = *(const LAS f32x4*)(mod + k), sc = *(const LAS f32x4*)(mod + 1024 + k);
        const f32x4 h = (v[j] * rstd) * nw * (sc + 1.0f) + sh;
        u32x2 w; w.x = cvtpk(h.x, h.y); w.y = cvtpk(h.z, h.w); *(u32x2*)(XN + (size_t)row * 1024 + k) = w;
#pragma unroll
        for (int c = 0; c < 4; ++c) { const float hk = h[c];
            if (j < 2) {
#pragma unroll
                for (int e4 = 0; e4 < 4; ++e4) acc4[e4] += wr0[j * 16 + c * 4 + e4] * hk;
            } else { const LAS f32x4* wp = (const LAS f32x4*)(wt + ((c + 4 * j) * 256 + lane) * 4);
#pragma unroll
                for (int e4 = 0; e4 < 4; ++e4) acc4[e4] += wp[e4 * 64] * hk; } }
        asm volatile("" ::: "memory"); }
    float acc[16];
#pragma unroll
    for (int e = 0; e < 16; ++e) acc[e] = acc4[e >> 2][e & 3];
    const float val = reduce16(acc, lane);
    if ((lane & 3) == 0) { const int e = lane >> 2;
        if (e < 8) { const int dir = e >> 2, hh = e & 3; Bt[(size_t)((dir * 8 + b) * 4 + hh) * TOK + t] = __builtin_amdgcn_rcpf(1.0f + __expf(-val)); }
        else { const int e2 = e - 8, dir = e2 >> 2, hh = e2 & 3; Gg[(size_t)((dir * 8 + b) * 4 + hh) * TOK + t] = cA * softplus_f(val + cB); } }
}
__device__ __forceinline__ void p1_phase(Frame& F, const float* x_, const float* ctx_, const float* norm1_w_, const float* w_in_, const float* a_log_, const float* dt_bias_, int rep) {
    LAS float* wt = (LAS float*)F.lds;
    LAS float* nwl = wt + 16384;
    LAS float* mdl = nwl + 1024;
    const float* MOD = WSP(float, WS_MOD); bf16* XN = WSP(bf16, WS_XN); float* Gg = WSP(float, WS_G); float* Bt = WSP(float, WS_BETA);
    {
        f32x4 tw[8], tm[9], tn;
#pragma unroll
        for (int q = 0; q < 8; ++q) { const int idx = F.tid + 512 * q, k = idx >> 2, e4 = idx & 3; tw[q] = *(const f32x4*)(w_in_ + (size_t)k * INW + NIN + 4 * e4); }
#pragma unroll
        for (int q = 0; q < 9; ++q) { const int idx = F.tid + 512 * q; tm[q] = *(const f32x4*)(MOD + (size_t)(idx >> 9) * 6144 + (idx & 511) * 4); }
        tn = *(const f32x4*)(norm1_w_ + 4 * (F.tid & 255));
#pragma unroll
        for (int q = 0; q < 8; ++q) { const int idx = F.tid + 512 * q, k = idx >> 2, e4 = idx & 3; *(LAS f32x4*)(wt + ((((k & 3) + 4 * (k >> 8)) * 4 + e4) * 64 + ((k & 255) >> 2)) * 4) = tw[q]; }
#pragma unroll
        for (int q = 0; q < 9; ++q) { const int idx = F.tid + 512 * q; *(LAS f32x4*)(mdl + (idx >> 9) * 2048 + (idx & 511) * 4) = tm[q]; }
        if (F.tid < 256) *(LAS f32x4*)(nwl + 4 * F.tid) = tn;
    }
    const int lane = F.lane;
    float cA = 0.f, cB = 0.f;
    { const int e = lane >> 2; if (e >= 8) { cA = -expf(a_log_[e - 8]); cB = dt_bias_[e - 8]; } }
#define P1_SRC(row) ((((row) % TOK) < CTXL) ? ctx_ + (size_t)(((row) / TOK) * CTXL + ((row) % TOK)) * 1024 : x_ + (size_t)(((row) / TOK) * SEQL + ((row) % TOK) - CTXL) * 1024)
#define P1_LOAD(P, row) do { const float* s_ = P1_SRC(row); _Pragma("unroll") for (int j_ = 0; j_ < 4; ++j_) P[j_] = __builtin_nontemporal_load((const f32x4*)(s_ + 4 * lane + 256 * j_)); } while (0)
    f32x4 P0[4], P1[4];
    const int r0 = F.gw, st = F.NGW;
    if (r0 < MROWS) P1_LOAD(P0, r0);
    if (r0 + st < MROWS) P1_LOAD(P1, r0 + st);
    __syncthreads();
    f32x4 wr0[32];
#pragma unroll
    for (int q = 0; q < 32; ++q) wr0[q] = *(const LAS f32x4*)(wt + ((q >> 2) * 256 + (q & 3) * 64 + lane) * 4);
    for (int row = r0; row < MROWS; row += 2 * st) {
        { f32x4 v[4];
#pragma unroll
          for (int j = 0; j < 4; ++j) v[j] = P0[j];
          if (row + 2 * st < MROWS) P1_LOAD(P0, row + 2 * st);
          p1_row(wr0, v, row, lane, wt, nwl, mdl, XN, Gg, Bt, cA, cB); }
        if (row + st < MROWS) { f32x4 v[4];
#pragma unroll
          for (int j = 0; j < 4; ++j) v[j] = P1[j];
          if (row + 3 * st < MROWS) P1_LOAD(P1, row + 3 * st);
          p1_row(wr0, v, row + st, lane, wt, nwl, mdl, XN, Gg, Bt, cA, cB); }
    }
#undef P1_SRC
#undef P1_LOAD
}

__device__ __forceinline__ void qk_prep8(float (&f)[8], const float* nw, bool rope, int prow, int pcol, const float* RT, int c, float scale) {
    float ss = 0.f;
#pragma unroll
    for (int j = 0; j < 8; ++j) ss += f[j] * f[j];
    ss += __shfl_xor(ss, 1); ss += __shfl_xor(ss, 2); ss += __shfl_xor(ss, 4);
    const float rstd = __builtin_amdgcn_rsqf(ss * (1.0f / 64.0f) + 1e-6f);
#pragma unroll
    for (int j = 0; j < 8; ++j) f[j] = f[j] * rstd * nw[8 * c + j];
    const int pos = (c & 4) ? pcol : prow;
#pragma unroll
    for (int j = 0; j < 8; ++j) { const float p = __shfl_xor(f[j], 2);
        if (rope) { const int fi = 8 * (c & 1) + j; const float cs = RT[2 * (pos * 16 + fi)], sn = RT[2 * (pos * 16 + fi) + 1]; f[j] = f[j] * cs + ((c & 2) ? p * sn : -p * sn); } }
#pragma unroll
    for (int j = 0; j < 8; ++j) f[j] *= scale;
}
#define CONV2(i, o0, o1) do { float a0_ = 0.f, a1_ = 0.f; _Pragma("unroll") for (int j_ = 0; j_ < 5; ++j_) { a0_ += bflo(raw[(i) + j_]) * w0[j_]; a1_ += bfhi(raw[(i) + j_]) * w1[j_]; } \
    o0 = a0_ * __builtin_amdgcn_rcpf(1.0f + __expf(-a0_)); o1 = a1_ * __builtin_amdgcn_rcpf(1.0f + __expf(-a1_)); } while (0)
template <int TY> __device__ __forceinline__ void conv_item(Frame& F, int it, const float* conv_w_) {
    const bf16* PD = WSP(bf16, WS_PD); bf16* DQ = WSP(bf16, WS_DQ); bf16* DK = WSP(bf16, WS_DK); bf16* DKT = WSP(bf16, WS_DKT); bf16* DVT = WSP(bf16, WS_DVT);
    LAS bf16* tile = (LAS bf16*)(F.lds + F.wave * 16640);
    const int lane = F.lane;
    const int hh = it & 3, bn = it / 12, n = bn % 36, b = bn / 36;
    const int t0 = 64 * n, lo = (n < 4) ? 0 : CTXL, hi = (n < 4) ? CTXL : TOK;
    const int col = TY * 512 + hh * 128 + 2 * lane;
    float w0[5], w1[5];
#pragma unroll
    for (int j = 0; j < 5; ++j) { w0[j] = conv_w_[j * 1536 + col]; w1[j] = conv_w_[j * 1536 + col + 1]; }
    const bf16* ub = PD + (size_t)(b * TOK) * 1536 + TY * 512 + hh * 128;
    const int lo2 = 2 * lane;
    unsigned raw[68];
#pragma unroll
    for (int i = 0; i < 68; ++i) { const int tt = t0 - 2 + i; const bool ok = (tt >= lo) && (tt < hi); const bf16* rp = ub + (size_t)__builtin_amdgcn_readfirstlane(ok ? tt : t0) * 1536; const unsigned vv = *(const unsigned*)(rp + lo2); raw[i] = ok ? vv : 0u; }
    const int dpos = ((2 * lane) & ~15) | perm16((2 * lane) & 15);
    float scl = 1.0f;
    if (TY < 2) {
        LAS float* sst = (LAS float*)tile;
#pragma unroll
        for (int i = 0; i < 64; ++i) { float a0, a1; CONV2(i, a0, a1); sst[i * 65 + lane] = a0 * a0 + a1 * a1; }
        LDS_WAIT(); asm volatile("" ::: "memory");
        float tot = 0.f;
#pragma unroll
        for (int j = 0; j < 64; ++j) tot += sst[lane * 65 + j];
        LDS_WAIT(); asm volatile("" ::: "memory");
        scl = ((TY == 0) ? 0.08838834764831845f : 1.0f) * __builtin_amdgcn_rsqf(tot + 1e-6f);
    }
#pragma unroll
    for (int i = 0; i < 64; ++i) {
        float a0, a1; CONV2(i, a0, a1);
        if (TY < 2) { const float sc = __builtin_bit_cast(float, __builtin_amdgcn_readlane(__builtin_bit_cast(int, scl), i)); a0 *= sc; a1 *= sc; }
        const unsigned pk = cvtpk(a0, a1);
        if (TY == 0) *(unsigned*)(DQ + ((size_t)(b * 4 + hh) * TOK + t0 + i) * 128 + dpos) = pk;
        if (TY == 1) *(unsigned*)(DK + ((size_t)(b * 4 + hh) * TOK + t0 + i) * 128 + dpos) = pk;
        if (TY >= 1) *(LAS unsigned*)(tile + i * 130 + 2 * lane) = pk;
    }
    if (TY >= 1) {
        LDS_WAIT(); asm volatile("" ::: "memory");
        bf16* dst = (TY == 1 ? DKT : DVT) + (size_t)((b * 4 + hh) * 36 + n) * 8192;
#pragma unroll 4
        for (int q = 0; q < 16; ++q) { const int ch = q * 8 + (lane >> 3), j0 = 8 * (lane & 7); const LAS bf16* s = tile + ((j0 & ~15) + 4 * ((j0 >> 3) & 1)) * 130 + ch;
            v4u o; o.x = (unsigned)s[0] | ((unsigned)s[130] << 16); o.y = (unsigned)s[260] | ((unsigned)s[390] << 16); o.z = (unsigned)s[8 * 130] | ((unsigned)s[9 * 130] << 16); o.w = (unsigned)s[10 * 130] | ((unsigned)s[11 * 130] << 16);
            *(v4u*)(dst + ch * 64 + j0) = o; }
        LDS_WAIT(); asm volatile("" ::: "memory");
    }
}
__device__ __forceinline__ void p3_phase(Frame& F, const float* q_norm_w_, const float* k_norm_w_, const float* conv_w_, int rep) {
    bf16* PA = WSP(bf16, WS_PA); const float* RT = WSP(float, WS_ROPE);
    const int lane = F.lane;
    if (rep == 0 || rep == 2) {
        bf16* PAo = (rep == 2) ? WSP(bf16, WS_DO) : PA;
        LAS float* rtl = (LAS float*)(F.lds + 133120);
        for (int i = F.tid; i < 2048; i += 512) rtl[i] = RT[i];
        __syncthreads();
        for (int idx = blockIdx.x * 512 + F.tid; idx < MROWS * 2; idx += F.G * 512) {
            const int row = idx >> 1, hs = 8 + (idx & 1); const int b_ = row / TOK, t_ = row - b_ * TOK; const bool lat = t_ >= CTXL; const int tl = t_ - CTXL, prow = tl >> 6, pcol = tl & 63;
            bf16* p = PA + (size_t)row * 768 + (hs < 8 ? hs * 64 : 512 + (hs - 8) * 64);
            const float* nw = (hs < 8) ? q_norm_w_ : k_norm_w_;
            float f[64]; float ss = 0.f;
#pragma unroll
            for (int q = 0; q < 8; ++q) { const v4u raw = *(const v4u*)(p + 8 * q);
                f[8 * q] = bflo(raw.x); f[8 * q + 1] = bfhi(raw.x); f[8 * q + 2] = bflo(raw.y); f[8 * q + 3] = bfhi(raw.y); f[8 * q + 4] = bflo(raw.z); f[8 * q + 5] = bfhi(raw.z); f[8 * q + 6] = bflo(raw.w); f[8 * q + 7] = bfhi(raw.w); }
#pragma unroll
            for (int d = 0; d < 64; ++d) ss += f[d] * f[d];
            const float rstd = __builtin_amdgcn_rsqf(ss * (1.0f / 64.0f) + 1e-6f);
#pragma unroll
            for (int q = 0; q < 16; ++q) { const f32x4 w4 = *(const f32x4*)(nw + 4 * q); f[4 * q] *= rstd * w4.x; f[4 * q + 1] *= rstd * w4.y; f[4 * q + 2] *= rstd * w4.z; f[4 * q + 3] *= rstd * w4.w; }
            if (lat) {
#pragma unroll
                for (int a = 0; a < 2; ++a) { const int pos = a ? pcol : prow;
#pragma unroll
                    for (int fi = 0; fi < 16; ++fi) { const f32x2_t cs = *(const LAS f32x2_t*)(rtl + 2 * (pos * 16 + fi)); const float x1 = f[32 * a + fi], x2 = f[32 * a + 16 + fi];
                        f[32 * a + fi] = x1 * cs.x - x2 * cs.y; f[32 * a + 16 + fi] = x2 * cs.x + x1 * cs.y; } }
            }
            const float sc = (hs < 8) ? attn_body::C2 : 1.0f;
#pragma unroll
            for (int q = 0; q < 8; ++q) { v4u o; o.x = cvtpk(f[8 * q] * sc, f[8 * q + 1] * sc); o.y = cvtpk(f[8 * q + 2] * sc, f[8 * q + 3] * sc); o.z = cvtpk(f[8 * q + 4] * sc, f[8 * q + 5] * sc); o.w = cvtpk(f[8 * q + 6] * sc, f[8 * q + 7] * sc);
                *(v4u*)(PAo + (p - PA) + 8 * q) = o; }
        }
    }
    if (rep == 2) return;
    __syncthreads();
    for (int it = F.gw; it < NB * 36 * 12; it += F.NGW) {
        const int ty = (it >> 2) % 3;
        if (ty == 0) conv_item<0>(F, it, conv_w_); else if (ty == 1) conv_item<1>(F, it, conv_w_); else conv_item<2>(F, it, conv_w_);
    }
}

__device__ __forceinline__ f32x4 bmm16(const LAS float* A, const LAS float* B, f32x4 acc, int fr, int fq) {
#pragma unroll
    for (int s = 0; s < 4; ++s) acc = __builtin_amdgcn_mfma_f32_16x16x4f32(A[fr * 68 + 4 * s + fq], B[(4 * s + fq) * 68 + fr], acc, 0, 0, 0);
    return acc;
}
__device__ __forceinline__ void p4_phase(Frame& F) {
    const bf16* DQ = WSP(bf16, WS_DQ); const bf16* DK = WSP(bf16, WS_DK); const bf16* DKT = WSP(bf16, WS_DKT); const bf16* DVT = WSP(bf16, WS_DVT);
    const float* Gg = WSP(float, WS_G); const float* Bt = WSP(float, WS_BETA);
    bf16* QKD = WSP(bf16, WS_QKD);
    float* EG = WSP(float, WS_EG); float* EK = WSP(float, WS_EK); float* GL = WSP(float, WS_GLAST);
    LAS float* M = (LAS float*)(F.lds + F.wave * 17920);
    LAS float* gcv = M + 64 * 68;
    LAS float* btv = gcv + 64;
    const int lane = F.lane, fr = lane & 15, fq = lane >> 4;
    for (int task = F.gw; task < NB * 4 * 36 * 2; task += F.NGW) {
        int dir, n, bh;
        if (task < 2048) { dir = task & 1; n = 4 + ((task >> 1) & 31); bh = task >> 6; }
        else { const int t2 = task - 2048; dir = t2 & 1; n = (t2 >> 1) & 3; bh = t2 >> 3; }
        const int b = bh >> 2, hh = bh & 3;
        const size_t tokbase = (size_t)bh * TOK + 64 * n;
        const bf16* Kc = DK + tokbase * 128; const bf16* Qc = DQ + tokbase * 128;
        const size_t gbase = (size_t)(dir * 32 + bh) * TOK + 64 * n;
        const int rl = dir ? 63 - lane : lane;
        const float gl = Gg[gbase + rl], bl = Bt[gbase + rl];
        float gc = gl;
#pragma unroll
        for (int o = 1; o < 64; o <<= 1) { const float u = __shfl_up(gc, o); if (lane >= o) gc += u; }
        gcv[lane] = gc; btv[lane] = bl;
        const bool outc = n >= 4;
        LDS_WAIT(); asm volatile("" ::: "memory");
        bf16* qkd = QKD + ((size_t)(dir * 32 + bh) * 32 + (n - 4)) * 4096;
        bf16x8 kf[4][4], qfn[4];
#pragma unroll
        for (int rt = 0; rt < 4; ++rt) { const int i = 16 * rt + fr, ro = dir ? 63 - i : i;
#pragma unroll
            for (int ks = 0; ks < 4; ++ks) kf[rt][ks] = *(const bf16x8*)(Kc + ro * 128 + 32 * ks + 8 * fq); }
        { const int ro = dir ? 63 - fr : fr;
#pragma unroll
          for (int ks = 0; ks < 4; ++ks) qfn[ks] = *(const bf16x8*)(Qc + ro * 128 + 32 * ks + 8 * fq); }
#pragma unroll
        for (int rt = 0; rt < 4; ++rt) {
            bf16x8 qfr[4];
#pragma unroll
            for (int ks = 0; ks < 4; ++ks) qfr[ks] = qfn[ks];
            if (rt < 3) { const int i = 16 * (rt + 1) + fr, ro = dir ? 63 - i : i;
#pragma unroll
                for (int ks = 0; ks < 4; ++ks) qfn[ks] = *(const bf16x8*)(Qc + ro * 128 + 32 * ks + 8 * fq); }
#pragma unroll
            for (int ct = 0; ct < 4; ++ct) {
                const int iq = 16 * rt + fr, ioq = dir ? 63 - iq : iq;
                const int j0 = 16 * ct + 4 * fq, jo0 = dir ? 60 - j0 : j0;
                bf16* qdst = qkd + ioq * 64 + (jo0 & ~15) + perm16(jo0 & 15);
                if (ct > rt) { if (outc) *(u32x2*)qdst = (u32x2){0u, 0u}; continue; }
                f32x4 a = {0.f, 0.f, 0.f, 0.f}, q = {0.f, 0.f, 0.f, 0.f};
#pragma unroll
                for (int ks = 0; ks < 4; ++ks) { a = __builtin_amdgcn_mfma_f32_16x16x32_bf16(kf[rt][ks], kf[ct][ks], a, 0, 0, 0); if (outc) q = __builtin_amdgcn_mfma_f32_16x16x32_bf16(kf[ct][ks], qfr[ks], q, 0, 0, 0); }
                const int j = 16 * ct + fr; const float gj = gcv[j];
#pragma unroll
                for (int r = 0; r < 4; ++r) { const int i = 16 * rt + 4 * fq + r; const float dec = __expf(fminf(gcv[i] - gj, 0.f));
                    M[i * 68 + j] = (i > j) ? btv[i] * a[r] * dec : 0.f; }
                if (outc) { const float gi = gcv[iq]; float qv[4];
#pragma unroll
                    for (int r = 0; r < 4; ++r) { const int jj = j0 + r; qv[r] = (iq >= jj) ? q[r] * __expf(fminf(gi - gcv[jj], 0.f)) : 0.f; }
                    u32x2 w; if (dir) { w.x = cvtpk(qv[3], qv[2]); w.y = cvtpk(qv[1], qv[0]); } else { w.x = cvtpk(qv[0], qv[1]); w.y = cvtpk(qv[2], qv[3]); }
                    *(u32x2*)qdst = w; }
            }
        }
        LDS_WAIT(); asm volatile("" ::: "memory");
        {
            const int blk = fq, c = fr;
            float t[16];
            t[0] = (c == 0) ? 1.f : 0.f;
#pragma unroll
            for (int i = 1; i < 16; ++i) {
                const LAS float* rowp = M + (16 * blk + i) * 68 + 16 * blk;
                float acc = 0.f;
#pragma unroll
                for (int j4 = 0; j4 < (i + 3) / 4; ++j4) { const f32x4 av = *(const LAS f32x4*)(rowp + 4 * j4);
#pragma unroll
                    for (int jj = 0; jj < 4; ++jj) if (4 * j4 + jj < i) acc = fmaf(av[jj], t[4 * j4 + jj], acc); }
                t[i] = (c < i) ? -acc : ((c == i) ? 1.f : 0.f);
            }
            LDS_WAIT(); asm volatile("" ::: "memory");
#pragma unroll
            for (int i = 0; i < 16; ++i) M[(16 * blk + i) * 68 + 16 * blk + c] = t[i];
            LDS_WAIT(); asm volatile("" ::: "memory");
        }
#pragma unroll
        for (int k = 0; k < 3; ++k)
#pragma unroll
            for (int i = k + 1; i < 4; ++i) {
                f32x4 x = {0.f, 0.f, 0.f, 0.f};
#pragma unroll
                for (int j = k; j < i; ++j) x = bmm16(M + (16 * i) * 68 + 16 * j, M + (16 * j) * 68 + 16 * k, x, fr, fq);
                LAS float* scr = M + (16 * k) * 68 + 16 * i;
#pragma unroll
                for (int r = 0; r < 4; ++r) scr[(4 * fq + r) * 68 + fr] = x[r];
                LDS_WAIT(); asm volatile("" ::: "memory");
                f32x4 y = bmm16(M + (16 * i) * 68 + 16 * i, scr, (f32x4){0.f, 0.f, 0.f, 0.f}, fr, fq);
                LDS_WAIT(); asm volatile("" ::: "memory");
#pragma unroll
                for (int r = 0; r < 4; ++r) M[(16 * i + 4 * fq + r) * 68 + 16 * k + fr] = -y[r];
                LDS_WAIT(); asm volatile("" ::: "memory");
            }
        const float ej = __expf(gc);
        gcv[lane] = bl * ej;
        LDS_WAIT(); asm volatile("" ::: "memory");
        bf16x8 tuf[4][2], twf[4][2];
#pragma unroll
        for (int it = 0; it < 4; ++it) { const int io = 16 * it + fr, si = dir ? 63 - io : io;
#pragma unroll
            for (int ks = 0; ks < 2; ++ks) { unsigned pu[4], pw[4];
#pragma unroll
                for (int hf = 0; hf < 2; ++hf) { const int t0 = 32 * ks + 16 * (fq >> 1) + 4 * (fq & 1) + 8 * hf;
                    const int cb = dir ? 60 - t0 : t0;
                    const f32x4 tv = *(const LAS f32x4*)(M + si * 68 + cb), cu = *(const LAS f32x4*)(btv + cb), cw = *(const LAS f32x4*)(gcv + cb);
                    float u[4], w[4];
#pragma unroll
                    for (int e = 0; e < 4; ++e) { const int sc = cb + e; const float tt = (sc <= si) ? tv[e] : 0.f; u[e] = tt * cu[e]; w[e] = tt * cw[e]; }
                    if (dir) { pu[2 * hf] = cvtpk(u[3], u[2]); pu[2 * hf + 1] = cvtpk(u[1], u[0]); pw[2 * hf] = cvtpk(w[3], w[2]); pw[2 * hf + 1] = cvtpk(w[1], w[0]); }
                    else { pu[2 * hf] = cvtpk(u[0], u[1]); pu[2 * hf + 1] = cvtpk(u[2], u[3]); pw[2 * hf] = cvtpk(w[0], w[1]); pw[2 * hf + 1] = cvtpk(w[2], w[3]); } }
                tuf[it][ks] = __builtin_bit_cast(bf16x8, (v4u){pu[0], pu[1], pu[2], pu[3]}); twf[it][ks] = __builtin_bit_cast(bf16x8, (v4u){pw[0], pw[1], pw[2], pw[3]}); } }
        unsigned char* grp = wu_group(F, dir * 8 + b);
        bf16* WMg = (bf16*)(grp + (size_t)(hh * 36 + n) * 16384); bf16* UMg = (bf16*)(grp + 4608 * 1024 + (size_t)(hh * 36 + n) * 16384);
        const bf16* KTg = DKT + ((size_t)bh * 36 + n) * 8192; const bf16* VTg = DVT + ((size_t)bh * 36 + n) * 8192;
        {
#pragma unroll
          for (int d4 = 0; d4 < 8; d4 += 4) {
            bf16x8 ktf[4][2];
#pragma unroll
            for (int dt = 0; dt < 4; ++dt) { ktf[dt][0] = *(const bf16x8*)(KTg + (16 * (d4 + dt) + fr) * 64 + 8 * fq); ktf[dt][1] = *(const bf16x8*)(KTg + (16 * (d4 + dt) + fr) * 64 + 32 + 8 * fq); }
#pragma unroll
            for (int dq = 0; dq < 4; ++dq)
#pragma unroll
                for (int it = 0; it < 4; ++it) { const int dt = d4 + dq; f32x4 c = __builtin_amdgcn_mfma_f32_16x16x32_bf16(ktf[dq][0], twf[it][0], (f32x4){0.f, 0.f, 0.f, 0.f}, 0, 0, 0);
                    c = __builtin_amdgcn_mfma_f32_16x16x32_bf16(ktf[dq][1], twf[it][1], c, 0, 0, 0);
                    u32x2 w; w.x = cvtpk(c[0], c[1]); w.y = cvtpk(c[2], c[3]);
                    *(u32x2*)(WMg + (16 * it + fr) * 128 + 16 * dt + perm16(4 * fq)) = w; }
            asm volatile("" ::: "memory");
          }
        }
        {
#pragma unroll
          for (int v4 = 0; v4 < 8; v4 += 4) {
            bf16x8 vtf[4][2];
#pragma unroll
            for (int vt = 0; vt < 4; ++vt) { vtf[vt][0] = *(const bf16x8*)(VTg + (16 * (v4 + vt) + fr) * 64 + 8 * fq); vtf[vt][1] = *(const bf16x8*)(VTg + (16 * (v4 + vt) + fr) * 64 + 32 + 8 * fq); }
#pragma unroll
            for (int vq = 0; vq < 4; ++vq)
#pragma unroll
                for (int it = 0; it < 4; ++it) { const int vt = v4 + vq; f32x4 c = __builtin_amdgcn_mfma_f32_16x16x32_bf16(tuf[it][0], vtf[vq][0], (f32x4){0.f, 0.f, 0.f, 0.f}, 0, 0, 0);
                    c = __builtin_amdgcn_mfma_f32_16x16x32_bf16(tuf[it][1], vtf[vq][1], c, 0, 0, 0);
                    u32x2 w; w.x = cvtpk(c[0], c[1]); w.y = cvtpk(c[2], c[3]);
                    const int q = 2 * (it & 1) + (fq >> 1), h = fq & 1;
                    *(u32x2*)(UMg + (size_t)(((it >> 1) * 4 + (vt >> 1)) * 64 + 32 * h + 16 * (vt & 1) + fr) * 16 + 4 * q) = w; }
            asm volatile("" ::: "memory");
          }
        }
        const float glast = __shfl(gc, 63);
        EG[gbase + rl] = ej; EK[gbase + rl] = __expf(glast - gc);
        if (lane == 0) GL[(size_t)(dir * 32 + bh) * 36 + n] = __expf(glast);
        LDS_WAIT(); asm volatile("" ::: "memory");
    }
}

#define MFMA32(a, b, c) __builtin_amdgcn_mfma_f32_32x32x16_bf16((a), (b), (c), 0, 0, 0)
constexpr int SB_WQ = 0, SB_KT = 34816, SB_QK = 53248, SB_EG = 62464, SB_EK = 62720, SB_BYTES = 62976;
__device__ __forceinline__ bf16x8 pack8(const f32x16& x, int s) {
    v4u p; p.x = cvtpk(x[8 * s], x[8 * s + 1]); p.y = cvtpk(x[8 * s + 2], x[8 * s + 3]); p.z = cvtpk(x[8 * s + 4], x[8 * s + 5]); p.w = cvtpk(x[8 * s + 6], x[8 * s + 7]);
    return __builtin_bit_cast(bf16x8, p);
}
__device__ __forceinline__ void dn_scan(Frame& F, int chain) {
    const int dir = chain & 1, bh = chain >> 1, b = bh >> 2, hh = bh & 3;
    const bf16* DQ = WSP(bf16, WS_DQ); const bf16* DKT = WSP(bf16, WS_DKT); const bf16* QKg = WSP(bf16, WS_QKD);
    const float* EG = WSP(float, WS_EG); const float* EK = WSP(float, WS_EK); const float* GL = WSP(float, WS_GLAST);
    unsigned char* grp = wu_group(F, dir * 8 + b);
    const int tid = F.tid, lane = F.lane, w = F.wave;
#define SCAN_N(step) (((step) < 4) ? (dir ? 3 - (step) : (step)) : (dir ? 39 - (step) : (step)))
    if (w >= 4) {
        const int lt = tid - 256;
        for (int step = -1; step < 35; ++step) {
            const int n = SCAN_N(step + 1); const bool outc = n >= 4;
            LAS unsigned char* B = F.lds + ((step + 1) & 1) * SB_BYTES;
            const bf16* wm = (const bf16*)(grp + (size_t)(hh * 36 + n) * 16384);
            const bf16* qg = DQ + ((size_t)bh * TOK + 64 * n) * 128;
            const bf16* kt = DKT + ((size_t)bh * 36 + n) * 8192;
            const bf16* qk = QKg + ((size_t)(dir * 32 + bh) * 32 + (n - 4)) * 4096;
            v4u rw[4], rq[4], rk[4], rx[2]; float ev = 0.f;
#pragma unroll
            for (int q = 0; q < 4; ++q) { const int p = lt + 256 * q; rw[q] = *(const v4u*)(wm + p * 8); rk[q] = *(const v4u*)(kt + p * 8); if (outc) rq[q] = *(const v4u*)(qg + p * 8); }
            if (outc) {
#pragma unroll
                for (int q = 0; q < 2; ++q) rx[q] = *(const v4u*)(qk + (lt + 256 * q) * 8); }
            if (lt < 64) ev = EG[(size_t)(dir * 32 + bh) * TOK + 64 * n + lt]; else if (lt < 128) ev = EK[(size_t)(dir * 32 + bh) * TOK + 64 * n + lt - 64];
#pragma unroll
            for (int q = 0; q < 4; ++q) { const int p = lt + 256 * q;
                *(LAS v4u*)(B + SB_WQ + (p >> 4) * 272 + (p & 15) * 16) = rw[q];
                *(LAS v4u*)(B + SB_KT + (p >> 3) * 144 + (p & 7) * 16) = rk[q];
                if (outc) *(LAS v4u*)(B + SB_WQ + (64 + (p >> 4)) * 272 + (p & 15) * 16) = rq[q]; }
            if (outc) {
#pragma unroll
                for (int q = 0; q < 2; ++q) { const int p = lt + 256 * q; *(LAS v4u*)(B + SB_QK + (p >> 3) * 144 + (p & 7) * 16) = rx[q]; } }
            if (lt < 128) *(LAS float*)(B + SB_EG + lt * 4) = ev;
            asm volatile("s_waitcnt vmcnt(0) lgkmcnt(0)" ::: "memory");
            __builtin_amdgcn_s_barrier();
            asm volatile("" ::: "memory");
        }
    } else {
        const int r = lane & 31, h = lane >> 5, vs = w;
        bf16* DOb = WSP(bf16, WS_DO) + (size_t)dir * NLAT * 512;
        f32x16 sacc[4]; bf16x8 Sb[8];
#pragma unroll
        for (int q = 0; q < 4; ++q)
#pragma unroll
            for (int e = 0; e < 16; ++e) sacc[q][e] = 0.f;
#pragma unroll
        for (int q = 0; q < 8; ++q) Sb[q] = (bf16x8){0, 0, 0, 0, 0, 0, 0, 0};
        v4u umn[2][2]; float glast_n;
        { const int n0 = SCAN_N(0); const bf16* um = (const bf16*)(grp + 4608 * 1024 + (size_t)(hh * 36 + n0) * 16384);
#pragma unroll
          for (int it = 0; it < 2; ++it) { const v4u* up = (const v4u*)(um + (size_t)((it * 4 + vs) * 64 + lane) * 16); umn[it][0] = up[0]; umn[it][1] = up[1]; }
          glast_n = GL[(size_t)(dir * 32 + bh) * 36 + n0]; }
        for (int step = 0; step < 36; ++step) {
            const int n = SCAN_N(step); const bool outc = n >= 4;
            asm volatile("s_waitcnt lgkmcnt(0)" ::: "memory");
            __builtin_amdgcn_s_barrier();
            asm volatile("" ::: "memory");
            const LAS unsigned char* B = F.lds + (step & 1) * SB_BYTES;
            v4u um[2][2]; um[0][0] = umn[0][0]; um[0][1] = umn[0][1]; um[1][0] = umn[1][0]; um[1][1] = umn[1][1];
            const float glast = glast_n;
            if (step + 1 < 36) { const int n1 = SCAN_N(step + 1); const bf16* umg = (const bf16*)(grp + 4608 * 1024 + (size_t)(hh * 36 + n1) * 16384);
#pragma unroll
                for (int it = 0; it < 2; ++it) { const v4u* up = (const v4u*)(umg + (size_t)((it * 4 + vs) * 64 + lane) * 16); umn[it][0] = up[0]; umn[it][1] = up[1]; }
                glast_n = GL[(size_t)(dir * 32 + bh) * 36 + n1]; }
            bf16x8 Vnb[4], Vsb[4]; f32x16 oacc[2];
#pragma unroll
            for (int it = 0; it < 2; ++it) {
                f32x16 ws;
#pragma unroll
                for (int e = 0; e < 16; ++e) ws[e] = 0.f;
                const LAS unsigned char* ap = B + SB_WQ + (32 * it + r) * 272 + h * 16;
#pragma unroll
                for (int s = 0; s < 8; ++s) ws = MFMA32(*(const LAS bf16x8*)(ap + s * 32), Sb[s], ws);
                f32x16 vn, vsc;
#pragma unroll
                for (int q = 0; q < 2; ++q) { const v4u uu = um[it][q];
                    vn[8 * q + 0] = bflo(uu.x) - ws[8 * q + 0]; vn[8 * q + 1] = bfhi(uu.x) - ws[8 * q + 1]; vn[8 * q + 2] = bflo(uu.y) - ws[8 * q + 2]; vn[8 * q + 3] = bfhi(uu.y) - ws[8 * q + 3];
                    vn[8 * q + 4] = bflo(uu.z) - ws[8 * q + 4]; vn[8 * q + 5] = bfhi(uu.z) - ws[8 * q + 5]; vn[8 * q + 6] = bflo(uu.w) - ws[8 * q + 6]; vn[8 * q + 7] = bfhi(uu.w) - ws[8 * q + 7]; }
#pragma unroll
                for (int q = 0; q < 4; ++q) { const f32x4 ek = *(const LAS f32x4*)(B + SB_EK + (32 * it + 8 * q + 4 * h) * 4);
#pragma unroll
                    for (int e = 0; e < 4; ++e) vsc[4 * q + e] = vn[4 * q + e] * ek[e]; }
                Vnb[2 * it] = pack8(vn, 0); Vnb[2 * it + 1] = pack8(vn, 1); Vsb[2 * it] = pack8(vsc, 0); Vsb[2 * it + 1] = pack8(vsc, 1);
                if (outc) {
                    f32x16 qs;
#pragma unroll
                    for (int e = 0; e < 16; ++e) qs[e] = 0.f;
                    const LAS unsigned char* qp = B + SB_WQ + (64 + 32 * it + r) * 272 + h * 16;
#pragma unroll
                    for (int s = 0; s < 8; ++s) qs = MFMA32(*(const LAS bf16x8*)(qp + s * 32), Sb[s], qs);
#pragma unroll
                    for (int q = 0; q < 4; ++q) { const f32x4 eg = *(const LAS f32x4*)(B + SB_EG + (32 * it + 8 * q + 4 * h) * 4);
#pragma unroll
                        for (int e = 0; e < 4; ++e) oacc[it][4 * q + e] = qs[4 * q + e] * eg[e]; }
                }
            }
            if (outc) {
#pragma unroll
                for (int it = 0; it < 2; ++it) {
                    const LAS unsigned char* ap = B + SB_QK + (32 * it + r) * 144 + h * 16;
#pragma unroll
                    for (int s = 0; s < 4; ++s) oacc[it] = MFMA32(*(const LAS bf16x8*)(ap + s * 32), Vnb[s], oacc[it]);
                    bf16* op = DOb + ((size_t)b * SEQL + 64 * (n - 4) + 32 * it + 4 * h) * 512 + hh * 128 + 32 * vs + r;
#pragma unroll
                    for (int e = 0; e < 16; ++e) op[(size_t)((e & 3) + 8 * (e >> 2)) * 512] = (bf16)(cvtpk(oacc[it][e], 0.f) & 0xffffu);
                }
            }
#pragma unroll
            for (int dt = 0; dt < 4; ++dt) {
#pragma unroll
                for (int e = 0; e < 16; ++e) sacc[dt][e] *= glast;
                const LAS unsigned char* ap = B + SB_KT + (32 * dt + r) * 144 + h * 16;
#pragma unroll
                for (int s = 0; s < 4; ++s) sacc[dt] = MFMA32(*(const LAS bf16x8*)(ap + s * 32), Vsb[s], sacc[dt]);
                Sb[2 * dt] = pack8(sacc[dt], 0); Sb[2 * dt + 1] = pack8(sacc[dt], 1);
            }
        }
    }
#undef SCAN_N
    asm volatile("s_waitcnt vmcnt(0)" ::: "memory");
    __syncthreads();
    if (F.tid == 0) {
        __builtin_amdgcn_fence(__ATOMIC_RELEASE, "agent");
        asm volatile("s_waitcnt vmcnt(0)" ::: "memory");
        (void)__hip_atomic_fetch_add(F.ctl + CW_SCAN, 1u, RLX_AGENT);
    }
}
__device__ __forceinline__ void p6_phase(Frame& F, const float* o_norm_w_, const int rbeg, const int rend, const int rstep);
__device__ __forceinline__ void p5_phase(Frame& F, int rep, const float* qnw_, const float* o_norm_w_) {
    if (blockIdx.x >= 192 && rep != 2) {
        const int chain = (int)blockIdx.x - 192;
        if (F.tid == 0) { unsigned sp = 0u;
            while (__hip_atomic_load(F.ctl + CW_CHAIN + chain, RLX_AGENT) < 36u && ++sp < (1u << 22)) __builtin_amdgcn_s_sleep(4);
            __builtin_amdgcn_fence(__ATOMIC_ACQUIRE, "agent");
            asm volatile("s_waitcnt vmcnt(0)" ::: "memory"); }
        __syncthreads();
        dn_scan(F, chain);
    }
    if (rep == 1) return;
    const attn_body::bf16* PA = (const attn_body::bf16*)WSP(bf16, WS_PA); attn_body::bf16* Y = (attn_body::bf16*)WSP(bf16, WS_Y);
    for (;;) {
        __syncthreads();
        if (F.tid == 0) F.MISC[0] = __hip_atomic_fetch_add(F.ctl + CW_ATTNQ + 64 * rep, 1u, RLX_AGENT);
        __syncthreads();
        const int u = (int)F.MISC[0];
        if (u >= 512) break;
        const int b = u >> 6, hq = (u >> 3) & 7, qb = u & 7;
        attn_body::attn_unit<8>(PA + ((size_t)b * TOK + CTXL + qb * 256) * 768 + hq * 64, PA + (size_t)b * TOK * 768 + 512 + (hq >> 2) * 64, PA + (size_t)b * TOK * 768 + 640 + (hq >> 2) * 64,
                                Y + ((size_t)b * SEQL + qb * 256) * 1024 + hq * 64, (char*)F.ldsg, qnw_, WSP(float, WS_ROPE), qb * 256);
    }
    __syncthreads();
    if (rep != 0) return;
    if (F.tid == 0) { unsigned sp = 0u;
        while (__hip_atomic_load(F.ctl + CW_SCAN, RLX_AGENT) < 64u && ++sp < (1u << 22)) __builtin_amdgcn_s_sleep(4);
        __builtin_amdgcn_fence(__ATOMIC_ACQUIRE, "agent");
        asm volatile("s_waitcnt vmcnt(0)" ::: "memory"); }
    __syncthreads();
    for (;;) {
        __syncthreads();
        if (F.tid == 0) F.MISC[0] = __hip_atomic_fetch_add(F.ctl + CW_P6Q, 1u, RLX_AGENT);
        __syncthreads();
        const int c = (int)F.MISC[0];
        if (c >= NLAT / 64) break;
        p6_phase(F, o_norm_w_, c * 64 + F.wave, c * 64 + 64, 8);
    }
}


__device__ __forceinline__ void p6_phase(Frame& F, const float* o_norm_w_, const int rbeg, const int rend, const int rstep) {
    const bf16* DO = WSP(bf16, WS_DO); const bf16* PZ = WSP(bf16, WS_PZ); bf16* Y = WSP(bf16, WS_Y);
    const int lane = F.lane;
    const int ch = (8 * lane) & 127;
    const f32x4 w0 = *(const f32x4*)(o_norm_w_ + ch), w1 = *(const f32x4*)(o_norm_w_ + ch + 4);
    v4u nr0, nr1, nzr;
    if (rbeg < rend) { const int row = rbeg, b = row >> 11, t = row & 2047; nr0 = *(const v4u*)(DO + (size_t)row * 512 + 8 * lane); nr1 = *(const v4u*)(DO + (size_t)(NLAT + row) * 512 + 8 * lane);
        nzr = *(const v4u*)(PZ + ((size_t)b * TOK + CTXL + t) * 512 + 8 * lane); }
    for (int row = rbeg; row < rend; row += rstep) {
        const v4u r0 = nr0, r1 = nr1, zr = nzr;
        if (row + rstep < rend) { const int row2 = row + rstep, b = row2 >> 11, t = row2 & 2047; nr0 = *(const v4u*)(DO + (size_t)row2 * 512 + 8 * lane); nr1 = *(const v4u*)(DO + (size_t)(NLAT + row2) * 512 + 8 * lane);
            nzr = *(const v4u*)(PZ + ((size_t)b * TOK + CTXL + t) * 512 + 8 * lane); }
        const f32x4 a0 = {bflo(r0.x) + bflo(r1.x), bfhi(r0.x) + bfhi(r1.x), bflo(r0.y) + bflo(r1.y), bfhi(r0.y) + bfhi(r1.y)}, a1 = {bflo(r0.z) + bflo(r1.z), bfhi(r0.z) + bfhi(r1.z), bflo(r0.w) + bflo(r1.w), bfhi(r0.w) + bfhi(r1.w)};
        float ss = (a0.x * a0.x + a0.y * a0.y) + (a0.z * a0.z + a0.w * a0.w) + (a1.x * a1.x + a1.y * a1.y) + (a1.z * a1.z + a1.w * a1.w);
        ss = row16_sum(ss);
        const float rstd = __builtin_amdgcn_rsqf(ss * (1.0f / 128.0f) + 1e-6f);
        const float z[8] = {bflo(zr.x), bfhi(zr.x), bflo(zr.y), bfhi(zr.y), bflo(zr.z), bfhi(zr.z), bflo(zr.w), bfhi(zr.w)};
        float y[8] = {a0.x * rstd * w0.x, a0.y * rstd * w0.y, a0.z * rstd * w0.z, a0.w * rstd * w0.w, a1.x * rstd * w1.x, a1.y * rstd * w1.y, a1.z * rstd * w1.z, a1.w * rstd * w1.w};
#pragma unroll
        for (int j = 0; j < 8; ++j) y[j] *= z[j] / (1.0f + __expf(-z[j]));
        v4u o; o.x = pk2(y[0], y[1]); o.y = pk2(y[2], y[3]); o.z = pk2(y[4], y[5]); o.w = pk2(y[6], y[7]);
        *(v4u*)(Y + (size_t)row * 1024 + 512 + 8 * lane) = o;
    }
}

__device__ __forceinline__ void p9_phase(Frame& F);
__device__ __forceinline__ void p8_row(const f32x4 (&wr0)[16], const f32x4 (&v)[4], int row, int lane, const LAS float* wt, const LAS float* nwl, const LAS float* mdl, bf16* H2, float* AFF) {
    const int b = row >> 11, t = row & 2047;
    const LAS float* mod = mdl + b * 2048;
    float ss = 0.f;
#pragma unroll
    for (int j = 0; j < 4; ++j) ss += (v[j].x * v[j].x + v[j].y * v[j].y) + (v[j].z * v[j].z + v[j].w * v[j].w);
    const float rstd = __builtin_amdgcn_rsqf(wave_sum(ss) * (1.0f / 1024.0f) + 1e-6f);
    f32x4 acc4[4];
#pragma unroll
    for (int e = 0; e < 4; ++e) acc4[e] = (f32x4){0.f, 0.f, 0.f, 0.f};
#pragma unroll
    for (int j = 0; j < 4; ++j) { const int k = 4 * lane + 256 * j;
        const f32x4 nw = *(const LAS f32x4*)(nwl + k), sh = *(const LAS f32x4*)(mod + k), sc = *(const LAS f32x4*)(mod + 1024 + k);
        const f32x4 h = (v[j] * rstd) * nw * (sc + 1.0f) + sh;
        u32x2 w; w.x = cvtpk(h.x, h.y); w.y = cvtpk(h.z, h.w); *(u32x2*)(H2 + (size_t)row * 1024 + k) = w;
#pragma unroll
        for (int c = 0; c < 4; ++c) { const float hk = h[c];
            if (j < 1) {
#pragma unroll
                for (int e4 = 0; e4 < 4; ++e4) acc4[e4] += wr0[c * 4 + e4] * hk;
            } else { const LAS f32x4* wp = (const LAS f32x4*)(wt + ((c + 4 * j) * 256 + lane) * 4);
#pragma unroll
                for (int e4 = 0; e4 < 4; ++e4) acc4[e4] += wp[e4 * 64] * hk; } }
        asm volatile("" ::: "memory"); }
    float acc[16];
#pragma unroll
    for (int e = 0; e < 16; ++e) acc[e] = acc4[e >> 2][e & 3];
    const float val = reduce16(acc, lane);
    float lg[16]; float mx = -3.0e38f;
#pragma unroll
    for (int e = 0; e < 16; ++e) { lg[e] = __shfl(val, e << 2); mx = fmaxf(mx, lg[e]); }
    float sum = 0.f;
#pragma unroll
    for (int e = 0; e < 16; ++e) { lg[e] = __expf(lg[e] - mx); sum += lg[e]; }
    float mine = 0.f;
#pragma unroll
    for (int e = 0; e < 16; ++e) mine = (lane == e) ? lg[e] : mine;
    if (lane < 16) AFF[((size_t)b * 16 + lane) * 2048 + t] = mine / sum;
}
__device__ __forceinline__ void p8_phase(Frame& F, const float* norm2_w_, const float* router_w_, const float* w_gate_, const float* w_up_, const float* w_down_, const float* x_) {
    LAS float* wt = (LAS float*)F.lds;
    LAS float* nwl = wt + 16384;
    LAS float* mdl = nwl + 1024;
    const float* MOD = WSP(float, WS_MOD); bf16* H2 = WSP(bf16, WS_H2); float* AFF = WSP(float, WS_AFF);
    {
        f32x4 tw[8], tm[8], tn;
#pragma unroll
        for (int q = 0; q < 8; ++q) { const int idx = F.tid + 512 * q; tw[q] = *(const f32x4*)(router_w_ + 4 * idx); }
#pragma unroll
        for (int q = 0; q < 8; ++q) { const int idx = F.tid + 512 * q; tm[q] = *(const f32x4*)(MOD + (size_t)(idx >> 9) * 6144 + 3072 + (idx & 511) * 4); }
        tn = *(const f32x4*)(norm2_w_ + 4 * (F.tid & 255));
#pragma unroll
        for (int q = 0; q < 8; ++q) { const int idx = F.tid + 512 * q, k = idx >> 2, e4 = idx & 3; *(LAS f32x4*)(wt + ((((k & 3) + 4 * (k >> 8)) * 4 + e4) * 64 + ((k & 255) >> 2)) * 4) = tw[q]; }
#pragma unroll
        for (int q = 0; q < 8; ++q) { const int idx = F.tid + 512 * q; *(LAS f32x4*)(mdl + (idx >> 9) * 2048 + (idx & 511) * 4) = tm[q]; }
        if (F.tid < 256) *(LAS f32x4*)(nwl + 4 * F.tid) = tn;
    }
    const int lane = F.lane;
    const bf16* YL = WSP(bf16, WS_XG);
#define P8_LOAD(P, row) do { _Pragma("unroll") for (int j_ = 0; j_ < 4; ++j_) P[j_] = *(const f32x4*)(x_ + (size_t)(row) * 1024 + 4 * lane + 256 * j_); } while (0)
#define P8_LOADY(Y, row) do { _Pragma("unroll") for (int j_ = 0; j_ < 4; ++j_) Y[j_] = *(const u32x2*)(YL + (size_t)(row) * 1024 + 4 * lane + 256 * j_); } while (0)
#define P8_ADDY(v, Y) do { _Pragma("unroll") for (int j_ = 0; j_ < 4; ++j_) { v[j_].x += bflo(Y[j_].x); v[j_].y += bfhi(Y[j_].x); v[j_].z += bflo(Y[j_].y); v[j_].w += bfhi(Y[j_].y); } } while (0)
    {
        f32x4 P0[4], P1[4]; u32x2 Y0[4], Y1[4];
        const int r0 = F.gw, st = F.NGW;
        if (r0 < NLAT) { P8_LOAD(P0, r0); P8_LOADY(Y0, r0); }
        if (r0 + st < NLAT) { P8_LOAD(P1, r0 + st); P8_LOADY(Y1, r0 + st); }
        __syncthreads();
        f32x4 wr0[16];
#pragma unroll
        for (int q = 0; q < 16; ++q) wr0[q] = *(const LAS f32x4*)(wt + ((q >> 2) * 256 + (q & 3) * 64 + lane) * 4);
        for (int row = r0; row < NLAT; row += 2 * st) {
            { f32x4 v[4];
#pragma unroll
              for (int j = 0; j < 4; ++j) v[j] = P0[j];
              P8_ADDY(v, Y0);
              if (row + 2 * st < NLAT) { P8_LOAD(P0, row + 2 * st); P8_LOADY(Y0, row + 2 * st); }
              p8_row(wr0, v, row, lane, wt, nwl, mdl, H2, AFF); }
            if (row + st < NLAT) { f32x4 v[4];
#pragma unroll
              for (int j = 0; j < 4; ++j) v[j] = P1[j];
              P8_ADDY(v, Y1);
              if (row + 3 * st < NLAT) { P8_LOAD(P1, row + 3 * st); P8_LOADY(Y1, row + 3 * st); }
              p8_row(wr0, v, row + st, lane, wt, nwl, mdl, H2, AFF); }
        }
    }
#undef P8_LOAD
#undef P8_LOADY
#undef P8_ADDY
    asm volatile("s_waitcnt vmcnt(0)" ::: "memory");
    __syncthreads();
    if (F.tid == 0) {
        __builtin_amdgcn_fence(__ATOMIC_RELEASE, "agent");
        asm volatile("s_waitcnt vmcnt(0)" ::: "memory");
        (void)__hip_atomic_fetch_add(F.ctl + CW_ROWS, 1u, RLX_AGENT);
        if (blockIdx.x < 128) { unsigned sp = 0u;
            while (__hip_atomic_load(F.ctl + CW_ROWS, RLX_AGENT) < (unsigned)F.G && ++sp < (1u << 22)) __builtin_amdgcn_s_sleep(4);
            __builtin_amdgcn_fence(__ATOMIC_ACQUIRE, "agent");
            asm volatile("s_waitcnt vmcnt(0)" ::: "memory"); }
    }
    __syncthreads();
    if (blockIdx.x < 128) p9_phase(F);
    LAS float* scr = (LAS float*)(F.lds + 65536 + F.wave * 8448);
    bf16* WGU = WSP(bf16, WS_WGU); bf16* WD = WSP(bf16, WS_WD);
#ifndef P8_NOCONV
    {
        auto item_src = [&](int it, int& k0, int& n0, bf16*& dst) -> const float* {
            const int ty = it / 8192, r = it % 8192, e = r >> 9, kb = (r & 511) >> 5, nb = r & 31; n0 = 32 * nb; k0 = 64 * kb;
            if (ty == 0) { dst = WGU + ((size_t)e * 2048 + 256 * (n0 >> 7) + (n0 & 127)) * 1024 + k0; return w_gate_ + (size_t)e * 1048576; }
            if (ty == 1) { dst = WGU + ((size_t)e * 2048 + 256 * (n0 >> 7) + 128 + (n0 & 127)) * 1024 + k0; return w_up_ + (size_t)e * 1048576; }
            dst = WD + ((size_t)e * 1024 + n0) * 1024 + k0; return w_down_ + (size_t)e * 1048576; };
        constexpr int NIT = 3 * 16 * 512;
        f32x4 lA[8], lB[8]; const int st = 1;
#define CV_LOAD(L, it_) do { int k_, n_; bf16* d_; const float* W_ = item_src((it_), k_, n_, d_); _Pragma("unroll") for (int i_ = 0; i_ < 8; ++i_) L[i_] = __builtin_nontemporal_load((const f32x4*)(W_ + (size_t)(k_ + 8 * i_ + (F.lane >> 3)) * 1024 + n_ + 4 * (F.lane & 7))); } while (0)
#define CV_ITEM(L, it_, more_) do { int k0, n0; bf16* dst; (void)item_src((it_), k0, n0, dst); \
            _Pragma("unroll") for (int i_ = 0; i_ < 8; ++i_) { LAS float* d = scr + (8 * i_ + (F.lane >> 3)) * 33 + 4 * (F.lane & 7); d[0] = L[i_].x; d[1] = L[i_].y; d[2] = L[i_].z; d[3] = L[i_].w; } \
            if (more_) CV_LOAD(L, (it_) + 2 * st); \
            LDS_WAIT(); asm volatile("" ::: "memory"); \
            const int c = F.lane & 7; \
            _Pragma("unroll") for (int j = 0; j < 4; ++j) { const int n = (F.lane >> 3) + 8 * j; const LAS float* sp = scr + (8 * c) * 33 + n; \
                v4u o; o.x = cvtpk(sp[0 * 33], sp[1 * 33]); o.y = cvtpk(sp[2 * 33], sp[3 * 33]); o.z = cvtpk(sp[4 * 33], sp[5 * 33]); o.w = cvtpk(sp[6 * 33], sp[7 * 33]); \
                *(GAS v4u*)(dst + (size_t)n * 1024 + 8 * c) = o; } \
            LDS_WAIT(); asm volatile("" ::: "memory"); } while (0)
        const int cnt = (F.gw < 1024) ? 10 : 14, it0 = (F.gw < 1024) ? F.gw * 10 : 10240 + (F.gw - 1024) * 14;
        CV_LOAD(lA, it0); CV_LOAD(lB, it0 + 1);
        for (int q = 0; q < cnt; q += 2) {
            CV_ITEM(lA, it0 + q, q + 2 < cnt);
            CV_ITEM(lB, it0 + q + 1, q + 3 < cnt);
        }
#undef CV_LOAD
#undef CV_ITEM
    }
#endif
}

__device__ __forceinline__ void p9_phase(Frame& F) {
    const float* AFF = WSP(float, WS_AFF); int* IDX = WSP(int, WS_IDX); float* GATE = WSP(float, WS_GATE); int* INV = WSP(int, WS_INV);
    int* XROW = WSP(int, WS_XROW);
    LAS unsigned long long* keys = (LAS unsigned long long*)F.lds;
    for (int be = blockIdx.x; be < 128; be += F.G) {
        const int b = be >> 4, e = be & 15;
        const float* a = AFF + (size_t)be * 2048;
        __syncthreads();
        { float av[4];
#pragma unroll
          for (int q = 0; q < 4; ++q) av[q] = a[F.tid + 512 * q];
#pragma unroll
          for (int q = 0; q < 4; ++q) { const int i = F.tid + 512 * q; keys[i] = ((unsigned long long)__builtin_bit_cast(unsigned, av[q]) << 32) | (unsigned long long)(0xFFFFFFFFu - (unsigned)i); } }
        __syncthreads();
        for (int k = 2; k <= 2048; k <<= 1)
            for (int j = k >> 1; j > 0; j >>= 1) {
#pragma unroll
                for (int q = 0; q < 2; ++q) { const int p = F.tid + 512 * q; const int i = ((p & ~(j - 1)) << 1) | (p & (j - 1)), ix = i | j;
                    const unsigned long long x = keys[i], y = keys[ix]; const bool desc = (i & k) == 0;
                    if ((x < y) == desc) { keys[i] = y; keys[ix] = x; } }
                __syncthreads();
            }
        for (int p = F.tid; p < 2048; p += 512) { const unsigned long long kk = keys[p]; const int tok = (int)(0xFFFFFFFFu - (unsigned)(kk & 0xFFFFFFFFull));
                if (p < 256) { IDX[be * 256 + p] = tok; GATE[be * 256 + p] = __builtin_bit_cast(float, (unsigned)(kk >> 32)); XROW[(e * 8 + b) * 256 + p] = b * 2048 + tok; }
                INV[((size_t)b * 2048 + tok) * 16 + e] = (p < 256) ? p : -1; }
    }
    __syncthreads();
}

#define ACC16(p, q) do { acc[0] += bflo(p.x); acc[1] += bfhi(p.x); acc[2] += bflo(p.y); acc[3] += bfhi(p.y); acc[4] += bflo(p.z); acc[5] += bfhi(p.z); acc[6] += bflo(p.w); acc[7] += bfhi(p.w); \
    acc[8] += bflo(q.x); acc[9] += bfhi(q.x); acc[10] += bflo(q.y); acc[11] += bfhi(q.y); acc[12] += bflo(q.z); acc[13] += bfhi(q.z); acc[14] += bflo(q.w); acc[15] += bfhi(q.w); } while (0)
__device__ __forceinline__ void p13_phase(Frame& F, int rep, const float* x_) {
    const bf16* YB = WSP(bf16, WS_YB); const int* INV = WSP(int, WS_INV); const float* MOD = WSP(float, WS_MOD);
    const int lane = F.lane;
    const bf16* YL = WSP(bf16, WS_XG);
    int ninv = -1; f32x4 nx[4]; v4u ny0 = {0u, 0u, 0u, 0u}, ny1 = ny0;
    if (F.gw < NLAT) { ninv = (lane < 16) ? INV[(size_t)F.gw * 16 + lane] : -1;
#pragma unroll
        for (int q = 0; q < 4; ++q) nx[q] = *(const f32x4*)(x_ + (size_t)F.gw * 1024 + 16 * lane + 4 * q);
        { const v4u* yp = (const v4u*)(YL + (size_t)F.gw * 1024 + 16 * lane); ny0 = yp[0]; ny1 = yp[1]; } }
    for (int row = F.gw; row < NLAT; row += F.NGW) {
        const int b = row >> 11;
        const int inv = ninv; f32x4 xv4[4];
#pragma unroll
        for (int q = 0; q < 4; ++q) xv4[q] = nx[q];
        { const v4u y0 = ny0, y1 = ny1;
          xv4[0] += (f32x4){bflo(y0.x), bfhi(y0.x), bflo(y0.y), bfhi(y0.y)}; xv4[1] += (f32x4){bflo(y0.z), bfhi(y0.z), bflo(y0.w), bfhi(y0.w)};
          xv4[2] += (f32x4){bflo(y1.x), bfhi(y1.x), bflo(y1.y), bfhi(y1.y)}; xv4[3] += (f32x4){bflo(y1.z), bfhi(y1.z), bflo(y1.w), bfhi(y1.w)}; }
        const unsigned long long mask = __ballot(inv >= 0);
        const unsigned long long m1 = mask & (mask - 1), m2 = m1 & (m1 - 1);
        v4u p0 = {0u, 0u, 0u, 0u}, q0 = p0, p1 = p0, q1 = p0;
        if (mask) { const int e = __builtin_ctzll(mask); const int slot = __shfl(inv, e); const v4u* yr = (const v4u*)(YB + ((size_t)(e * 8 + b) * 256 + slot) * 1024 + 16 * lane); p0 = yr[0]; q0 = yr[1]; }
        if (m1) { const int e = __builtin_ctzll(m1); const int slot = __shfl(inv, e); const v4u* yr = (const v4u*)(YB + ((size_t)(e * 8 + b) * 256 + slot) * 1024 + 16 * lane); p1 = yr[0]; q1 = yr[1]; }
        const float* g2 = MOD + (size_t)b * 6144 + 5120 + 16 * lane;
        f32x4 gv[4];
#pragma unroll
        for (int q = 0; q < 4; ++q) gv[q] = *(const f32x4*)(g2 + 4 * q);
        if (row + F.NGW < NLAT) { ninv = (lane < 16) ? INV[(size_t)(row + F.NGW) * 16 + lane] : -1;
#pragma unroll
            for (int q = 0; q < 4; ++q) nx[q] = *(const f32x4*)(x_ + (size_t)(row + F.NGW) * 1024 + 16 * lane + 4 * q);
            { const v4u* yp = (const v4u*)(YL + (size_t)(row + F.NGW) * 1024 + 16 * lane); ny0 = yp[0]; ny1 = yp[1]; } }
        float acc[16];
#pragma unroll
        for (int j = 0; j < 16; ++j) acc[j] = 0.f;
        ACC16(p0, q0); ACC16(p1, q1);
        unsigned long long mm = m2;
        while (mm) { const int e = __builtin_ctzll(mm); mm &= mm - 1; const int slot = __shfl(inv, e);
            const v4u* yr = (const v4u*)(YB + ((size_t)(e * 8 + b) * 256 + slot) * 1024 + 16 * lane);
            const v4u p = yr[0], q = yr[1]; ACC16(p, q); }
        float* op = F.out + (size_t)row * 1024 + 16 * lane;
#pragma unroll
        for (int q = 0; q < 4; ++q) *(f32x4*)(op + 4 * q) = xv4[q] + gv[q] * (f32x4){acc[4 * q], acc[4 * q + 1], acc[4 * q + 2], acc[4 * q + 3]};
    }
}
#undef ACC16

struct Args { const float* in[20]; float* out; unsigned char* ws; int ph_lo, ph_hi, rep, pad; };
__global__ void __launch_bounds__(512, 2) hyb_fwd(Args args) {
    extern __shared__ __attribute__((aligned(16))) unsigned char lds[];
    Frame F;
    F.lds = (LAS unsigned char*)lds; F.ldsg = lds;
    F.MISC = (volatile LAS unsigned*)(F.lds + MISC_OFF);
    F.tid = threadIdx.x; F.lane = F.tid & 63; F.wave = __builtin_amdgcn_readfirstlane(F.tid >> 6);
    F.G = gridDim.x; F.gw = blockIdx.x * 8 + F.wave; F.NGW = F.G * 8;
    F.ws = args.ws; F.ctl = (gu32*)(args.ws + WS_CTL); F.out = args.out;
    for (int u = F.tid; u < (LDS_BYTES - 131072) / 4; u += 512) ((LAS unsigned*)(F.lds + 131072))[u] = 0u;
    __syncthreads();
    const int lo = args.ph_lo, hi = args.ph_hi;
    XcdBarrier bar; bar.bar = (unsigned*)(F.ctl + CW_BAR); bar.x = 0; bar.st = nullptr;
    if (hi - lo > 1) bar = xcd_barrier_post((unsigned*)(F.ctl + CW_BAR), F.MISC + 8);
#define IN(k) (lo <= (k) && (k) < hi)
#ifndef PHMASK
#define PHMASK 0xFFFF
#endif
#define PHEN(k) (((PHMASK) >> (k)) & 1)
#define SEAM(k) do { if (IN(k) && IN((k) + 1)) xcd_barrier(bar); } while (0)
    if (IN(0) && PHEN(0)) p0_phase(F, args.in[1], args.in[3], args.in[4], args.in[5], args.in[8], args.in[15]);
    SEAM(0);
    if (IN(1) && PHEN(1)) p1_phase(F, args.in[0], args.in[2], args.in[6], args.in[8], args.in[12], args.in[13], args.rep);
    SEAM(1);
    if (IN(2) && PHEN(2)) { pg8::Gemm g{WSP(bf16, WS_XN), WSP(bf16, WS_WIN), MROWS, NIN, 1024, nullptr}; pg8::SchedIn S{F.G, (int)blockIdx.x}; pg8::EpiIn E{WSP(bf16, WS_PA), WSP(bf16, WS_PD), WSP(bf16, WS_PZ)};
        pg8::gemm_phase<pg8::EpiIn, pg8::SchedIn, true, true>(F.lds, g, S, E); }
    SEAM(2);
    if (IN(3) && PHEN(3)) p3_phase(F, args.in[9], args.in[10], args.in[11], args.rep);
    SEAM(3);
    if (IN(4) && PHEN(4)) {
        if (args.rep == 0) {
            p4_phase(F);
            asm volatile("s_waitcnt vmcnt(0)" ::: "memory");
            __syncthreads();
            if (F.tid == 0) { __builtin_amdgcn_fence(__ATOMIC_RELEASE, "agent"); asm volatile("s_waitcnt vmcnt(0)" ::: "memory"); }
            __syncthreads();
            if (F.tid < 16) { const int gw = (int)blockIdx.x * 8 + (F.tid & 7);
                if (F.tid < 8) (void)__hip_atomic_fetch_add(F.ctl + CW_CHAIN + (gw >> 6) * 2 + (gw & 1), 1u, RLX_AGENT);
                else if (gw < 256) (void)__hip_atomic_fetch_add(F.ctl + CW_CHAIN + (gw >> 3) * 2 + (gw & 1), 1u, RLX_AGENT); }
        }
        __syncthreads(); p5_phase(F, args.rep, args.in[9], args.in[14]); }
    SEAM(4);
    if (IN(5) && PHEN(5)) { pg8::Gemm g{WSP(bf16, WS_Y), WSP(bf16, WS_WOUT), NLAT, 1024, 1024, nullptr}; pg8::StaticOrder S; S.init(NLAT, 1024, F.G, (int)blockIdx.x); pg8::EpiOut E{WSP(float, WS_MOD), WSP(bf16, WS_XG)};
        pg8::gemm_phase<pg8::EpiOut, pg8::StaticOrder, false, true>(F.lds, g, S, E); }
    SEAM(5);
    if (IN(6) && PHEN(6)) p8_phase(F, args.in[7], args.in[16], args.in[17], args.in[18], args.in[19], args.in[0]);
    SEAM(6);
    if (IN(7) && PHEN(7)) { pg8::Gemm g{WSP(bf16, WS_H2), WSP(bf16, WS_WGU), 32768, 32768, 1024, WSP(int, WS_XROW)}; pg8::SchedExp<8> S{F.G, (int)blockIdx.x}; pg8::EpiGLU E{WSP(bf16, WS_HID)};
        pg8::gemm_phase<pg8::EpiGLU, pg8::SchedExp<8>, true, true, true>(F.lds, g, S, E); }
    SEAM(7);
    if (IN(8) && PHEN(8)) { pg8::Gemm g{WSP(bf16, WS_HID), WSP(bf16, WS_WD), 32768, 16384, 1024, nullptr}; pg8::SchedExp<4> S{F.G, (int)blockIdx.x}; pg8::EpiDown E{WSP(bf16, WS_YB), WSP(float, WS_GATE)};
        pg8::gemm_phase<pg8::EpiDown, pg8::SchedExp<4>, true, true>(F.lds, g, S, E); }
    SEAM(8);
    if (IN(9) && PHEN(9)) p13_phase(F, args.rep, args.in[0]);
#undef IN
#undef SEAM
}

extern "C" void kernel_launch(void* const* d_in, const int* in_sizes, int n_in, void* d_out, int out_size, void* d_ws, size_t ws_size, hipStream_t stream) {
    static int grid = 0;
    if (grid == 0) {
        if (n_in != 20 || out_size != NLAT * 1024 || ws_size < WS_NEED) { fprintf(stderr, "kernel_launch: unexpected problem (n_in %d, out %d, ws %zu < %zu)\n", n_in, out_size, ws_size, (size_t)WS_NEED); grid = -1; return; }
        int dev = 0, cus = 0;
        if (hipGetDevice(&dev) != hipSuccess || hipDeviceGetAttribute(&cus, hipDeviceAttributeMultiprocessorCount, dev) != hipSuccess) { grid = -1; return; }
        if (hipFuncSetAttribute((const void*)hyb_fwd, hipFuncAttributeMaxDynamicSharedMemorySize, LDS_BYTES) != hipSuccess) { fprintf(stderr, "kernel_launch: hipFuncSetAttribute failed\n"); grid = -1; return; }
        (void)hipGetLastError();
        grid = 256;
        if (cus != 256) fprintf(stderr, "kernel_launch: device reports %d CUs; this kernel is built for 256\n", cus);
    }
    if (grid < 0) return;
    (void)hipMemsetAsync((char*)d_ws + WS_CTL, 0, CTL_ZERO_BYTES, stream);
    Args a{};
    for (int i = 0; i < 20; ++i) a.in[i] = (const float*)d_in[i];
    a.out = (float*)d_out; a.ws = (unsigned char*)d_ws;
#if MK_MULTI
    for (int p = 0; p <= NPHASE; ++p) { a.ph_lo = p; a.ph_hi = p + 1; a.rep = 0; hipLaunchKernelGGL(hyb_fwd, dim3(grid), dim3(512), LDS_BYTES, stream, a);
#ifdef REP_PHASE
        if (p == REP_PHASE) { a.rep = REP_VAL; hipLaunchKernelGGL(hyb_fwd, dim3(grid), dim3(512), LDS_BYTES, stream, a); }
#endif
    }
#else
    a.ph_lo = 0; a.ph_hi = NPHASE + 1;
    hipLaunchKernelGGL(hyb_fwd, dim3(grid), dim3(512), LDS_BYTES, stream, a);
#endif
}
```

```cpp
#include <hip/hip_runtime.h>
#include <cstdio>
#include <cstdint>
namespace pg8 {
#define PG8_LAS __attribute__((address_space(3)))
typedef unsigned short bf16_t;
typedef short bf16x8 __attribute__((ext_vector_type(8)));
typedef float f32x4 __attribute__((ext_vector_type(4)));
typedef unsigned u32x4 __attribute__((ext_vector_type(4)));
typedef unsigned u32x2 __attribute__((ext_vector_type(2)));
typedef int v4i_t __attribute__((ext_vector_type(4)));
typedef int v8i_t __attribute__((ext_vector_type(8)));
constexpr int BM = 256, BK = 64, HALF = 128, HTB = HALF * BK * 2  , STAGE_BYTES = 8 * HTB, NXCD = 8, WGM = 8;

__host__ __device__ __forceinline__ int lds_byte(int r, int c) { const int st = (r >> 4) * 2 + (c >> 5), rr = r & 15, cc = c & 31, ob = rr * 64 + cc * 2; return st * 1024 + (ob ^ (((ob >> 9) & 1) << 5)); }
__host__ __device__ __forceinline__ void stage_rc(int b, int& R, int& C) { const int st = b / 1024, sb = b % 1024, swz = sb ^ (((sb >> 9) & 1) << 5); R = (st >> 1) * 16 + swz / 64; C = (st & 1) * 32 + (swz % 64) / 2; }
__host__ __device__ __forceinline__ int perm32(int rho) { const int n = rho >> 4, i = rho & 15; return 8 * (i >> 2) + 4 * n + (i & 3); }

struct Unit { int pm, pn; };
struct Gemm { const bf16_t* A; const bf16_t* Bt; int M, N, K; const int* arow; };

struct StaticOrder {
    int nM, nN, nwg, G, c;
    __host__ __device__ void init(int M, int N, int G_, int c_) { nM = M / BM; nN = N / BM; nwg = nM * nN; G = G_; c = c_; }
    __host__ __device__ bool next(int i, Unit& u) const {
        const long L = (long)i * G + c; if (L >= nwg) return false;
        int wgid = (int)L; { const int q = nwg / NXCD, r = nwg % NXCD, xcd = wgid % NXCD, off = wgid / NXCD; wgid = (xcd < r ? xcd * (q + 1) : r * (q + 1) + (xcd - r) * q) + off; }
        const int nig = WGM * nN, gid = wgid / nig, fm = gid * WGM, gsz = (nM - fm) < WGM ? (nM - fm) : WGM;
        u.pm = fm + ((wgid % nig) % gsz); u.pn = (wgid % nig) / gsz; return true;
    }
    __device__ __forceinline__ void a_ready(const Unit&) const {}
    __device__ __forceinline__ void done(const Unit&) const {}
};

__device__ __forceinline__ unsigned pk4_fp8(float a, float b, float c, float d) {
    a = __builtin_amdgcn_fmed3f(a, -448.f, 448.f); b = __builtin_amdgcn_fmed3f(b, -448.f, 448.f); c = __builtin_amdgcn_fmed3f(c, -448.f, 448.f); d = __builtin_amdgcn_fmed3f(d, -448.f, 448.f);
    int w = __builtin_amdgcn_cvt_pk_fp8_f32(a, b, 0, false); w = __builtin_amdgcn_cvt_pk_fp8_f32(c, d, w, true); return (unsigned)w; }
constexpr float FP8_SH2 = 16.f, FP8_SW = 64.f, FP8_SHID = 8.f, FP8_SYB = 64.f;
__device__ __forceinline__ unsigned cvt_pk_bf16(float lo, float hi) { unsigned r; asm volatile("v_cvt_pk_bf16_f32 %0, %1, %2" : "=v"(r) : "v"(lo), "v"(hi)); return r; }
#ifndef EPI_WT
#define EPI_WT 0
#endif
__device__ __forceinline__ void st16_wt(void* p, u32x4 v) {
#if EPI_WT
    asm volatile("global_store_dwordx4 %0, %1, off sc1" :: "v"(p), "v"(v) : "memory");
#else
    *(u32x4*)p = v;
#endif
}
__device__ __forceinline__ float silu_f(float x) { return x * __builtin_amdgcn_rcpf(1.0f + __expf(-x)); }
struct EpiIn {
    static constexpr bool PERM = true, AFTER_DRAIN = false;
    bf16_t *PA, *PD, *PZ;
    __device__ __forceinline__ void operator()(const f32x4 (&acc)[2][2][4][2], const Unit& u, int wr, int wc, int fr, int fq) const {
        bf16_t* base; int ldc, colt;
        if (u.pn < 3) { base = PA; ldc = 768; colt = u.pn * 256; }
        else if (u.pn < 9) { base = PD; ldc = 1536; colt = (u.pn - 3) * 256; }
        else { base = PZ; ldc = 512; colt = (u.pn - 9) * 256; }
        const int row0 = u.pm * BM + wr * 64 + fr, col0 = colt + wc * 32 + 8 * fq;
#pragma unroll
        for (int ai = 0; ai < 2; ++ai)
#pragma unroll
            for (int m = 0; m < 4; ++m) { bf16_t* rowp = base + (size_t)(row0 + ai * HALF + m * 16) * ldc + col0;
#pragma unroll
                for (int bj = 0; bj < 2; ++bj) { const f32x4 v0 = acc[ai][bj][m][0], v1 = acc[ai][bj][m][1];
                    u32x4 w; w.x = cvt_pk_bf16(v0[0], v0[1]); w.y = cvt_pk_bf16(v0[2], v0[3]); w.z = cvt_pk_bf16(v1[0], v1[1]); w.w = cvt_pk_bf16(v1[2], v1[3]);
                    st16_wt(rowp + bj * HALF, w); } }
    }
};
struct EpiOut {
    static constexpr bool PERM = true, AFTER_DRAIN = false;
    const float* mod; bf16_t* YL;
    __device__ __forceinline__ void operator()(const f32x4 (&acc)[2][2][4][2], const Unit& u, int wr, int wc, int fr, int fq) const {
        const int row0 = u.pm * BM + wr * 64 + fr, col0 = u.pn * BM + wc * 32 + 8 * fq;
        const float* g1 = mod + (size_t)(u.pm >> 3) * 6144 + 2048;
        f32x4 gv[2][2];
#pragma unroll
        for (int bj = 0; bj < 2; ++bj)
#pragma unroll
            for (int n = 0; n < 2; ++n) gv[bj][n] = *(const f32x4*)(g1 + col0 + bj * HALF + 4 * n);
#pragma unroll
        for (int ai = 0; ai < 2; ++ai)
#pragma unroll
            for (int m = 0; m < 4; ++m) { bf16_t* rowp = YL + (size_t)(row0 + ai * HALF + m * 16) * 1024 + col0;
#pragma unroll
                for (int bj = 0; bj < 2; ++bj) { const f32x4 v0 = acc[ai][bj][m][0] * gv[bj][0], v1 = acc[ai][bj][m][1] * gv[bj][1];
                    u32x4 w; w.x = cvt_pk_bf16(v0[0], v0[1]); w.y = cvt_pk_bf16(v0[2], v0[3]); w.z = cvt_pk_bf16(v1[0], v1[1]); w.w = cvt_pk_bf16(v1[2], v1[3]);
                    *(u32x4*)(rowp + bj * HALF) = w; } }
    }
};
struct EpiGLU {
    static constexpr bool PERM = true, AFTER_DRAIN = false;
    unsigned char* HID;
    __device__ __forceinline__ void operator()(const f32x4 (&acc)[2][2][4][2], const Unit& u, int wr, int wc, int fr, int fq) const {
        const int row0 = u.pm * BM + wr * 64 + fr, col0 = (u.pn & 7) * 128 + wc * 32 + 8 * fq;
        constexpr float us = 1.0f / (FP8_SH2 * FP8_SW);
#pragma unroll
        for (int ai = 0; ai < 2; ++ai)
#pragma unroll
            for (int m = 0; m < 4; ++m) { unsigned char* rowp = HID + (size_t)(row0 + ai * HALF + m * 16) * 1024 + col0;
                float hv[8];
#pragma unroll
                for (int n = 0; n < 2; ++n)
#pragma unroll
                    for (int j = 0; j < 4; ++j) hv[n * 4 + j] = silu_f(acc[ai][0][m][n][j] * us) * (acc[ai][1][m][n][j] * (us * FP8_SHID));
                u32x2 w; w.x = pk4_fp8(hv[0], hv[1], hv[2], hv[3]); w.y = pk4_fp8(hv[4], hv[5], hv[6], hv[7]);
                *(u32x2*)rowp = w; }
    }
};
struct EpiDown {
    static constexpr bool PERM = true, AFTER_DRAIN = false;
    unsigned char* Yb; const float* gatev;
    __device__ __forceinline__ void operator()(const f32x4 (&acc)[2][2][4][2], const Unit& u, int wr, int wc, int fr, int fq) const {
        const int e = u.pm >> 3, b = u.pm & 7;
        const int r0 = wr * 64 + fr, col0 = (u.pn & 3) * 256 + wc * 32 + 8 * fq;
        const float* gp = gatev + (size_t)(b * 16 + e) * 256;
#pragma unroll
        for (int ai = 0; ai < 2; ++ai)
#pragma unroll
            for (int m = 0; m < 4; ++m) { const int s = r0 + ai * HALF + m * 16; const float gt = gp[s] * (FP8_SYB / (FP8_SHID * FP8_SW));
                unsigned char* rowp = Yb + ((size_t)u.pm * BM + s) * 1024 + col0;
#pragma unroll
                for (int bj = 0; bj < 2; ++bj) { const f32x4 v0 = acc[ai][bj][m][0] * gt, v1 = acc[ai][bj][m][1] * gt;
                    u32x2 w; w.x = pk4_fp8(v0[0], v0[1], v0[2], v0[3]); w.y = pk4_fp8(v1[0], v1[1], v1[2], v1[3]);
                    *(u32x2*)(rowp + bj * HALF) = w; } }
    }
};
struct SchedIn {
    int G, c;
    __device__ __forceinline__ bool next(int i, Unit& u) const {
        const int L = i * G + c; if (L >= 760) return false;
        if (L < 704) { StaticOrder S; S.init(16384, 2816, G, c); Unit t; S.next(i, t); u.pm = (t.pm >> 3) * 9 + 1 + (t.pm & 7); u.pn = t.pn; }
        else { const int j = L - 704; u.pm = (j / 7) * 9; u.pn = 2 + (j % 7); }
        return true;
    }
    __device__ __forceinline__ void a_ready(const Unit&) const {}
    __device__ __forceinline__ void done(const Unit&) const {}
};
template <int NPN> struct SchedExp {
    int G, c;
    __device__ __forceinline__ bool next(int i, Unit& u) const {
        const int per = G >> 3, x = c & 7, loc = c >> 3;
        const int uidx = i * per + loc; if (uidx >= 2 * 8 * NPN) return false;
        const int e = x + 8 * (uidx / (8 * NPN)), w = uidx % (8 * NPN);
        u.pm = e * 8 + (w & 7); u.pn = e * NPN + (w >> 3); return true;
    }
    __device__ __forceinline__ void a_ready(const Unit&) const {}
    __device__ __forceinline__ void done(const Unit&) const {}
};
template <class Epi, class Sched, bool ALIGN_EPI = false, bool SP2 = false, bool GATHER = false, bool FP8 = false>
__device__ __forceinline__ void gemm_phase(PG8_LAS unsigned char* lds, const Gemm g, const Sched& S, const Epi& E) {
    const int tid = threadIdx.x, wid = __builtin_amdgcn_readfirstlane(tid >> 6), lane = tid & 63, wr = wid >> 2, wc = wid & 3, fr = lane & 15, fq = lane >> 4;
    const int K = g.K, nt = K / BK;
    unsigned voffA[2], voffB[2];
#pragma unroll
    for (int i = 0; i < 2; ++i) { int R, C; stage_rc(tid * 16 + i * 8192, R, C); const int Rb = Epi::PERM ? ((R & ~31) + perm32(R & 31)) : R;
        voffA[i] = (unsigned)(R * K + C) * 2u; voffB[i] = (unsigned)(Rb * K + C) * 2u; }
    static_assert(!GATHER || SP2, "gather is wired into the SP2 loop only");
    unsigned gA[2][2] = {{0u, 0u}, {0u, 0u}}, gN[2][2] = {{0u, 0u}, {0u, 0u}}; int gR[2] = {0, 0}, gC[2] = {0, 0};
    if constexpr (GATHER) {
#pragma unroll
        for (int i = 0; i < 2; ++i) stage_rc(tid * 16 + i * 8192, gR[i], gC[i]); }
#define PG8_GLOAD(u, dst) do { _Pragma("unroll") for (int h_ = 0; h_ < 2; ++h_) _Pragma("unroll") for (int i_ = 0; i_ < 2; ++i_) \
        dst[h_][i_] = ((unsigned)g.arow[(u).pm * BM + h_ * HALF + gR[i_]] * (unsigned)K + (unsigned)gC[i_]) * 2u; } while (0)
    const size_t kstep = (size_t)(BK * 2);
    const size_t hstep = (size_t)HALF * K * 2;
    const size_t tstep = 2 * hstep;
    const unsigned ldsw = (unsigned)wid * 1024u;
    const int aoff = lds_byte(wr * 64 + fr, fq * 8), boff = lds_byte(wc * 32 + fr, fq * 8);
#define PG8_SA(b, h) (((b) * 2 + (h)) * HTB)
#define PG8_SB(b, h) ((4 + (b) * 2 + (h)) * HTB)
#define PG8_STAGE(bufoff, gbase, voff) do { _Pragma("unroll") for (int _i = 0; _i < 2; ++_i) \
        __builtin_amdgcn_global_load_lds((const unsigned*)((const char*)(gbase) + (voff)[_i]), (PG8_LAS unsigned*)(lds + (bufoff) + ldsw + _i * 8192), 16, 0, 0); } while (0)
#define PG8_LDA(dst, b, h) do { _Pragma("unroll") for (int m = 0; m < 4; ++m) { if constexpr (FP8) { dst##8[m].lo = *(const PG8_LAS v4i_t*)(lds + PG8_SA(b, h) + aoff + m * 2048); dst##8[m].hi = *(const PG8_LAS v4i_t*)(lds + PG8_SA(b, h) + aoff + m * 2048 + 1024); } \
        else { _Pragma("unroll") for (int k = 0; k < 2; ++k) dst[m][k] = *(const PG8_LAS bf16x8*)(lds + PG8_SA(b, h) + aoff + m * 2048 + k * 1024); } } } while (0)
#define PG8_LDB(dst, b, h) do { _Pragma("unroll") for (int n = 0; n < 2; ++n) { if constexpr (FP8) { dst##8[n].lo = *(const PG8_LAS v4i_t*)(lds + PG8_SB(b, h) + boff + n * 2048); dst##8[n].hi = *(const PG8_LAS v4i_t*)(lds + PG8_SB(b, h) + boff + n * 2048 + 1024); } \
        else { _Pragma("unroll") for (int k = 0; k < 2; ++k) dst[n][k] = *(const PG8_LAS bf16x8*)(lds + PG8_SB(b, h) + boff + n * 2048 + k * 1024); } } } while (0)
#define PG8_MMA(ai, bj, At, Bt) do { __builtin_amdgcn_s_setprio(1); \
        if constexpr (FP8) { _Pragma("unroll") for (int m = 0; m < 4; ++m) _Pragma("unroll") for (int n = 0; n < 2; ++n) \
            asm volatile("v_mfma_f32_16x16x128_f8f6f4 %0, %1, %2, %0" : "+v"(acc[ai][bj][m][n]) : "v"(Bt##8[n]), "v"(At##8[m])); } \
        else { _Pragma("unroll") for (int m = 0; m < 4; ++m) _Pragma("unroll") for (int n = 0; n < 2; ++n) _Pragma("unroll") for (int k = 0; k < 2; ++k) \
            acc[ai][bj][m][n] = __builtin_amdgcn_mfma_f32_16x16x32_bf16(Bt[n][k], At[m][k], acc[ai][bj][m][n], 0, 0, 0); } \
        __builtin_amdgcn_s_setprio(0); } while (0)
#define PG8_WAIT_V(n) asm volatile("s_waitcnt vmcnt(" #n ")" ::: "memory")
#define PG8_WAIT_L(n) asm volatile("s_waitcnt lgkmcnt(" #n ")" ::: "memory")
#define PG8_BAR __builtin_amdgcn_s_barrier()
#define PG8_SCHED __builtin_amdgcn_sched_barrier(0)
    Unit cur, nxt; int ui = 0;
    if (!S.next(0, cur)) return;
    f32x4 acc[2][2][4][2];
#pragma unroll
    for (int a = 0; a < 2; ++a)
#pragma unroll
        for (int b = 0; b < 2; ++b)
#pragma unroll
            for (int m = 0; m < 4; ++m)
#pragma unroll
                for (int n = 0; n < 2; ++n) acc[a][b][m][n] = (f32x4){0.f, 0.f, 0.f, 0.f};
    bf16x8 At[4][2], B0[2][2], B1[2][2];
    v8i_t At8[4], B08[2], B18[2];
    const char* cA = (const char*)g.A + (GATHER ? (size_t)0 : (size_t)cur.pm * tstep); const char* cB = (const char*)g.Bt + (size_t)cur.pn * tstep;
    S.a_ready(cur);
    if constexpr (GATHER) { PG8_GLOAD(cur, gA); }
    const size_t ahs = GATHER ? (size_t)0 : hstep;
    if constexpr (SP2) {
        PG8_STAGE(PG8_SB(0, 0), cB, voffB); PG8_STAGE(PG8_SB(0, 1), cB + hstep, voffB); PG8_STAGE(PG8_SA(0, 0), cA, (GATHER ? gA[0] : voffA)); PG8_STAGE(PG8_SA(0, 1), cA + ahs, (GATHER ? gA[1] : voffA));
        if (wr == 1) PG8_BAR;
        PG8_WAIT_V(2); PG8_BAR;
        PG8_STAGE(PG8_SB(1, 0), cB + kstep, voffB); PG8_STAGE(PG8_SA(1, 0), cA + kstep, (GATHER ? gA[0] : voffA)); PG8_STAGE(PG8_SB(1, 1), cB + hstep + kstep, voffB);
        PG8_WAIT_V(6); PG8_BAR;
    } else {
        PG8_STAGE(PG8_SB(0, 0), cB, voffB); PG8_STAGE(PG8_SA(0, 0), cA, voffA); PG8_STAGE(PG8_SB(0, 1), cB + hstep, voffB); PG8_STAGE(PG8_SA(0, 1), cA + hstep, voffA);
        if (wr == 1) PG8_BAR;
        PG8_WAIT_V(4); PG8_BAR;
        PG8_STAGE(PG8_SB(1, 0), cB + kstep, voffB); PG8_STAGE(PG8_SA(1, 0), cA + kstep, voffA); PG8_STAGE(PG8_SB(1, 1), cB + hstep + kstep, voffB);
        PG8_WAIT_V(6); PG8_BAR;
    }
    for (;;) {
        const bool has_next = S.next(ui + 1, nxt);
        const char* nA = GATHER ? cA : (has_next ? (const char*)g.A + (size_t)nxt.pm * tstep : cA);
        if constexpr (GATHER) { if (has_next) { PG8_GLOAD(nxt, gN); } else { gN[0][0] = gA[0][0]; gN[0][1] = gA[0][1]; gN[1][0] = gA[1][0]; gN[1][1] = gA[1][1]; } } const char* nB = has_next ? (const char*)g.Bt + (size_t)nxt.pn * tstep : cB;
        for (int t = 0; t < nt; t += 2) {
            const bool last = (t == nt - 2);
            const char* a1 = cA + (size_t)(t + 1) * kstep;
            const char* a2 = last ? nA : cA + (size_t)(t + 2) * kstep; const char* b2 = last ? nB : cB + (size_t)(t + 2) * kstep;
            const char* a3 = a2 + kstep; const char* b3 = b2 + kstep;
            if (last && has_next) S.a_ready(nxt);
            unsigned g2[2][2];
#pragma unroll
            for (int h_ = 0; h_ < 2; ++h_)
#pragma unroll
                for (int i_ = 0; i_ < 2; ++i_) g2[h_][i_] = last ? gN[h_][i_] : gA[h_][i_];
            if constexpr (SP2) {
            PG8_LDB(B0, 0, 0); PG8_LDB(B1, 0, 1); PG8_SCHED; PG8_LDA(At, 0, 0); PG8_STAGE(PG8_SA(1, 1), a1 + ahs, (GATHER ? gA[1] : voffA));
            PG8_WAIT_V(8); PG8_WAIT_L(0); PG8_BAR; PG8_MMA(0, 0, At, B0); PG8_MMA(0, 1, At, B1); PG8_BAR; PG8_SCHED;
            PG8_LDA(At, 0, 1); PG8_STAGE(PG8_SB(0, 0), b2, voffB); PG8_STAGE(PG8_SB(0, 1), b2 + hstep, voffB); PG8_STAGE(PG8_SA(0, 0), a2, (GATHER ? g2[0] : voffA));
            PG8_WAIT_V(8); PG8_WAIT_L(0); PG8_BAR; PG8_MMA(1, 0, At, B0); PG8_MMA(1, 1, At, B1); PG8_BAR; PG8_SCHED;
            PG8_LDB(B0, 1, 0); PG8_LDB(B1, 1, 1); PG8_SCHED; PG8_LDA(At, 1, 0); PG8_STAGE(PG8_SA(0, 1), a2 + ahs, (GATHER ? g2[1] : voffA));
            PG8_WAIT_V(8); PG8_WAIT_L(0); PG8_BAR; PG8_MMA(0, 0, At, B0); PG8_MMA(0, 1, At, B1); PG8_BAR; PG8_SCHED;
            PG8_LDA(At, 1, 1); PG8_STAGE(PG8_SB(1, 0), b3, voffB); PG8_STAGE(PG8_SB(1, 1), b3 + hstep, voffB); PG8_STAGE(PG8_SA(1, 0), a3, (GATHER ? g2[0] : voffA));
            PG8_WAIT_V(8); PG8_WAIT_L(0); PG8_BAR; PG8_MMA(1, 0, At, B0); PG8_MMA(1, 1, At, B1); PG8_BAR; PG8_SCHED;
            } else {
            PG8_LDB(B0, 0, 0); PG8_SCHED; PG8_LDA(At, 0, 0); PG8_STAGE(PG8_SA(1, 1), a1 + hstep, voffA);
            PG8_WAIT_L(8); PG8_BAR; PG8_WAIT_L(0); PG8_MMA(0, 0, At, B0); PG8_BAR; PG8_SCHED;
            PG8_LDB(B1, 0, 1); PG8_STAGE(PG8_SB(0, 0), b2, voffB);
            PG8_BAR; PG8_WAIT_L(0); PG8_MMA(0, 1, At, B1); PG8_BAR;
            PG8_LDA(At, 0, 1); PG8_STAGE(PG8_SA(0, 0), a2, voffA);
            PG8_BAR; PG8_WAIT_L(0); PG8_MMA(1, 0, At, B0); PG8_BAR; PG8_SCHED;
            PG8_STAGE(PG8_SB(0, 1), b2 + hstep, voffB);
            PG8_WAIT_V(6); PG8_BAR; PG8_MMA(1, 1, At, B1); PG8_BAR;
            PG8_LDB(B0, 1, 0); PG8_SCHED; PG8_LDA(At, 1, 0); PG8_STAGE(PG8_SA(0, 1), a2 + hstep, voffA);
            PG8_WAIT_L(8); PG8_BAR; PG8_WAIT_L(0); PG8_MMA(0, 0, At, B0); PG8_BAR; PG8_SCHED;
            PG8_LDB(B1, 1, 1); PG8_STAGE(PG8_SB(1, 0), b3, voffB);
            PG8_BAR; PG8_WAIT_L(0); PG8_MMA(0, 1, At, B1); PG8_BAR;
            PG8_LDA(At, 1, 1); PG8_STAGE(PG8_SA(1, 0), a3, voffA);
            PG8_BAR; PG8_WAIT_L(0); PG8_MMA(1, 0, At, B0); PG8_BAR; PG8_SCHED;
            PG8_STAGE(PG8_SB(1, 1), b3 + hstep, voffB);
            PG8_WAIT_V(6); PG8_BAR; PG8_MMA(1, 1, At, B1); PG8_BAR;
            }
        }
        if constexpr (ALIGN_EPI) { if (wr == 0) PG8_BAR; }
        if constexpr (FP8) { asm volatile("s_nop 15\n\ts_nop 15" ::: "memory"); }
        if constexpr (!Epi::AFTER_DRAIN) { E(acc, cur, wr, wc, fr, fq); S.done(cur); }
        if (!has_next) break;
#pragma unroll
        for (int a = 0; a < 2; ++a)
#pragma unroll
            for (int b = 0; b < 2; ++b)
#pragma unroll
                for (int m = 0; m < 4; ++m)
#pragma unroll
                    for (int n = 0; n < 2; ++n) acc[a][b][m][n] = (f32x4){0.f, 0.f, 0.f, 0.f};
        cur = nxt; cA = nA; cB = nB; ++ui;
        if constexpr (GATHER) { gA[0][0] = gN[0][0]; gA[0][1] = gN[0][1]; gA[1][0] = gN[1][0]; gA[1][1] = gN[1][1]; }
        if constexpr (ALIGN_EPI) { if (wr == 1) PG8_BAR; }
    }
    PG8_WAIT_V(0);
    if constexpr (!ALIGN_EPI) { if (wr == 0) PG8_BAR; }
    PG8_BAR;
    if constexpr (Epi::AFTER_DRAIN) { E.fused(acc, cur, wr, wc, fr, fq, lds, wid, lane); S.done(cur); }
#undef PG8_GLOAD
#undef PG8_SA
#undef PG8_SB
#undef PG8_STAGE
#undef PG8_LDA
#undef PG8_LDB
#undef PG8_MMA
#undef PG8_WAIT_V
#undef PG8_WAIT_L
#undef PG8_BAR
#undef PG8_SCHED
}
}
#include <hip/hip_bf16.h>
#include <cmath>
namespace attn_body {
using bf16=__hip_bfloat16;
using bf16x8=__attribute__((ext_vector_type(8)))short;
using s16x4=__attribute__((ext_vector_type(4)))short;
using f32x16=__attribute__((ext_vector_type(16)))float;
using u32x4=__attribute__((ext_vector_type(4)))unsigned;
constexpr int D=64, QP=768, KVP=768, OP=1024, NTILES=36;
constexpr int NW=8,QBLK=32,QB=QBLK*NW,KVBLK=64;
constexpr int ATTN_UNIT_ROWS=QB;
__device__ __forceinline__ int crow(int r,int hi){return (r&3)+8*(r>>2)+4*hi;}
#define SBAR() __builtin_amdgcn_sched_barrier(0)

constexpr int NSLOT=3, SLOTB=8192;
constexpr int LDS_K=0, LDS_V=NSLOT*SLOTB, LDS_WS=2*NSLOT*SLOTB, LDS_OST=LDS_WS+NW*64*4, LDS_BYTES=LDS_OST+NW*4096;
constexpr float C2=0.125f*1.4426950408889634f;
__device__ __forceinline__ void glds16(const void*gsrc,unsigned lds_dst){unsigned keep;
  asm volatile("s_mov_b32 %0, m0\n\ts_mov_b32 m0, %2\n\ts_nop 0\n\tglobal_load_lds_dwordx4 %1, off\n\ts_mov_b32 m0, %0":"=&s"(keep):"v"(gsrc),"s"(lds_dst):"memory");}
__device__ __forceinline__ float max3f(float a,float b,float c){float r;asm("v_max3_f32 %0, %1, %2, %3":"=v"(r):"v"(a),"v"(b),"v"(c));return r;}
__device__ __forceinline__ float max2f(float a,float b){float r;asm("v_max_f32_e32 %0, %1, %2":"=v"(r):"v"(a),"v"(b));return r;}
__device__ __forceinline__ float fadd_s(float a,float b){float r;asm("v_add_f32_e32 %0, %1, %2":"=v"(r):"v"(a),"v"(b));return r;}
__device__ __forceinline__ float fsub_s(float a,float b){float r;asm("v_sub_f32_e32 %0, %1, %2":"=v"(r):"v"(a),"v"(b));return r;}
typedef float f32x2_t __attribute__((ext_vector_type(2))); typedef __bf16 bf16x2_t __attribute__((ext_vector_type(2)));
__device__ __forceinline__ unsigned cvtpk_s(float lo,float hi){f32x2_t v={lo,hi};bf16x2_t b=__builtin_convertvector(v,bf16x2_t);return __builtin_bit_cast(unsigned,b);}
#define WAIT_BAR(N) asm volatile("s_waitcnt vmcnt(" #N ") lgkmcnt(0)\n\ts_barrier":::"memory")

__device__ __forceinline__ void qkt(f32x16&p0,f32x16&p1,const char*Kslot,const bf16x8*qr,const f32x16&negm,int r32,int hi){
  const char*kb=Kslot+hi*1024+r32*16;
  #pragma unroll
  for(int d0=0;d0<4;++d0){
    const bf16x8 b0=*reinterpret_cast<const bf16x8*>(kb+d0*2048);
    const bf16x8 b1=*reinterpret_cast<const bf16x8*>(kb+d0*2048+512);
    if(d0==0){p0=__builtin_amdgcn_mfma_f32_32x32x16_bf16(b0,qr[0],negm,0,0,0);p1=__builtin_amdgcn_mfma_f32_32x32x16_bf16(b1,qr[0],negm,0,0,0);}
    else{p0=__builtin_amdgcn_mfma_f32_32x32x16_bf16(b0,qr[d0],p0,0,0,0);p1=__builtin_amdgcn_mfma_f32_32x32x16_bf16(b1,qr[d0],p1,0,0,0);}}
}
typedef __attribute__((address_space(3))) const char* lds_cptr;
typedef short v4i16_t __attribute__((ext_vector_type(4)));
__device__ __forceinline__ void kload8(bf16x8*kf,lds_cptr kp){
  kf[0]=*(const __attribute__((address_space(3))) bf16x8*)(kp);      kf[1]=*(const __attribute__((address_space(3))) bf16x8*)(kp+512);
  kf[2]=*(const __attribute__((address_space(3))) bf16x8*)(kp+2048); kf[3]=*(const __attribute__((address_space(3))) bf16x8*)(kp+2560);
  kf[4]=*(const __attribute__((address_space(3))) bf16x8*)(kp+4096); kf[5]=*(const __attribute__((address_space(3))) bf16x8*)(kp+4608);
  kf[6]=*(const __attribute__((address_space(3))) bf16x8*)(kp+6144); kf[7]=*(const __attribute__((address_space(3))) bf16x8*)(kp+6656);
}
__device__ __forceinline__ void kload2(bf16x8*kf,lds_cptr kp,int j){ kf[2*j]=*(const __attribute__((address_space(3))) bf16x8*)(kp+j*2048); kf[2*j+1]=*(const __attribute__((address_space(3))) bf16x8*)(kp+j*2048+512); }
__device__ __forceinline__ s16x4 vtr(lds_cptr p){ return __builtin_bit_cast(s16x4,__builtin_amdgcn_ds_read_tr16_b64_v4i16((__attribute__((address_space(3))) v4i16_t*)p)); }
__device__ __forceinline__ float rowmax(const f32x16&p0,const f32x16&p1){
  float a=max3f(p0[0],p0[1],p1[0]),b=max3f(p0[2],p0[3],p1[1]);a=max3f(a,p1[2],p1[3]);
  #pragma unroll
  for(int r=4;r<16;r+=4){a=max3f(a,p0[r],p0[r+1]);b=max3f(b,p0[r+2],p0[r+3]);a=max3f(a,p1[r],p1[r+1]);b=max3f(b,p1[r+2],p1[r+3]);}
  const float m=max2f(a,b);
  auto rr=__builtin_amdgcn_permlane32_swap(__float_as_uint(m),__float_as_uint(m),false,false);
  return max2f(__uint_as_float(rr[0]),__uint_as_float(rr[1]));
}
__device__ __forceinline__ void pv(f32x16*o,int vb,bf16x8 pa0,bf16x8 pa1,bf16x8 pa2,bf16x8 pa3){
  #pragma unroll
  for(int d0=0;d0<2;++d0){s16x4 lo[4],hi[4];
    #pragma unroll
    for(int ks=0;ks<4;++ks){
      asm volatile("ds_read_b64_tr_b16 %0,%1 offset:%c2":"=&v"(lo[ks]):"v"(vb),"i"(d0*4096+ks*1024):"memory");
      asm volatile("ds_read_b64_tr_b16 %0,%1 offset:%c2":"=&v"(hi[ks]):"v"(vb),"i"(d0*4096+ks*1024+512):"memory");}
    asm volatile("s_waitcnt lgkmcnt(0)":::"memory");SBAR();
    #define PK(k) (bf16x8){lo[k][0],lo[k][1],lo[k][2],lo[k][3],hi[k][0],hi[k][1],hi[k][2],hi[k][3]}
    o[d0]=__builtin_amdgcn_mfma_f32_32x32x16_bf16(pa0,PK(0),o[d0],0,0,0);
    o[d0]=__builtin_amdgcn_mfma_f32_32x32x16_bf16(pa1,PK(1),o[d0],0,0,0);
    o[d0]=__builtin_amdgcn_mfma_f32_32x32x16_bf16(pa2,PK(2),o[d0],0,0,0);
    o[d0]=__builtin_amdgcn_mfma_f32_32x32x16_bf16(pa3,PK(3),o[d0],0,0,0);
    #undef PK
  }
}

#ifndef ATTN_STORE16
#define ATTN_STORE16(p,v) (*(u32x4*)(p)=(v))
#endif
template<int THRL> __device__ __forceinline__ void attn_unit(const bf16*Qw0,const bf16*__restrict__ Kh,const bf16*__restrict__ Vh,bf16*Ow0,char*shm,const float*qnw,const float*RT,int tl0){
  const int tid=threadIdx.x,lane=tid&63,r32=lane&31,hi=lane>>5; const int wid=__builtin_amdgcn_readfirstlane(tid>>6);
  const bf16*Qw=Qw0+(long)wid*QBLK*QP;


  const unsigned lds0=(unsigned)(uintptr_t)shm;
  float*wsf=(float*)(shm+LDS_WS)+wid*64;
  const bf16*ksrc=Kh+(long)lane*KVP+wid*8;
  const bf16*vsrc=Vh+(long)(16*(wid&3)+(lane>>2))*KVP+(wid>>2)*32+(lane&3)*8;
  const unsigned kdst=lds0+LDS_K+wid*1024, vdst=lds0+LDS_V+wid*1024;
  #define DMA_K(t,slot) glds16(ksrc+(long)(t)*KVBLK*KVP,(unsigned)__builtin_amdgcn_readfirstlane(kdst+(slot)))
  #define DMA_V(t,slot) glds16(vsrc+(long)(t)*KVBLK*KVP,(unsigned)__builtin_amdgcn_readfirstlane(vdst+(slot)))
  const int vb0=(int)(lds0+LDS_V)+((lane>>4)&1)*32+(lane&3)*8+(4*hi+((lane&15)>>2))*64;
  const char*Kbase=shm+LDS_K; bf16x8 kf[8];
  const lds_cptr shm3=(lds_cptr)shm; const lds_cptr kp0=shm3+LDS_K+hi*1024+r32*16; const lds_cptr vp0=shm3+LDS_V+((lane>>4)&1)*32+(lane&3)*8+(4*hi+((lane&15)>>2))*64;
  constexpr int NT=NTILES;
  DMA_K(0,0);DMA_V(0,0);DMA_K(1,SLOTB);
  bf16x8 qr[4];
  #pragma unroll
  for(int d0=0;d0<4;++d0)qr[d0]=*reinterpret_cast<const bf16x8*>(&Qw[(long)r32*QP+d0*16+hi*8]);
  { float qf[4][8]; float ss=0.f;
    #pragma unroll
    for(int d0=0;d0<4;++d0){ const u32x4 w=__builtin_bit_cast(u32x4,qr[d0]);
      qf[d0][0]=__uint_as_float(w[0]<<16);qf[d0][1]=__uint_as_float(w[0]&0xffff0000u);qf[d0][2]=__uint_as_float(w[1]<<16);qf[d0][3]=__uint_as_float(w[1]&0xffff0000u);
      qf[d0][4]=__uint_as_float(w[2]<<16);qf[d0][5]=__uint_as_float(w[2]&0xffff0000u);qf[d0][6]=__uint_as_float(w[3]<<16);qf[d0][7]=__uint_as_float(w[3]&0xffff0000u);
      #pragma unroll
      for(int j=0;j<8;++j)ss+=qf[d0][j]*qf[d0][j]; }
    { auto rr=__builtin_amdgcn_permlane32_swap(__float_as_uint(ss),__float_as_uint(ss),false,false); ss=__uint_as_float(rr[0])+__uint_as_float(rr[1]); }
    const float rstd=__builtin_amdgcn_rsqf(ss*(1.0f/64.0f)+1e-6f);
    #pragma unroll
    for(int d0=0;d0<4;++d0){
      #pragma unroll
      for(int j=0;j<8;++j)qf[d0][j]*=rstd*qnw[d0*16+hi*8+j]; }
    const int tl=tl0+wid*QBLK+r32, prow=tl>>6, pcol=tl&63;
    #pragma unroll
    for(int a=0;a<2;++a){ const int pos=a?pcol:prow;
      #pragma unroll
      for(int j=0;j<8;++j){ const float cs=RT[2*(pos*16+hi*8+j)], sn=RT[2*(pos*16+hi*8+j)+1]; const float x1=qf[2*a][j], x2=qf[2*a+1][j];
        qf[2*a][j]=x1*cs-x2*sn; qf[2*a+1][j]=x2*cs+x1*sn; } }
    #pragma unroll
    for(int d0=0;d0<4;++d0){ u32x4 w;
      w[0]=cvtpk_s(qf[d0][0]*C2,qf[d0][1]*C2); w[1]=cvtpk_s(qf[d0][2]*C2,qf[d0][3]*C2); w[2]=cvtpk_s(qf[d0][4]*C2,qf[d0][5]*C2); w[3]=cvtpk_s(qf[d0][6]*C2,qf[d0][7]*C2);
      qr[d0]=__builtin_bit_cast(bf16x8,w); } }
  float mhat=0.f,l_reg=0.f;f32x16 o[2];o[0]=f32x16{};o[1]=f32x16{};f32x16 negm=f32x16{};asm volatile("":"+v"(negm));

  #define CMASK(P0,P1,t) do{}while(0)
  bool resc=false;
  #define START(P0,P1) do{ const float rm=rowmax(P0,P1); resc=false; \
    { const float dl=rm; mhat=fadd_s(mhat,dl); \
      _Pragma("unroll") for(int r=0;r<16;++r){P0[r]=fsub_s(P0[r],dl);P1[r]=fsub_s(P1[r],dl);} \
      _Pragma("unroll") for(int r=0;r<16;++r)negm[r]=-mhat; asm volatile("":"+v"(negm)); } \
    _Pragma("unroll") for(int r=0;r<16;++r)P0[r]=__builtin_amdgcn_exp2f(P0[r]); }while(0)
  #define RESC() do{ if(resc){ asm volatile("s_waitcnt lgkmcnt(0)":::"memory"); \
      _Pragma("unroll") for(int d_=0;d_<2;++d_) _Pragma("unroll") for(int r=0;r<16;++r)o[d_][r]*=wsf[crow(r,hi)]; } }while(0)
  f32x16 pA0,pA1,pB0,pB1;
  int sl_prev=0,sl_cur=0,sl_next=SLOTB;
  #define ROT() do{sl_prev=sl_cur;sl_cur=sl_next;sl_next=(sl_next==(NSLOT-1)*SLOTB)?0:sl_next+SLOTB;}while(0)
  DMA_K(2,2*SLOTB);
  WAIT_BAR(3);
  qkt(pA0,pA1,Kbase,qr,negm,r32,hi);asm volatile("s_nop 15\n\ts_nop 7":"+v"(pA0),"+v"(pA1));CMASK(pA0,pA1,0);
  START(pA0,pA1);
  _Pragma("unroll") for(int r=0;r<16;++r)pA1[r]=__builtin_amdgcn_exp2f(pA1[r]);
  WAIT_BAR(0);
  DMA_K(3,0);DMA_V(1,SLOTB);
  ROT();
  kload8(kf,kp0+sl_cur);
  WAIT_BAR(2);
  s16x4 vlo[8],vhi[8]; u32x4 pw0,pw1,pw2,pw3;
  #define PKW(P,B) cvtpk_s(P[B],P[B+1])
  #define PAF(k) __builtin_bit_cast(bf16x8,pw##k)
  #define VFR(i) (bf16x8){vlo[i][0],vlo[i][1],vlo[i][2],vlo[i][3],vhi[i][0],vhi[i][1],vhi[i][2],vhi[i][3]}
  #define PIN(x) asm volatile("":"+v"(x))
  #define MX3(a,b,c) __builtin_fmaxf(__builtin_fmaxf((a),(b)),(c))
  #define GAPA(MF,A0,A1,A2,A3,W0,W1,PW) do{ MF; sacc+=A0; sacc+=A1; sacc+=A2; sacc+=A3; PIN(sacc); W0; W1; PIN(PW); SBAR(); }while(0)
  #define EX(v) __builtin_amdgcn_exp2f(v)
  #define GAPB(MF,X,B) do{ MF; X[B]=EX(X[B]); X[B+1]=EX(X[B+1]); X[B+2]=EX(X[B+2]); X[B+3]=EX(X[B+3]); PIN(X); SBAR(); }while(0)
  #define VRD(i) do{ vlo[i]=vtr(vp_+(((i)>>2)*4096+((i)&3)*1024)); vhi[i]=vtr(vp_+(((i)>>2)*4096+((i)&3)*1024+512)); }while(0)
  #define KRD(G,j) do{ if(G){ kload2(kf,kp0+sl_next,j); SBAR(); } }while(0)
  #define STEP(C0,C1,P0,P1,t,GK,GV,GL) do{ SBAR(); \
    const lds_cptr vp_=vp0+sl_prev; \
    VRD(0); SBAR(); float sacc=(P0[0]+P0[1]); \
    GAPA(C0=__builtin_amdgcn_mfma_f32_32x32x16_bf16(kf[0],qr[0],negm,0,0,0), P0[2],P0[3],P0[4],P0[5],     pw0[0]=PKW(P0,0), pw0[1]=PKW(P0,2), pw0); \
    VRD(4); SBAR(); GAPA(C1=__builtin_amdgcn_mfma_f32_32x32x16_bf16(kf[1],qr[0],negm,0,0,0), P0[6],P0[7],P0[8],P0[9],     pw0[2]=PKW(P0,4), pw0[3]=PKW(P0,6), pw0); \
    VRD(1); SBAR(); GAPA(C0=__builtin_amdgcn_mfma_f32_32x32x16_bf16(kf[2],qr[1],C0,0,0,0),   P0[10],P0[11],P0[12],P0[13], pw1[0]=PKW(P0,8), pw1[1]=PKW(P0,10), pw1); \
    VRD(5); SBAR(); GAPA(C1=__builtin_amdgcn_mfma_f32_32x32x16_bf16(kf[3],qr[1],C1,0,0,0),   P0[14],P0[15],P1[0],P1[1],   pw1[2]=PKW(P0,12),pw1[3]=PKW(P0,14), pw1); \
    VRD(2); SBAR(); GAPA(C0=__builtin_amdgcn_mfma_f32_32x32x16_bf16(kf[4],qr[2],C0,0,0,0),   P1[2],P1[3],P1[4],P1[5],     pw2[0]=PKW(P1,0), pw2[1]=PKW(P1,2), pw2); \
    VRD(6); SBAR(); GAPA(C1=__builtin_amdgcn_mfma_f32_32x32x16_bf16(kf[5],qr[2],C1,0,0,0),   P1[6],P1[7],P1[8],P1[9],     pw2[2]=PKW(P1,4), pw2[3]=PKW(P1,6), pw2); \
    VRD(3); SBAR(); GAPA(C0=__builtin_amdgcn_mfma_f32_32x32x16_bf16(kf[6],qr[3],C0,0,0,0),   P1[10],P1[11],P1[12],P1[13], pw3[0]=PKW(P1,8), pw3[1]=PKW(P1,10), pw3); \
    VRD(7); SBAR(); GAPA(C1=__builtin_amdgcn_mfma_f32_32x32x16_bf16(kf[7],qr[3],C1,0,0,0),   P1[14],P1[15],0.f,0.f,       pw3[2]=PKW(P1,12),pw3[3]=PKW(P1,14), pw3); \
    l_reg+=sacc; \
    if(GK){DMA_K((t)+3,sl_cur);} if(GV){DMA_V((t)+1,sl_next);} \
    CMASK(C0,C1,t); \
    { float a=MX3(C0[0],C0[1],C1[0]),b=MX3(C0[2],C0[3],C1[1]); a=MX3(a,C1[2],C1[3]); \
      _Pragma("unroll") for(int r=4;r<16;r+=4){a=MX3(a,C0[r],C0[r+1]);b=MX3(b,C0[r+2],C0[r+3]);a=MX3(a,C1[r],C1[r+1]);b=MX3(b,C1[r+2],C1[r+3]);} \
      float rm=__builtin_fmaxf(a,b); { auto rr=__builtin_amdgcn_permlane32_swap(__float_as_uint(rm),__float_as_uint(rm),false,false); rm=__builtin_fmaxf(__uint_as_float(rr[0]),__uint_as_float(rr[1])); } \
      resc=false; \
      if(__builtin_expect(__any(rm>(float)THRL),0)){ const float dl=__builtin_fmaxf(rm,0.f); mhat+=dl; \
        _Pragma("unroll") for(int r=0;r<16;++r){C0[r]-=dl;C1[r]-=dl;} \
        _Pragma("unroll") for(int r=0;r<16;++r)negm[r]=-mhat; asm volatile("":"+v"(negm)); \
        const float f=__builtin_amdgcn_exp2f(-dl); l_reg*=f; if(hi==0)wsf[r32]=f; resc=true; } } \
    SBAR(); \
    GAPB(o[0]=__builtin_amdgcn_mfma_f32_32x32x16_bf16(PAF(0),VFR(0),o[0],0,0,0), C0,0); \
    GAPB(o[1]=__builtin_amdgcn_mfma_f32_32x32x16_bf16(PAF(0),VFR(4),o[1],0,0,0), C0,4); \
    KRD(GL,0); GAPB(o[0]=__builtin_amdgcn_mfma_f32_32x32x16_bf16(PAF(1),VFR(1),o[0],0,0,0), C0,8); \
    KRD(GL,1); GAPB(o[1]=__builtin_amdgcn_mfma_f32_32x32x16_bf16(PAF(1),VFR(5),o[1],0,0,0), C0,12); \
    KRD(GL,2); GAPB(o[0]=__builtin_amdgcn_mfma_f32_32x32x16_bf16(PAF(2),VFR(2),o[0],0,0,0), C1,0); \
    KRD(GL,3); GAPB(o[1]=__builtin_amdgcn_mfma_f32_32x32x16_bf16(PAF(2),VFR(6),o[1],0,0,0), C1,4); \
    GAPB(o[0]=__builtin_amdgcn_mfma_f32_32x32x16_bf16(PAF(3),VFR(3),o[0],0,0,0), C1,8); \
    GAPB(o[1]=__builtin_amdgcn_mfma_f32_32x32x16_bf16(PAF(3),VFR(7),o[1],0,0,0), C1,12); \
    }while(0)
  int t=1;
  #undef CMASK
  #define CMASK(P0,P1,t) do{}while(0)
  for(;t+5<NT;t+=2){
    STEP(pB0,pB1,pA0,pA1,t,true,true,true);     WAIT_BAR(2); RESC(); ROT();
    STEP(pA0,pA1,pB0,pB1,t+1,true,true,true);   WAIT_BAR(2); RESC(); ROT();
  }
  #undef CMASK
  #define CMASK(P0,P1,t) do{}while(0)
  #define ENDW(tt) do{ if((tt)+3<NT){WAIT_BAR(2);} else if((tt)+2<NT){WAIT_BAR(1);} else {WAIT_BAR(0);} }while(0)
  for(;t+1<NT;t+=2){
    STEP(pB0,pB1,pA0,pA1,t,(t+3<NT),(t+1<NT),(t+1<NT));       ENDW(t);   RESC(); ROT();
    STEP(pA0,pA1,pB0,pB1,t+1,(t+4<NT),(t+2<NT),(t+2<NT));     ENDW(t+1); RESC(); ROT();
  }
  STEP(pB0,pB1,pA0,pA1,NT-1,false,false,false); RESC();
  { float sacc=pB0[0]+pB0[1]; _Pragma("unroll") for(int r=2;r<16;++r)sacc+=pB0[r]; _Pragma("unroll") for(int r=0;r<16;++r)sacc+=pB1[r]; l_reg+=sacc;
    pw0=(u32x4){PKW(pB0,0),PKW(pB0,2),PKW(pB0,4),PKW(pB0,6)};pw1=(u32x4){PKW(pB0,8),PKW(pB0,10),PKW(pB0,12),PKW(pB0,14)};pw2=(u32x4){PKW(pB1,0),PKW(pB1,2),PKW(pB1,4),PKW(pB1,6)};pw3=(u32x4){PKW(pB1,8),PKW(pB1,10),PKW(pB1,12),PKW(pB1,14)};
    SBAR(); pv(o,vb0+sl_cur,PAF(0),PAF(1),PAF(2),PAF(3)); }
  #undef PKW
  #undef PAF
  #undef VFR
  #undef PIN
  #undef MX3
  #undef GAPA
  #undef GAPB
  #undef EX
  #undef VRD
  #undef KRD
  #undef STEP
  #undef ENDW
  {auto rr=__builtin_amdgcn_permlane32_swap(__float_as_uint(l_reg),__float_as_uint(l_reg),false,false);l_reg=__uint_as_float(rr[0])+__uint_as_float(rr[1]);}
  if(hi==0)wsf[32+r32]=l_reg;asm volatile("s_waitcnt lgkmcnt(0)":::"memory");
  float rli[16];
  #pragma unroll
  for(int r=0;r<16;++r)rli[r]=__builtin_amdgcn_rcpf(wsf[32+crow(r,hi)]);
  bf16*Ow=Ow0+(long)wid*QBLK*OP;
  { bf16*stg=(bf16*)(shm+LDS_OST)+wid*2048;
    #pragma unroll
    for(int r=0;r<16;++r){const int orow=crow(r,hi);
      #pragma unroll
      for(int d0=0;d0<2;++d0)stg[orow*64+d0*32+r32]=__float2bfloat16(o[d0][r]*rli[r]);}
    asm volatile("s_waitcnt lgkmcnt(0)":::"memory");
    #pragma unroll
    for(int i=0;i<4;++i){const int row=i*8+(lane>>3),ch=lane&7; const u32x4 v=*(const u32x4*)(stg+row*64+ch*8); ATTN_STORE16(Ow+(long)row*OP+ch*8,v);} }
  asm volatile("s_waitcnt lgkmcnt(0)\n\ts_barrier":::"memory");
  #undef DMA_K
  #undef DMA_V
  #undef CMASK
  #undef START
  #undef RESC
  #undef ROT
}
__device__ __forceinline__ void attn_helper(const bf16*__restrict__ Kh,const bf16*__restrict__ Vh,char*shm){
  const int tid=threadIdx.x,lane=tid&63; const int wid=__builtin_amdgcn_readfirstlane(tid>>6);
  const unsigned lds0=(unsigned)(uintptr_t)shm;
  const bf16*ksrc=Kh+(long)lane*KVP+wid*8;
  const bf16*vsrc=Vh+(long)(16*(wid&3)+(lane>>2))*KVP+(wid>>2)*32+(lane&3)*8;
  const unsigned kdst=lds0+LDS_K+wid*1024, vdst=lds0+LDS_V+wid*1024;
  #define DMA_K(t,slot) glds16(ksrc+(long)(t)*KVBLK*KVP,(unsigned)__builtin_amdgcn_readfirstlane(kdst+(slot)))
  #define DMA_V(t,slot) glds16(vsrc+(long)(t)*KVBLK*KVP,(unsigned)__builtin_amdgcn_readfirstlane(vdst+(slot)))
  #define ROT() do{sl_prev=sl_cur;sl_cur=sl_next;sl_next=(sl_next==(NSLOT-1)*SLOTB)?0:sl_next+SLOTB;}while(0)
  #define ENDW(tt) do{ if((tt)+3<NT){WAIT_BAR(2);} else if((tt)+2<NT){WAIT_BAR(1);} else {WAIT_BAR(0);} }while(0)
  constexpr int NT=NTILES;
  int sl_prev=0,sl_cur=0,sl_next=SLOTB; (void)sl_prev;
  DMA_K(0,0);DMA_V(0,0);DMA_K(1,SLOTB);
  DMA_K(2,2*SLOTB);
  WAIT_BAR(3);
  WAIT_BAR(0);
  DMA_K(3,0);DMA_V(1,SLOTB);
  ROT();
  WAIT_BAR(2);
  int t=1;
  for(;t+5<NT;t+=2){
    DMA_K(t+3,sl_cur);DMA_V(t+1,sl_next); WAIT_BAR(2); ROT();
    DMA_K(t+4,sl_cur);DMA_V(t+2,sl_next); WAIT_BAR(2); ROT();
  }
  for(;t+1<NT;t+=2){
    if(t+3<NT){DMA_K(t+3,sl_cur);} if(t+1<NT){DMA_V(t+1,sl_next);} ENDW(t);   ROT();
    if(t+4<NT){DMA_K(t+4,sl_cur);} if(t+2<NT){DMA_V(t+2,sl_next);} ENDW(t+1); ROT();
  }
  asm volatile("s_barrier":::"memory");
  #undef DMA_K
  #undef DMA_V
  #undef ROT
  #undef ENDW
}
constexpr int ATTN_LDS_BYTES=LDS_BYTES;
#undef SBAR
#undef WAIT_BAR
}
#define GAS __attribute__((address_space(1)))
#define LAS __attribute__((address_space(3)))
typedef unsigned short bf16;
typedef unsigned v4u __attribute__((ext_vector_type(4)));
typedef float f32x4 __attribute__((ext_vector_type(4)));
typedef short bf16x8 __attribute__((ext_vector_type(8)));
typedef GAS unsigned gu32;
typedef GAS unsigned long long gu64;
#define RLX_AGENT __ATOMIC_RELAXED, __HIP_MEMORY_SCOPE_AGENT
#define LDS_WAIT() asm volatile("s_waitcnt lgkmcnt(0)" ::: "memory")
#define VM_WAIT() asm volatile("s_waitcnt vmcnt(0)" ::: "memory")
__device__ __forceinline__ unsigned long long rt() { return __builtin_amdgcn_s_memrealtime(); }
__device__ __forceinline__ unsigned f2bf(float f) { unsigned u = __builtin_bit_cast(unsigned, f); return (u + 0x7fffu + ((u >> 16) & 1u)) >> 16; }
__device__ __forceinline__ unsigned pk2(float lo, float hi) { return f2bf(lo) | (f2bf(hi) << 16); }

#define XB_TMO      128
#define XB_XCNT(j)  (256  + 64 * (j))
#define XB_XSUB(j)  (1280 + 64 * (j))
#define XB_XGEN(j)  (2304 + 64 * (j))
#define XB_TOP      3328
#define XB_TOPGEN   3392
#define XCD_BAR_WORDS 3456
#define XB_SPIN_CAP (1u << 18)

__device__ __forceinline__ unsigned xb_ld(unsigned* p)              { return __hip_atomic_load(p, __ATOMIC_RELAXED, __HIP_MEMORY_SCOPE_AGENT); }
__device__ __forceinline__ unsigned xb_add(unsigned* p, unsigned v) { return __hip_atomic_fetch_add(p, v, __ATOMIC_RELAXED, __HIP_MEMORY_SCOPE_AGENT); }
__device__ __forceinline__ unsigned xb_xcc_id() { return (unsigned)__builtin_amdgcn_s_getreg((3 << 11) | 20) & 0xFu; }
#define XB_SPIN(cond, bar) do { unsigned _sp = 0; while (cond) { __builtin_amdgcn_s_sleep(1); \
    if ((++_sp & 255u) == 0u) { if (xb_ld(&(bar)[XB_TMO])) break; if (_sp > XB_SPIN_CAP) { atomicAdd(&(bar)[XB_TMO], 1u); break; } } } } while (0)

struct XcdBarrier {
    unsigned* bar; unsigned x;
    volatile LAS unsigned* st;
};

__device__ __forceinline__ XcdBarrier xcd_barrier_post(unsigned* bar, volatile LAS unsigned* st) {
    XcdBarrier b; b.bar = bar; b.x = xb_xcc_id(); b.st = st;
    if (threadIdx.x == 0) (void)xb_add(&bar[XB_XCNT(b.x)], 1u);
    return b;
}
__device__ __forceinline__ void xcd_barrier_complete(unsigned* bar, unsigned x, unsigned& nloc, unsigned& nx) {
    const unsigned G = gridDim.x * gridDim.y * gridDim.z;
    unsigned sum, cnt, mine, sp = 0u;
    for (;;) {
        sum = 0u; cnt = 0u; mine = 0u;
#pragma unroll
        for (unsigned j = 0; j < 16; ++j) { const unsigned c = xb_ld(&bar[XB_XCNT(j)]); sum += c; cnt += (c > 0u) ? 1u : 0u; mine = (j == x) ? c : mine; }
        if (sum == G) break;
        __builtin_amdgcn_s_sleep(1);
        if ((++sp & 255u) == 0u) { if (xb_ld(&bar[XB_TMO])) break; if (sp > XB_SPIN_CAP) { atomicAdd(&bar[XB_TMO], 1u); break; } }
    }
    nloc = mine > 0u ? mine : 1u; nx = cnt > 0u ? cnt : 1u;
}

__device__ __forceinline__ void xcd_barrier(const XcdBarrier& b) {
    asm volatile("s_waitcnt vmcnt(0)" ::: "memory");
    __syncthreads();
    if (threadIdx.x == 0) {
        unsigned* bar = b.bar;
        __builtin_amdgcn_s_waitcnt(0);
        unsigned nloc = b.st[0], nx = b.st[1];
        if (nloc == 0u) { xcd_barrier_complete(bar, b.x, nloc, nx); b.st[0] = nloc; b.st[1] = nx; }
        const unsigned old = xb_add(&bar[XB_XSUB(b.x)], 1u);
        const unsigned gen = old / nloc;
        if (old + 1u == (gen + 1u) * nloc) {
            __builtin_amdgcn_fence(__ATOMIC_RELEASE, "agent");
            asm volatile("s_waitcnt vmcnt(0)" ::: "memory");
            const unsigned og = xb_add(&bar[XB_TOP], 1u);
            const unsigned tg = og / nx;
            if (og + 1u == (tg + 1u) * nx) xb_add(&bar[XB_TOPGEN], 1u);
            else XB_SPIN(xb_ld(&bar[XB_TOPGEN]) == tg, bar);
            __builtin_amdgcn_fence(__ATOMIC_ACQUIRE, "agent");
            xb_add(&bar[XB_XGEN(b.x)], 1u);
            asm volatile("s_waitcnt vmcnt(0)" ::: "memory");
        } else {
            XB_SPIN(xb_ld(&bar[XB_XGEN(b.x)]) == gen, bar);
            __builtin_amdgcn_fence(__ATOMIC_ACQUIRE, "agent");
            asm volatile("s_waitcnt vmcnt(0)" ::: "memory");
        }
    }
    __syncthreads();
}

__device__ __forceinline__ void xcd_barrier_arrive(const XcdBarrier& b, volatile LAS unsigned* tk) {
    asm volatile("s_waitcnt vmcnt(0)" ::: "memory");
    __syncthreads();
    if (threadIdx.x == 0) {
        unsigned* bar = b.bar;
        __builtin_amdgcn_s_waitcnt(0);
        unsigned nloc = b.st[0], nx = b.st[1];
        if (nloc == 0u) { xcd_barrier_complete(bar, b.x, nloc, nx); b.st[0] = nloc; b.st[1] = nx; }
        const unsigned old = xb_add(&bar[XB_XSUB(b.x)], 1u);
        const unsigned gen = old / nloc;
        unsigned role = 0u, tg = 0u;
        if (old + 1u == (gen + 1u) * nloc) {
            __builtin_amdgcn_fence(__ATOMIC_RELEASE, "agent");
            asm volatile("s_waitcnt vmcnt(0)" ::: "memory");
            const unsigned og = xb_add(&bar[XB_TOP], 1u);
            tg = og / nx;
            if (og + 1u == (tg + 1u) * nx) { xb_add(&bar[XB_TOPGEN], 1u); role = 2u; } else role = 1u;
        }
        tk[0] = role; tk[1] = gen; tk[2] = tg;
    }
}
__device__ __forceinline__ void xcd_barrier_wait(const XcdBarrier& b, volatile LAS unsigned* tk) {
    if (threadIdx.x == 0) {
        unsigned* bar = b.bar;
        const unsigned role = tk[0], gen = tk[1], tg = tk[2];
        if (role != 0u) {
            if (role == 1u) XB_SPIN(xb_ld(&bar[XB_TOPGEN]) == tg, bar);
            __builtin_amdgcn_fence(__ATOMIC_ACQUIRE, "agent");
            xb_add(&bar[XB_XGEN(b.x)], 1u);
            asm volatile("s_waitcnt vmcnt(0)" ::: "memory");
        } else {
            XB_SPIN(xb_ld(&bar[XB_XGEN(b.x)]) == gen, bar);
            __builtin_amdgcn_fence(__ATOMIC_ACQUIRE, "agent");
            asm volatile("s_waitcnt vmcnt(0)" ::: "memory");
        }
    }
    __syncthreads();
}
constexpr int NB = 8, SEQL = 2048, CTXL = 256, TOK = 2304, DM_ = 1024, MROWS = NB * TOK, NLAT = NB * SEQL, INW = 2832, NIN = 2816;
constexpr int NPHASE = 9;
#ifndef REP_VAL
#define REP_VAL 1
#endif
#ifndef MK_MULTI
#define MK_MULTI 0
#endif
constexpr size_t MiB = 1u << 20;
constexpr size_t WS_CTL = 0, CTL_ZERO_BYTES = 65536;
constexpr size_t WS_MOD = 1 * MiB;
constexpr size_t WS_ROPE = WS_MOD + 256 * 1024;
constexpr size_t WS_G = 2 * MiB;
constexpr size_t WS_BETA = WS_G + 640 * 1024;
constexpr size_t WS_EG = WS_BETA + 640 * 1024;
constexpr size_t WS_EK = WS_EG + 640 * 1024;
constexpr size_t WS_GLAST = WS_EK + 640 * 1024;
constexpr size_t WS_AFF = 5 * MiB;
constexpr size_t WS_IDX = 6 * MiB;
constexpr size_t WS_GATE = WS_IDX + 256 * 1024;
constexpr size_t WS_XROW = WS_IDX + 512 * 1024;
constexpr size_t WS_INV = 7 * MiB;
constexpr size_t S1 = 8 * MiB;
constexpr size_t WS_XN = S1;
constexpr size_t WS_DQ = WS_XN, WS_DK = WS_XN + 18 * MiB;
constexpr size_t WS_PD = WS_XN + 36 * MiB;

constexpr size_t WS_DKT = WS_PD + 54 * MiB;
constexpr size_t WS_DVT = WS_DKT + 18 * MiB;
constexpr size_t WS_PA = WS_DVT + 18 * MiB;
constexpr size_t WS_PZ = WS_PA + 27 * MiB;
constexpr size_t WS_Y = WS_PZ + 18 * MiB;
constexpr size_t WS_DO = WS_Y + 32 * MiB;
constexpr size_t WS_WIN = WS_DO + 32 * MiB;
constexpr size_t WS_WOUT = WS_WIN + 6 * MiB;
constexpr size_t WS_WU2 = WS_WOUT + 2 * MiB;
constexpr size_t WS_QKD2 = WS_WU2 + 27 * MiB;
constexpr size_t WS_QKD = WS_QKD2;
constexpr size_t WS_END1 = WS_QKD2 + 16 * MiB;
constexpr size_t WS_WGU = S1;
constexpr size_t WS_YB = WS_WGU;
constexpr size_t WS_WD = WS_WGU + 64 * MiB;
constexpr size_t WS_H2 = WS_WD + 32 * MiB;
constexpr size_t WS_XG = WS_H2 + 32 * MiB;
constexpr size_t WS_X1 = WS_XG + 32 * MiB;
constexpr size_t WS_HID = WS_XG + 64 * MiB;
constexpr size_t WS_END2 = WS_HID + 64 * MiB;
constexpr size_t WS_NEED = WS_END1 > WS_END2 ? WS_END1 : WS_END2;
constexpr int CW_TMO = 0, CW_CODE = 1, CW_ATTNQ = 64, CW_SCAN = 512, CW_P6Q = 576, CW_ROWS = 640, CW_CVQ = 704, CW_CHAIN = 768, CW_CHAIN2 = 896, CW_XSUB2 = 1024  , CW_TOP2 = 2048, CW_XSUB3 = 2112  , CW_XCNTS = 3200  , CW_XSUBS = 3456  , CW_BAR = 4096;
constexpr int LDS_BYTES = 147456;
constexpr int MISC_OFF = 146944;

typedef unsigned u32x2 __attribute__((ext_vector_type(2)));
__device__ __forceinline__ float bf2f(unsigned short h) { return __builtin_bit_cast(float, (unsigned)h << 16); }
__device__ __forceinline__ float bflo(unsigned w) { return __builtin_bit_cast(float, w << 16); }
__device__ __forceinline__ float bfhi(unsigned w) { return __builtin_bit_cast(float, w & 0xffff0000u); }
__device__ __forceinline__ float wave_sum(float v) {
    int x = __builtin_bit_cast(int, v);
#define WS_STEP(ctrl, rmask) do { const int t_ = __builtin_amdgcn_update_dpp(0, x, (ctrl), (rmask), 0xf, false); x = __builtin_bit_cast(int, __builtin_bit_cast(float, x) + __builtin_bit_cast(float, t_)); } while (0)
    WS_STEP(0xB1, 0xf);
    WS_STEP(0x4E, 0xf);
    WS_STEP(0x141, 0xf);
    WS_STEP(0x140, 0xf);
    WS_STEP(0x142, 0xa);
    WS_STEP(0x143, 0xc);
#undef WS_STEP
    return __builtin_bit_cast(float, __builtin_amdgcn_readlane(x, 63));
}
__device__ __forceinline__ float dpp_xor1(float v) { return __builtin_bit_cast(float, __builtin_amdgcn_update_dpp(0, __builtin_bit_cast(int, v), 0xB1, 0xf, 0xf, false)); }
__device__ __forceinline__ float dpp_xor2(float v) { return __builtin_bit_cast(float, __builtin_amdgcn_update_dpp(0, __builtin_bit_cast(int, v), 0x4E, 0xf, 0xf, false)); }
__device__ __forceinline__ float row16_sum(float v) {
    v += dpp_xor1(v); v += dpp_xor2(v);
    v += __builtin_bit_cast(float, __builtin_amdgcn_update_dpp(0, __builtin_bit_cast(int, v), 0x141, 0xf, 0xf, false));
    v += __builtin_bit_cast(float, __builtin_amdgcn_update_dpp(0, __builtin_bit_cast(int, v), 0x140, 0xf, 0xf, false));
    return v;
}
__device__ __forceinline__ float reduce16(const float (&a)[16], int lane) {
    float b8[8], b4[4], b2[2];
#pragma unroll
    for (int e = 0; e < 8; ++e) { const float send = (lane & 32) ? a[e] : a[e + 8], keep = (lane & 32) ? a[e + 8] : a[e]; b8[e] = keep + __shfl_xor(send, 32); }
#pragma unroll
    for (int e = 0; e < 4; ++e) { const float send = (lane & 16) ? b8[e] : b8[e + 4], keep = (lane & 16) ? b8[e + 4] : b8[e]; b4[e] = keep + __shfl_xor(send, 16); }
#pragma unroll
    for (int e = 0; e < 2; ++e) { const float send = (lane & 8) ? b4[e] : b4[e + 2], keep = (lane & 8) ? b4[e + 2] : b4[e]; b2[e] = keep + __shfl_xor(send, 8); }
    const float send = (lane & 4) ? b2[0] : b2[1], keep = (lane & 4) ? b2[1] : b2[0];
    float r = keep + __shfl_xor(send, 4);
    r += dpp_xor2(r); r += dpp_xor1(r);
    return r;
}

typedef float f32x2_t __attribute__((ext_vector_type(2))); typedef __bf16 bf16x2_t __attribute__((ext_vector_type(2)));
typedef float f32x16 __attribute__((ext_vector_type(16)));
__device__ __forceinline__ unsigned cvtpk(float lo, float hi) { f32x2_t v = {lo, hi}; bf16x2_t b = __builtin_convertvector(v, bf16x2_t); return __builtin_bit_cast(unsigned, b); }
__device__ __forceinline__ int perm16(int p) { return 8 * ((p >> 2) & 1) + 4 * ((p >> 3) & 1) + (p & 3); }
struct Frame {
    LAS unsigned char* lds; unsigned char* ldsg;
    volatile LAS unsigned* MISC;
    gu32* ctl;
    int tid, lane, wave, G, gw, NGW;
    float* out; unsigned char* ws;
};
#define WSP(T, off) ((T*)(F.ws + (off)))
#ifdef PROF
#define PROF_WORD 8192
#define PROF_EV(k) do { if (F.tid == 0) __hip_atomic_store(F.ctl + PROF_WORD + (k) * 256 + blockIdx.x, (unsigned)__builtin_amdgcn_s_memrealtime(), RLX_AGENT); } while (0)
#else
#define PROF_EV(k) do {} while (0)
#endif
__device__ __forceinline__ unsigned char* wu_group(Frame& F, int g) { return g < 6 ? F.ws + WS_PD + (size_t)g * 9 * MiB : g < 13 ? (unsigned char*)F.out + (size_t)(g - 6) * 9 * MiB : F.ws + WS_WU2 + (size_t)(g - 13) * 9 * MiB; }

__device__ __forceinline__ void transpose_item(const float* W, int ldw, int k0, int n0, bf16* dst, int K, LAS float* scr, int lane) {
    f32x4 ld[8];
#pragma unroll
    for (int i = 0; i < 8; ++i) ld[i] = __builtin_nontemporal_load((const f32x4*)(W + (size_t)(k0 + 8 * i + (lane >> 3)) * ldw + n0 + 4 * (lane & 7)));
#pragma unroll
    for (int i = 0; i < 8; ++i) { LAS float* d = scr + (8 * i + (lane >> 3)) * 33 + 4 * (lane & 7); d[0] = ld[i].x; d[1] = ld[i].y; d[2] = ld[i].z; d[3] = ld[i].w; }
    LDS_WAIT(); asm volatile("" ::: "memory");
    const int c = lane & 7;
#pragma unroll
    for (int j = 0; j < 4; ++j) { const int n = (lane >> 3) + 8 * j; const LAS float* s = scr + (8 * c) * 33 + n;
        v4u o; o.x = pk2(s[0 * 33], s[1 * 33]); o.y = pk2(s[2 * 33], s[3 * 33]); o.z = pk2(s[4 * 33], s[5 * 33]); o.w = pk2(s[6 * 33], s[7 * 33]);
        *(GAS v4u*)(dst + (size_t)n * K + 8 * c) = o; }
    LDS_WAIT(); asm volatile("" ::: "memory");
}
__device__ __forceinline__ void p0_phase(Frame& F, const float* c_, const float* c_ctx_, const float* w_mod_, const float* b_mod_, const float* w_in_, const float* w_out_) {
    float* MOD = WSP(float, WS_MOD);
    if (blockIdx.x < 192) {
        LAS float* sc = (LAS float*)F.lds;
        LAS float* red = (LAS float*)(F.lds + 36864);
        const int col = F.tid & 31, kg = F.tid >> 5, n0 = blockIdx.x * 32;
        float acc[9];
#pragma unroll
        for (int r = 0; r < 9; ++r) acc[r] = 0.f;
        const float* wp = w_mod_ + n0 + col;
        float wv[64];
#pragma unroll
        for (int i = 0; i < 16; ++i)
#pragma unroll
            for (int j = 0; j < 4; ++j) wv[4 * i + j] = __builtin_nontemporal_load(wp + (size_t)(4 * (kg + 16 * i) + j) * 6144);
        { float cv[18];
#pragma unroll
          for (int q = 0; q < 18; ++q) { const int i = F.tid + 512 * q, r = i >> 10, k = i & 1023; cv[q] = (r < 8) ? c_[r * 1024 + k] : c_ctx_[k]; }
#pragma unroll
          for (int q = 0; q < 18; ++q) { const float v = cv[q]; sc[F.tid + 512 * q] = v * __builtin_amdgcn_rcpf(1.0f + __expf(-v)); } }
        __syncthreads();
#pragma unroll
        for (int i = 0; i < 16; ++i) { const int k = 4 * (kg + 16 * i);
#pragma unroll
            for (int r = 0; r < 9; ++r) { const f32x4 s4 = *(const LAS f32x4*)(sc + r * 1024 + k); acc[r] += (s4.x * wv[4 * i] + s4.y * wv[4 * i + 1]) + (s4.z * wv[4 * i + 2] + s4.w * wv[4 * i + 3]); } }
#pragma unroll
        for (int r = 0; r < 9; ++r) red[(kg * 9 + r) * 32 + col] = acc[r];
        __syncthreads();
        if (F.tid < 288) { const int r = F.tid >> 5, cc = F.tid & 31; float s = 0.f;
#pragma unroll
            for (int g2 = 0; g2 < 16; ++g2) s += red[(g2 * 9 + r) * 32 + cc];
            MOD[r * 6144 + n0 + cc] = s + b_mod_[n0 + cc]; }
        __syncthreads();
    } else if (blockIdx.x == 200) {
        float* RT = WSP(float, WS_ROPE);
        for (int i = F.tid; i < 1024; i += 512) { const int pos = i >> 4, fi = i & 15; const float fr = powf(10000.0f, -(float)fi / 16.0f); const float ang = (float)pos * fr;
            RT[2 * i] = cosf(ang); RT[2 * i + 1] = sinf(ang); }
    }
    LAS float* scr = (LAS float*)(F.lds + 57344 + F.wave * 8448);
    bf16* WinT = WSP(bf16, WS_WIN); bf16* WoutT = WSP(bf16, WS_WOUT);
    constexpr int I_IN = 16 * 88, I_OUT = 16 * 32;
    for (int it = F.gw; it < I_IN + I_OUT; it += F.NGW) {
        if (it < I_IN) { const int kb = it / 88, nb = it % 88; transpose_item(w_in_, INW, 64 * kb, 32 * nb, WinT + (size_t)(32 * nb) * 1024 + 64 * kb, 1024, scr, F.lane); }
        else { const int r = it - I_IN, kb = r / 32, nb = r % 32; transpose_item(w_out_, 1024, 64 * kb, 32 * nb, WoutT + (size_t)(32 * nb) * 1024 + 64 * kb, 1024, scr, F.lane); }
    }
}

__device__ __forceinline__ float softplus_f(float x) { return fmaxf(x, 0.f) + __logf(1.0f + __expf(-fabsf(x))); }
__device__ __forceinline__ void p1_row(const f32x4 (&wr0)[32], const f32x4 (&v)[4], int row, int lane, const LAS float* wt, const LAS float* nwl, const LAS float* mdl, bf16* XN, float* Gg, float* Bt, float cA, float cB) {
    const int b = row / TOK, t = row - b * TOK;
    const LAS float* mod = mdl + (t < CTXL ? 8 : b) * 2048;
    float ss = 0.f;
#pragma unroll
    for (int j = 0; j < 4; ++j) ss += (v[j].x * v[j].x + v[j].y * v[j].y) + (v[j].z * v[j].z + v[j].w * v[j].w);
    const float rstd = __builtin_amdgcn_rsqf(wave_sum(ss) * (1.0f / 1024.0f) + 1e-6f);
    f32x4 acc4[4];
#pragma unroll
    for (int e = 0; e < 4; ++e) acc4[e] = (f32x4){0.f, 0.f, 0.f, 0.f};
#pragma unroll
    for (int j = 0; j < 4; ++j) { const int k = 4 * lane + 256 * j;
        const f32x4 nw = *(const LAS f32x4*)(nwl + k), sh = *(const LAS f32x4*)(mod + k), sc = *(const LAS f32x4*)(mod + 1024 + k);
        const f32x4 h = (v[j] * rstd) * nw * (sc + 1.0f) + sh;
        u32x2 w; w.x = cvtpk(h.x, h.y); w.y = cvtpk(h.z, h.w); *(u32x2*)(XN + (size_t)row * 1024 + k) = w;
#pragma unroll
        for (int c = 0; c < 4; ++c) { const float hk = h[c];
            if (j < 2) {
#pragma unroll
                for (int e4 = 0; e4 < 4; ++e4) acc4[e4] += wr0[j * 16 + c * 4 + e4] * hk;
            } else { const LAS f32x4* wp = (const LAS f32x4*)(wt + ((c + 4 * j) * 256 + lane) * 4);
#pragma unroll
                for (int e4 = 0; e4 < 4; ++e4) acc4[e4] += wp[e4 * 64] * hk; } }
        asm volatile("" ::: "memory"); }
    float acc[16];
#pragma unroll
    for (int e = 0; e < 16; ++e) acc[e] = acc4[e >> 2][e & 3];
    const float val = reduce16(acc, lane);
    if ((lane & 3) == 0) { const int e = lane >> 2;
        if (e < 8) { const int dir = e >> 2, hh = e & 3; Bt[(size_t)((dir * 8 + b) * 4 + hh) * TOK + t] = __builtin_amdgcn_rcpf(1.0f + __expf(-val)); }
        else { const int e2 = e - 8, dir = e2 >> 2, hh = e2 & 3; Gg[(size_t)((dir * 8 + b) * 4 + hh) * TOK + t] = cA * softplus_f(val + cB); } }
}
__device__ __forceinline__ void p1_phase(Frame& F, const float* x_, const float* ctx_, const float* norm1_w_, const float* w_in_, const float* a_log_, const float* dt_bias_, int rep) {
    LAS float* wt = (LAS float*)F.lds;
    LAS float* nwl = wt + 16384;
    LAS float* mdl = nwl + 1024;
    const float* MOD = WSP(float, WS_MOD); bf16* XN = WSP(bf16, WS_XN); float* Gg = WSP(float, WS_G); float* Bt = WSP(float, WS_BETA);
    {
        f32x4 tw[8], tm[9], tn;
#pragma unroll
        for (int q = 0; q < 8; ++q) { const int idx = F.tid + 512 * q, k = idx >> 2, e4 = idx & 3; tw[q] = *(const f32x4*)(w_in_ + (size_t)k * INW + NIN + 4 * e4); }
#pragma unroll
        for (int q = 0; q < 9; ++q) { const int idx = F.tid + 512 * q; tm[q] = *(const f32x4*)(MOD + (size_t)(idx >> 9) * 6144 + (idx & 511) * 4); }
        tn = *(const f32x4*)(norm1_w_ + 4 * (F.tid & 255));
#pragma unroll
        for (int q = 0; q < 8; ++q) { const int idx = F.tid + 512 * q, k = idx >> 2, e4 = idx & 3; *(LAS f32x4*)(wt + ((((k & 3) + 4 * (k >> 8)) * 4 + e4) * 64 + ((k & 255) >> 2)) * 4) = tw[q]; }
#pragma unroll
        for (int q = 0; q < 9; ++q) { const int idx = F.tid + 512 * q; *(LAS f32x4*)(mdl + (idx >> 9) * 2048 + (idx & 511) * 4) = tm[q]; }
        if (F.tid < 256) *(LAS f32x4*)(nwl + 4 * F.tid) = tn;
    }
    const int lane = F.lane;
    float cA = 0.f, cB = 0.f;
    { const int e = lane >> 2; if (e >= 8) { cA = -expf(a_log_[e - 8]); cB = dt_bias_[e - 8]; } }
#define P1_SRC(row) ((((row) % TOK) < CTXL) ? ctx_ + (size_t)(((row) / TOK) * CTXL + ((row) % TOK)) * 1024 : x_ + (size_t)(((row) / TOK) * SEQL + ((row) % TOK) - CTXL) * 1024)
#define P1_LOAD(P, row) do { const float* s_ = P1_SRC(row); _Pragma("unroll") for (int j_ = 0; j_ < 4; ++j_) P[j_] = __builtin_nontemporal_load((const f32x4*)(s_ + 4 * lane + 256 * j_)); } while (0)
    f32x4 P0[4], P1[4];
    const int r0 = F.gw, st = F.NGW;
    if (r0 < MROWS) P1_LOAD(P0, r0);
    if (r0 + st < MROWS) P1_LOAD(P1, r0 + st);
    __syncthreads();
    f32x4 wr0[32];
#pragma unroll
    for (int q = 0; q < 32; ++q) wr0[q] = *(const LAS f32x4*)(wt + ((q >> 2) * 256 + (q & 3) * 64 + lane) * 4);
    for (int row = r0; row < MROWS; row += 2 * st) {
        { f32x4 v[4];
#pragma unroll
          for (int j = 0; j < 4; ++j) v[j] = P0[j];
          if (row + 2 * st < MROWS) P1_LOAD(P0, row + 2 * st);
          p1_row(wr0, v, row, lane, wt, nwl, mdl, XN, Gg, Bt, cA, cB); }
        if (row + st < MROWS) { f32x4 v[4];
#pragma unroll
          for (int j = 0; j < 4; ++j) v[j] = P1[j];
          if (row + 3 * st < MROWS) P1_LOAD(P1, row + 3 * st);
          p1_row(wr0, v, row + st, lane, wt, nwl, mdl, XN, Gg, Bt, cA, cB); }
    }
#undef P1_SRC
#undef P1_LOAD
}

__device__ __forceinline__ void qk_prep8(float (&f)[8], const float* nw, bool rope, int prow, int pcol, const float* RT, int c, float scale) {
    float ss = 0.f;
#pragma unroll
    for (int j = 0; j < 8; ++j) ss += f[j] * f[j];
    ss += __shfl_xor(ss, 1); ss += __shfl_xor(ss, 2); ss += __shfl_xor(ss, 4);
    const float rstd = __builtin_amdgcn_rsqf(ss * (1.0f / 64.0f) + 1e-6f);
#pragma unroll
    for (int j = 0; j < 8; ++j) f[j] = f[j] * rstd * nw[8 * c + j];
    const int pos = (c & 4) ? pcol : prow;
#pragma unroll
    for (int j = 0; j < 8; ++j) { const float p = __shfl_xor(f[j], 2);
        if (rope) { const int fi = 8 * (c & 1) + j; const float cs = RT[2 * (pos * 16 + fi)], sn = RT[2 * (pos * 16 + fi) + 1]; f[j] = f[j] * cs + ((c & 2) ? p * sn : -p * sn); } }
#pragma unroll
    for (int j = 0; j < 8; ++j) f[j] *= scale;
}
#define CONV2(i, o0, o1) do { float a0_ = 0.f, a1_ = 0.f; _Pragma("unroll") for (int j_ = 0; j_ < 5; ++j_) { a0_ += bflo(raw[(i) + j_]) * w0[j_]; a1_ += bfhi(raw[(i) + j_]) * w1[j_]; } \
    o0 = a0_ * __builtin_amdgcn_rcpf(1.0f + __expf(-a0_)); o1 = a1_ * __builtin_amdgcn_rcpf(1.0f + __expf(-a1_)); } while (0)
template <int TY> __device__ __forceinline__ void conv_item(Frame& F, int it, const float* conv_w_) {
    const bf16* PD = WSP(bf16, WS_PD); bf16* DQ = WSP(bf16, WS_DQ); bf16* DK = WSP(bf16, WS_DK); bf16* DKT = WSP(bf16, WS_DKT); bf16* DVT = WSP(bf16, WS_DVT);
    LAS bf16* tile = (LAS bf16*)(F.lds + F.wave * 16640);
    const int lane = F.lane;
    const int hh = it & 3, bn = it / 12, n = bn % 36, b = bn / 36;
    const int t0 = 64 * n, lo = (n < 4) ? 0 : CTXL, hi = (n < 4) ? CTXL : TOK;
    const int col = TY * 512 + hh * 128 + 2 * lane;
    float w0[5], w1[5];
#pragma unroll
    for (int j = 0; j < 5; ++j) { w0[j] = conv_w_[j * 1536 + col]; w1[j] = conv_w_[j * 1536 + col + 1]; }
    const bf16* ub = PD + (size_t)(b * TOK) * 1536 + TY * 512 + hh * 128;
    const int lo2 = 2 * lane;
    unsigned raw[68];
#pragma unroll
    for (int i = 0; i < 68; ++i) { const int tt = t0 - 2 + i; const bool ok = (tt >= lo) && (tt < hi); const bf16* rp = ub + (size_t)__builtin_amdgcn_readfirstlane(ok ? tt : t0) * 1536; const unsigned vv = *(const unsigned*)(rp + lo2); raw[i] = ok ? vv : 0u; }
    const int dpos = ((2 * lane) & ~15) | perm16((2 * lane) & 15);
    float scl = 1.0f;
    if (TY < 2) {
        LAS float* sst = (LAS float*)tile;
#pragma unroll
        for (int i = 0; i < 64; ++i) { float a0, a1; CONV2(i, a0, a1); sst[i * 65 + lane] = a0 * a0 + a1 * a1; }
        LDS_WAIT(); asm volatile("" ::: "memory");
        float tot = 0.f;
#pragma unroll
        for (int j = 0; j < 64; ++j) tot += sst[lane * 65 + j];
        LDS_WAIT(); asm volatile("" ::: "memory");
        scl = ((TY == 0) ? 0.08838834764831845f : 1.0f) * __builtin_amdgcn_rsqf(tot + 1e-6f);
    }
#pragma unroll
    for (int i = 0; i < 64; ++i) {
        float a0, a1; CONV2(i, a0, a1);
        if (TY < 2) { const float sc = __builtin_bit_cast(float, __builtin_amdgcn_readlane(__builtin_bit_cast(int, scl), i)); a0 *= sc; a1 *= sc; }
        const unsigned pk = cvtpk(a0, a1);
        if (TY == 0) *(unsigned*)(DQ + ((size_t)(b * 4 + hh) * TOK + t0 + i) * 128 + dpos) = pk;
        if (TY == 1) *(unsigned*)(DK + ((size_t)(b * 4 + hh) * TOK + t0 + i) * 128 + dpos) = pk;
        if (TY >= 1) *(LAS unsigned*)(tile + i * 130 + 2 * lane) = pk;
    }
    if (TY >= 1) {
        LDS_WAIT(); asm volatile("" ::: "memory");
        bf16* dst = (TY == 1 ? DKT : DVT) + (size_t)((b * 4 + hh) * 36 + n) * 8192;
#pragma unroll 4
        for (int q = 0; q < 16; ++q) { const int ch = q * 8 + (lane >> 3), j0 = 8 * (lane & 7); const LAS bf16* s = tile + ((j0 & ~15) + 4 * ((j0 >> 3) & 1)) * 130 + ch;
            v4u o; o.x = (unsigned)s[0] | ((unsigned)s[130] << 16); o.y = (unsigned)s[260] | ((unsigned)s[390] << 16); o.z = (unsigned)s[8 * 130] | ((unsigned)s[9 * 130] << 16); o.w = (unsigned)s[10 * 130] | ((unsigned)s[11 * 130] << 16);
            *(v4u*)(dst + ch * 64 + j0) = o; }
        LDS_WAIT(); asm volatile("" ::: "memory");
    }
}
__device__ __forceinline__ void p3_phase(Frame& F, const float* q_norm_w_, const float* k_norm_w_, const float* conv_w_, int rep) {
    bf16* PA = WSP(bf16, WS_PA); const float* RT = WSP(float, WS_ROPE);
    for (int it = F.gw; it < NB * 36 * 12; it += F.NGW) {
        const int ty = (it >> 2) % 3;
        if (ty == 0) conv_item<0>(F, it, conv_w_); else if (ty == 1) conv_item<1>(F, it, conv_w_); else conv_item<2>(F, it, conv_w_);
    }
    if (rep == 0 && F.gw >= 1408) {
        int lane_o = F.lane; asm volatile("" : "+v"(lane_o));
        for (int idx = (F.gw - 1408) * 64 + lane_o; idx < MROWS * 2; idx += 640 * 64) {
            const int row = idx >> 1, hs = idx & 1; const int b_ = row / TOK, t_ = row - b_ * TOK; const bool lat = t_ >= CTXL; const int tl = t_ - CTXL, prow = tl >> 6, pcol = tl & 63;
            bf16* p = PA + (size_t)row * 768 + 512 + hs * 64;
            float f[64]; float ss = 0.f;
#pragma unroll
            for (int q = 0; q < 8; ++q) { const v4u raw = *(const v4u*)(p + 8 * q);
                f[8 * q] = bflo(raw.x); f[8 * q + 1] = bfhi(raw.x); f[8 * q + 2] = bflo(raw.y); f[8 * q + 3] = bfhi(raw.y); f[8 * q + 4] = bflo(raw.z); f[8 * q + 5] = bfhi(raw.z); f[8 * q + 6] = bflo(raw.w); f[8 * q + 7] = bfhi(raw.w); }
#pragma unroll
            for (int d = 0; d < 64; ++d) ss += f[d] * f[d];
            const float rstd = __builtin_amdgcn_rsqf(ss * (1.0f / 64.0f) + 1e-6f);
#pragma unroll
            for (int q = 0; q < 16; ++q) { const f32x4 w4 = *(const f32x4*)(k_norm_w_ + 4 * q); f[4 * q] *= rstd * w4.x; f[4 * q + 1] *= rstd * w4.y; f[4 * q + 2] *= rstd * w4.z; f[4 * q + 3] *= rstd * w4.w; }
            if (lat) {
#pragma unroll
                for (int a = 0; a < 2; ++a) { const int pos = a ? pcol : prow;
#pragma unroll
                    for (int fi = 0; fi < 16; ++fi) { const f32x2_t cs = *(const f32x2_t*)(RT + 2 * (pos * 16 + fi)); const float x1 = f[32 * a + fi], x2 = f[32 * a + 16 + fi];
                        f[32 * a + fi] = x1 * cs.x - x2 * cs.y; f[32 * a + 16 + fi] = x2 * cs.x + x1 * cs.y; } }
            }
#pragma unroll
            for (int q = 0; q < 8; ++q) { v4u o; o.x = cvtpk(f[8 * q], f[8 * q + 1]); o.y = cvtpk(f[8 * q + 2], f[8 * q + 3]); o.z = cvtpk(f[8 * q + 4], f[8 * q + 5]); o.w = cvtpk(f[8 * q + 6], f[8 * q + 7]);
                *(v4u*)(p + 8 * q) = o; }
        }
    }
    (void)q_norm_w_;
}

__device__ __forceinline__ f32x4 bmm16(const LAS float* A, const LAS float* B, f32x4 acc, int fr, int fq) {
#pragma unroll
    for (int s = 0; s < 4; ++s) acc = __builtin_amdgcn_mfma_f32_16x16x4f32(A[fr * 68 + 4 * s + fq], B[(4 * s + fq) * 68 + fr], acc, 0, 0, 0);
    return acc;
}
__device__ __forceinline__ void p4_phase(Frame& F, const int tb, const int te) {
    const bf16* DQ = WSP(bf16, WS_DQ); const bf16* DK = WSP(bf16, WS_DK); const bf16* DKT = WSP(bf16, WS_DKT); const bf16* DVT = WSP(bf16, WS_DVT);
    const float* Gg = WSP(float, WS_G); const float* Bt = WSP(float, WS_BETA);
    bf16* QKD = WSP(bf16, WS_QKD);
    float* EG = WSP(float, WS_EG); float* EK = WSP(float, WS_EK); float* GL = WSP(float, WS_GLAST);
    LAS float* M = (LAS float*)(F.lds + F.wave * 17920);
    LAS float* gcv = M + 64 * 68;
    LAS float* btv = gcv + 64;
    const int lane = F.lane, fr = lane & 15, fq = lane >> 4;
    for (int task = tb + F.gw; task < te; task += F.NGW) {
        int dir, n, bh, j;
        if (task < 2048) { dir = task & 1; j = (task >> 1) & 31; bh = task >> 6; }
        else { const int t2 = task - 2048; dir = t2 & 1; j = 32 + ((t2 >> 1) & 3); bh = t2 >> 3; }
        n = j < 4 ? (dir ? 3 - j : j) : (dir ? 39 - j : j);
        const int b = bh >> 2, hh = bh & 3;
        const size_t tokbase = (size_t)bh * TOK + 64 * n;
        const bf16* Kc = DK + tokbase * 128; const bf16* Qc = DQ + tokbase * 128;
        const size_t gbase = (size_t)(dir * 32 + bh) * TOK + 64 * n;
        const int rl = dir ? 63 - lane : lane;
        const float gl = Gg[gbase + rl], bl = Bt[gbase + rl];
        bf16x8 kf[4][4], qfn[4];
#pragma unroll
        for (int rt = 0; rt < 4; ++rt) { const int i = 16 * rt + fr, ro = dir ? 63 - i : i;
#pragma unroll
            for (int ks = 0; ks < 4; ++ks) kf[rt][ks] = *(const bf16x8*)(Kc + ro * 128 + 32 * ks + 8 * fq); }
        { const int ro = dir ? 63 - fr : fr;
#pragma unroll
          for (int ks = 0; ks < 4; ++ks) qfn[ks] = *(const bf16x8*)(Qc + ro * 128 + 32 * ks + 8 * fq); }
        float gc = gl;
#pragma unroll
        for (int o = 1; o < 64; o <<= 1) { const float u = __shfl_up(gc, o); if (lane >= o) gc += u; }
        gcv[lane] = gc; btv[lane] = bl;
        const bool outc = n >= 4;
        LDS_WAIT(); asm volatile("" ::: "memory");
        bf16* qkd = QKD + ((size_t)(dir * 32 + bh) * 32 + (n - 4)) * 4096;
#pragma unroll
        for (int rt = 0; rt < 4; ++rt) {
            bf16x8 qfr[4];
#pragma unroll
            for (int ks = 0; ks < 4; ++ks) qfr[ks] = qfn[ks];
            if (rt < 3) { const int i = 16 * (rt + 1) + fr, ro = dir ? 63 - i : i;
#pragma unroll
                for (int ks = 0; ks < 4; ++ks) qfn[ks] = *(const bf16x8*)(Qc + ro * 128 + 32 * ks + 8 * fq); }
#pragma unroll
            for (int ct = 0; ct < 4; ++ct) {
                const int iq = 16 * rt + fr, ioq = dir ? 63 - iq : iq;
                const int j0 = 16 * ct + 4 * fq, jo0 = dir ? 60 - j0 : j0;
                bf16* qdst = qkd + ioq * 64 + (jo0 & ~15) + perm16(jo0 & 15);
                if (ct > rt) { if (outc) *(u32x2*)qdst = (u32x2){0u, 0u}; continue; }
                f32x4 a = {0.f, 0.f, 0.f, 0.f}, q = {0.f, 0.f, 0.f, 0.f};
#pragma unroll
                for (int ks = 0; ks < 4; ++ks) { a = __builtin_amdgcn_mfma_f32_16x16x32_bf16(kf[rt][ks], kf[ct][ks], a, 0, 0, 0); if (outc) q = __builtin_amdgcn_mfma_f32_16x16x32_bf16(kf[ct][ks], qfr[ks], q, 0, 0, 0); }
                const int j = 16 * ct + fr; const float gj = gcv[j];
#pragma unroll
                for (int r = 0; r < 4; ++r) { const int i = 16 * rt + 4 * fq + r; const float dec = __expf(fminf(gcv[i] - gj, 0.f));
                    M[i * 68 + j] = (i > j) ? btv[i] * a[r] * dec : 0.f; }
                if (outc) { const float gi = gcv[iq]; float qv[4];
#pragma unroll
                    for (int r = 0; r < 4; ++r) { const int jj = j0 + r; qv[r] = (iq >= jj) ? q[r] * __expf(fminf(gi - gcv[jj], 0.f)) : 0.f; }
                    u32x2 w; if (dir) { w.x = cvtpk(qv[3], qv[2]); w.y = cvtpk(qv[1], qv[0]); } else { w.x = cvtpk(qv[0], qv[1]); w.y = cvtpk(qv[2], qv[3]); }
                    *(u32x2*)qdst = w; }
            }
        }
        LDS_WAIT(); asm volatile("" ::: "memory");
        {
            const int blk = fq, c = fr;
            float t[16];
            t[0] = (c == 0) ? 1.f : 0.f;
#pragma unroll
            for (int i = 1; i < 16; ++i) {
                const LAS float* rowp = M + (16 * blk + i) * 68 + 16 * blk;
                float acc = 0.f;
#pragma unroll
                for (int j4 = 0; j4 < (i + 3) / 4; ++j4) { const f32x4 av = *(const LAS f32x4*)(rowp + 4 * j4);
#pragma unroll
                    for (int jj = 0; jj < 4; ++jj) if (4 * j4 + jj < i) acc = fmaf(av[jj], t[4 * j4 + jj], acc); }
                t[i] = (c < i) ? -acc : ((c == i) ? 1.f : 0.f);
            }
            LDS_WAIT(); asm volatile("" ::: "memory");
#pragma unroll
            for (int i = 0; i < 16; ++i) M[(16 * blk + i) * 68 + 16 * blk + c] = t[i];
            LDS_WAIT(); asm volatile("" ::: "memory");
        }
#pragma unroll
        for (int k = 0; k < 3; ++k)
#pragma unroll
            for (int i = k + 1; i < 4; ++i) {
                f32x4 x = {0.f, 0.f, 0.f, 0.f};
#pragma unroll
                for (int j = k; j < i; ++j) x = bmm16(M + (16 * i) * 68 + 16 * j, M + (16 * j) * 68 + 16 * k, x, fr, fq);
                LAS float* scr = M + (16 * k) * 68 + 16 * i;
#pragma unroll
                for (int r = 0; r < 4; ++r) scr[(4 * fq + r) * 68 + fr] = x[r];
                LDS_WAIT(); asm volatile("" ::: "memory");
                f32x4 y = bmm16(M + (16 * i) * 68 + 16 * i, scr, (f32x4){0.f, 0.f, 0.f, 0.f}, fr, fq);
                LDS_WAIT(); asm volatile("" ::: "memory");
#pragma unroll
                for (int r = 0; r < 4; ++r) M[(16 * i + 4 * fq + r) * 68 + 16 * k + fr] = -y[r];
                LDS_WAIT(); asm volatile("" ::: "memory");
            }
        const float ej = __expf(gc);
        gcv[lane] = bl * ej;
        LDS_WAIT(); asm volatile("" ::: "memory");
        bf16x8 tuf[4][2], twf[4][2];
#pragma unroll
        for (int it = 0; it < 4; ++it) { const int io = 16 * it + fr, si = dir ? 63 - io : io;
#pragma unroll
            for (int ks = 0; ks < 2; ++ks) { unsigned pu[4], pw[4];
#pragma unroll
                for (int hf = 0; hf < 2; ++hf) { const int t0 = 32 * ks + 16 * (fq >> 1) + 4 * (fq & 1) + 8 * hf;
                    const int cb = dir ? 60 - t0 : t0;
                    const f32x4 tv = *(const LAS f32x4*)(M + si * 68 + cb), cu = *(const LAS f32x4*)(btv + cb), cw = *(const LAS f32x4*)(gcv + cb);
                    float u[4], w[4];
#pragma unroll
                    for (int e = 0; e < 4; ++e) { const int sc = cb + e; const float tt = (sc <= si) ? tv[e] : 0.f; u[e] = tt * cu[e]; w[e] = tt * cw[e]; }
                    if (dir) { pu[2 * hf] = cvtpk(u[3], u[2]); pu[2 * hf + 1] = cvtpk(u[1], u[0]); pw[2 * hf] = cvtpk(w[3], w[2]); pw[2 * hf + 1] = cvtpk(w[1], w[0]); }
                    else { pu[2 * hf] = cvtpk(u[0], u[1]); pu[2 * hf + 1] = cvtpk(u[2], u[3]); pw[2 * hf] = cvtpk(w[0], w[1]); pw[2 * hf + 1] = cvtpk(w[2], w[3]); } }
                tuf[it][ks] = __builtin_bit_cast(bf16x8, (v4u){pu[0], pu[1], pu[2], pu[3]}); twf[it][ks] = __builtin_bit_cast(bf16x8, (v4u){pw[0], pw[1], pw[2], pw[3]}); } }
        unsigned char* grp = wu_group(F, dir * 8 + b);
        bf16* WMg = (bf16*)(grp + (size_t)(hh * 36 + n) * 16384); bf16* UMg = (bf16*)(grp + 4608 * 1024 + (size_t)(hh * 36 + n) * 16384);
        const bf16* KTg = DKT + ((size_t)bh * 36 + n) * 8192; const bf16* VTg = DVT + ((size_t)bh * 36 + n) * 8192;
        {
#pragma unroll
          for (int d4 = 0; d4 < 8; d4 += 4) {
            bf16x8 ktf[4][2];
#pragma unroll
            for (int dt = 0; dt < 4; ++dt) { ktf[dt][0] = *(const bf16x8*)(KTg + (16 * (d4 + dt) + fr) * 64 + 8 * fq); ktf[dt][1] = *(const bf16x8*)(KTg + (16 * (d4 + dt) + fr) * 64 + 32 + 8 * fq); }
#pragma unroll
            for (int dq = 0; dq < 4; ++dq)
#pragma unroll
                for (int it = 0; it < 4; ++it) { const int dt = d4 + dq; f32x4 c = __builtin_amdgcn_mfma_f32_16x16x32_bf16(ktf[dq][0], twf[it][0], (f32x4){0.f, 0.f, 0.f, 0.f}, 0, 0, 0);
                    c = __builtin_amdgcn_mfma_f32_16x16x32_bf16(ktf[dq][1], twf[it][1], c, 0, 0, 0);
                    u32x2 w; w.x = cvtpk(c[0], c[1]); w.y = cvtpk(c[2], c[3]);
                    *(u32x2*)(WMg + (16 * it + fr) * 128 + 16 * dt + perm16(4 * fq)) = w; }
            asm volatile("" ::: "memory");
          }
        }
        {
#pragma unroll
          for (int v4 = 0; v4 < 8; v4 += 4) {
            bf16x8 vtf[4][2];
#pragma unroll
            for (int vt = 0; vt < 4; ++vt) { vtf[vt][0] = *(const bf16x8*)(VTg + (16 * (v4 + vt) + fr) * 64 + 8 * fq); vtf[vt][1] = *(const bf16x8*)(VTg + (16 * (v4 + vt) + fr) * 64 + 32 + 8 * fq); }
#pragma unroll
            for (int vq = 0; vq < 4; ++vq)
#pragma unroll
                for (int it = 0; it < 4; ++it) { const int vt = v4 + vq; f32x4 c = __builtin_amdgcn_mfma_f32_16x16x32_bf16(tuf[it][0], vtf[vq][0], (f32x4){0.f, 0.f, 0.f, 0.f}, 0, 0, 0);
                    c = __builtin_amdgcn_mfma_f32_16x16x32_bf16(tuf[it][1], vtf[vq][1], c, 0, 0, 0);
                    u32x2 w; w.x = cvtpk(c[0], c[1]); w.y = cvtpk(c[2], c[3]);
                    const int q = 2 * (it & 1) + (fq >> 1), h = fq & 1;
                    *(u32x2*)(UMg + (size_t)(((it >> 1) * 4 + (vt >> 1)) * 64 + 32 * h + 16 * (vt & 1) + fr) * 16 + 4 * q) = w; }
            asm volatile("" ::: "memory");
          }
        }
        const float glast = __shfl(gc, 63);
        EG[gbase + rl] = ej; EK[gbase + rl] = __expf(glast - gc);
        if (lane == 0) GL[(size_t)(dir * 32 + bh) * 36 + n] = __expf(glast);
        LDS_WAIT(); asm volatile("" ::: "memory");
    }
}

#define MFMA32(a, b, c) __builtin_amdgcn_mfma_f32_32x32x16_bf16((a), (b), (c), 0, 0, 0)
constexpr int SB_WQ = 0, SB_KT = 34816, SB_QK = 53248, SB_EG = 62464, SB_EK = 62720, SB_BYTES = 62976;
__device__ __forceinline__ bf16x8 pack8(const f32x16& x, int s) {
    v4u p; p.x = cvtpk(x[8 * s], x[8 * s + 1]); p.y = cvtpk(x[8 * s + 2], x[8 * s + 3]); p.z = cvtpk(x[8 * s + 4], x[8 * s + 5]); p.w = cvtpk(x[8 * s + 6], x[8 * s + 7]);
    return __builtin_bit_cast(bf16x8, p);
}
__device__ __forceinline__ void dn_scan(Frame& F, int chain) {
    const int dir = chain & 1, bh = chain >> 1, b = bh >> 2, hh = bh & 3;
    const bf16* DQ = WSP(bf16, WS_DQ); const bf16* DKT = WSP(bf16, WS_DKT); const bf16* QKg = WSP(bf16, WS_QKD);
    const float* EG = WSP(float, WS_EG); const float* EK = WSP(float, WS_EK); const float* GL = WSP(float, WS_GLAST);
    unsigned char* grp = wu_group(F, dir * 8 + b);
    const int tid = F.tid, lane = F.lane, w = F.wave;
#define SCAN_N(step) (((step) < 4) ? (dir ? 3 - (step) : (step)) : (dir ? 39 - (step) : (step)))
    if (w >= 4) {
        const int lt = tid - 256;
        for (int step = -1; step < 35; ++step) {
            const int n = SCAN_N(step + 1); const bool outc = n >= 4;
            LAS unsigned char* B = F.lds + ((step + 1) & 1) * SB_BYTES;
            const bf16* wm = (const bf16*)(grp + (size_t)(hh * 36 + n) * 16384);
            const bf16* qg = DQ + ((size_t)bh * TOK + 64 * n) * 128;
            const bf16* kt = DKT + ((size_t)bh * 36 + n) * 8192;
            const bf16* qk = QKg + ((size_t)(dir * 32 + bh) * 32 + (n - 4)) * 4096;
            v4u rw[4], rq[4], rk[4], rx[2]; float ev = 0.f;
#pragma unroll
            for (int q = 0; q < 4; ++q) { const int p = lt + 256 * q; rw[q] = *(const v4u*)(wm + p * 8); rk[q] = *(const v4u*)(kt + p * 8); if (outc) rq[q] = *(const v4u*)(qg + p * 8); }
            if (outc) {
#pragma unroll
                for (int q = 0; q < 2; ++q) rx[q] = *(const v4u*)(qk + (lt + 256 * q) * 8); }
            if (lt < 64) ev = EG[(size_t)(dir * 32 + bh) * TOK + 64 * n + lt]; else if (lt < 128) ev = EK[(size_t)(dir * 32 + bh) * TOK + 64 * n + lt - 64];
#pragma unroll
            for (int q = 0; q < 4; ++q) { const int p = lt + 256 * q;
                *(LAS v4u*)(B + SB_WQ + (p >> 4) * 272 + (p & 15) * 16) = rw[q];
                *(LAS v4u*)(B + SB_KT + (p >> 3) * 144 + (p & 7) * 16) = rk[q];
                if (outc) *(LAS v4u*)(B + SB_WQ + (64 + (p >> 4)) * 272 + (p & 15) * 16) = rq[q]; }
            if (outc) {
#pragma unroll
                for (int q = 0; q < 2; ++q) { const int p = lt + 256 * q; *(LAS v4u*)(B + SB_QK + (p >> 3) * 144 + (p & 7) * 16) = rx[q]; } }
            if (lt < 128) *(LAS float*)(B + SB_EG + lt * 4) = ev;
            if (step == 30 && lt == 0) {
                unsigned sp = 0u;
                while (__hip_atomic_load(F.ctl + CW_CHAIN2 + chain, RLX_AGENT) < 4u && ++sp < (1u << 22)) __builtin_amdgcn_s_sleep(4);
                __builtin_amdgcn_fence(__ATOMIC_ACQUIRE, "agent"); }
            asm volatile("s_waitcnt vmcnt(0) lgkmcnt(0)" ::: "memory");
            __builtin_amdgcn_s_barrier();
            asm volatile("" ::: "memory");
        }
    } else {
        const int r = lane & 31, h = lane >> 5, vs = w;
        bf16* DOb = WSP(bf16, WS_DO) + (size_t)dir * NLAT * 512;
        f32x16 sacc[4]; bf16x8 Sb[8];
#pragma unroll
        for (int q = 0; q < 4; ++q)
#pragma unroll
            for (int e = 0; e < 16; ++e) sacc[q][e] = 0.f;
#pragma unroll
        for (int q = 0; q < 8; ++q) Sb[q] = (bf16x8){0, 0, 0, 0, 0, 0, 0, 0};
        v4u umn[2][2]; float glast_n;
        { const int n0 = SCAN_N(0); const bf16* um = (const bf16*)(grp + 4608 * 1024 + (size_t)(hh * 36 + n0) * 16384);
#pragma unroll
          for (int it = 0; it < 2; ++it) { const v4u* up = (const v4u*)(um + (size_t)((it * 4 + vs) * 64 + lane) * 16); umn[it][0] = up[0]; umn[it][1] = up[1]; }
          glast_n = GL[(size_t)(dir * 32 + bh) * 36 + n0]; }
        for (int step = 0; step < 36; ++step) {
            const int n = SCAN_N(step); const bool outc = n >= 4;
            asm volatile("s_waitcnt lgkmcnt(0)" ::: "memory");
            __builtin_amdgcn_s_barrier();
            asm volatile("" ::: "memory");
            const LAS unsigned char* B = F.lds + (step & 1) * SB_BYTES;
            v4u um[2][2]; um[0][0] = umn[0][0]; um[0][1] = umn[0][1]; um[1][0] = umn[1][0]; um[1][1] = umn[1][1];
            const float glast = glast_n;
            if (step + 1 < 36) { const int n1 = SCAN_N(step + 1); const bf16* umg = (const bf16*)(grp + 4608 * 1024 + (size_t)(hh * 36 + n1) * 16384);
#pragma unroll
                for (int it = 0; it < 2; ++it) { const v4u* up = (const v4u*)(umg + (size_t)((it * 4 + vs) * 64 + lane) * 16); umn[it][0] = up[0]; umn[it][1] = up[1]; }
                glast_n = GL[(size_t)(dir * 32 + bh) * 36 + n1]; }
            bf16x8 Vnb[4], Vsb[4]; f32x16 oacc[2];
#pragma unroll
            for (int it = 0; it < 2; ++it) {
                f32x16 ws;
#pragma unroll
                for (int e = 0; e < 16; ++e) ws[e] = 0.f;
                const LAS unsigned char* ap = B + SB_WQ + (32 * it + r) * 272 + h * 16;
#pragma unroll
                for (int s = 0; s < 8; ++s) ws = MFMA32(*(const LAS bf16x8*)(ap + s * 32), Sb[s], ws);
                f32x16 vn, vsc;
#pragma unroll
                for (int q = 0; q < 2; ++q) { const v4u uu = um[it][q];
                    vn[8 * q + 0] = bflo(uu.x) - ws[8 * q + 0]; vn[8 * q + 1] = bfhi(uu.x) - ws[8 * q + 1]; vn[8 * q + 2] = bflo(uu.y) - ws[8 * q + 2]; vn[8 * q + 3] = bfhi(uu.y) - ws[8 * q + 3];
                    vn[8 * q + 4] = bflo(uu.z) - ws[8 * q + 4]; vn[8 * q + 5] = bfhi(uu.z) - ws[8 * q + 5]; vn[8 * q + 6] = bflo(uu.w) - ws[8 * q + 6]; vn[8 * q + 7] = bfhi(uu.w) - ws[8 * q + 7]; }
#pragma unroll
                for (int q = 0; q < 4; ++q) { const f32x4 ek = *(const LAS f32x4*)(B + SB_EK + (32 * it + 8 * q + 4 * h) * 4);
#pragma unroll
                    for (int e = 0; e < 4; ++e) vsc[4 * q + e] = vn[4 * q + e] * ek[e]; }
                Vnb[2 * it] = pack8(vn, 0); Vnb[2 * it + 1] = pack8(vn, 1); Vsb[2 * it] = pack8(vsc, 0); Vsb[2 * it + 1] = pack8(vsc, 1);
                if (outc) {
                    f32x16 qs;
#pragma unroll
                    for (int e = 0; e < 16; ++e) qs[e] = 0.f;
                    const LAS unsigned char* qp = B + SB_WQ + (64 + 32 * it + r) * 272 + h * 16;
#pragma unroll
                    for (int s = 0; s < 8; ++s) qs = MFMA32(*(const LAS bf16x8*)(qp + s * 32), Sb[s], qs);
#pragma unroll
                    for (int q = 0; q < 4; ++q) { const f32x4 eg = *(const LAS f32x4*)(B + SB_EG + (32 * it + 8 * q + 4 * h) * 4);
#pragma unroll
                        for (int e = 0; e < 4; ++e) oacc[it][4 * q + e] = qs[4 * q + e] * eg[e]; }
                }
            }
            if (outc) {
#pragma unroll
                for (int it = 0; it < 2; ++it) {
                    const LAS unsigned char* ap = B + SB_QK + (32 * it + r) * 144 + h * 16;
#pragma unroll
                    for (int s = 0; s < 4; ++s) oacc[it] = MFMA32(*(const LAS bf16x8*)(ap + s * 32), Vnb[s], oacc[it]);
                    bf16* op = DOb + ((size_t)b * SEQL + 64 * (n - 4) + 32 * it + 4 * h) * 512 + hh * 128 + 32 * vs + r;
#pragma unroll
                    for (int e = 0; e < 16; ++e) op[(size_t)((e & 3) + 8 * (e >> 2)) * 512] = (bf16)(cvtpk(oacc[it][e], 0.f) & 0xffffu);
                }
            }
#pragma unroll
            for (int dt = 0; dt < 4; ++dt) {
#pragma unroll
                for (int e = 0; e < 16; ++e) sacc[dt][e] *= glast;
                const LAS unsigned char* ap = B + SB_KT + (32 * dt + r) * 144 + h * 16;
#pragma unroll
                for (int s = 0; s < 4; ++s) sacc[dt] = MFMA32(*(const LAS bf16x8*)(ap + s * 32), Vsb[s], sacc[dt]);
                Sb[2 * dt] = pack8(sacc[dt], 0); Sb[2 * dt + 1] = pack8(sacc[dt], 1);
            }
        }
    }
#undef SCAN_N
    asm volatile("s_waitcnt vmcnt(0)" ::: "memory");
    __syncthreads();
    if (F.tid == 0) {
        bool flush = true;
        if (F.MISC[8] != 0u) { const unsigned x = xb_xcc_id(); const unsigned old = __hip_atomic_fetch_add(F.ctl + CW_XSUBS + 16 * x, 1u, RLX_AGENT);
            flush = (old + 1u == __hip_atomic_load(F.ctl + CW_XCNTS + 16 * x, RLX_AGENT)); }
        if (flush) { __builtin_amdgcn_fence(__ATOMIC_RELEASE, "agent"); asm volatile("s_waitcnt vmcnt(0)" ::: "memory"); (void)__hip_atomic_fetch_add(F.ctl + CW_SCAN, 1u, RLX_AGENT); }
    }
}
constexpr int CV_NIT = 3 * 16 * 512;
#ifndef CV_S
#define CV_S 10
#endif
constexpr int CV_O = 24 - CV_S;
#ifndef ATT_NFULL
#define ATT_NFULL 512
#endif
__device__ __forceinline__ void cv_run(Frame& F, const float* w_gate_, const float* w_up_, const float* w_down_, const int it0, const int cnt) {
    LAS float* scr = (LAS float*)(F.lds + 65536 + F.wave * 8448);
    unsigned char* WGU = WSP(unsigned char, WS_WGU); unsigned char* WD = WSP(unsigned char, WS_WD);
    auto item_src = [&](int it, int& k0, int& n0, unsigned char*& dst) -> const float* {
        const int ty = it / 8192, r = it % 8192, e = r >> 9, kb = (r & 511) >> 5, nb = r & 31; n0 = 32 * nb; k0 = 64 * kb;
        if (ty == 0) { dst = WGU + ((size_t)e * 2048 + 256 * (n0 >> 7) + (n0 & 127)) * 1024 + k0; return w_gate_ + (size_t)e * 1048576; }
        if (ty == 1) { dst = WGU + ((size_t)e * 2048 + 256 * (n0 >> 7) + 128 + (n0 & 127)) * 1024 + k0; return w_up_ + (size_t)e * 1048576; }
        dst = WD + ((size_t)e * 1024 + n0) * 1024 + k0; return w_down_ + (size_t)e * 1048576; };
    f32x4 lA[8], lB[8];
#define CV_LOAD(L, it_) do { int k_, n_; unsigned char* d_; const float* W_ = item_src((it_), k_, n_, d_); _Pragma("unroll") for (int i_ = 0; i_ < 8; ++i_) L[i_] = __builtin_nontemporal_load((const f32x4*)(W_ + (size_t)(k_ + 8 * i_ + (F.lane >> 3)) * 1024 + n_ + 4 * (F.lane & 7))); } while (0)
#define CV_ITEM(L, it_, more_) do { int k0, n0; unsigned char* dst; (void)item_src((it_), k0, n0, dst); \
        _Pragma("unroll") for (int i_ = 0; i_ < 8; ++i_) { LAS float* d = scr + (8 * i_ + (F.lane >> 3)) * 33 + 4 * (F.lane & 7); d[0] = L[i_].x; d[1] = L[i_].y; d[2] = L[i_].z; d[3] = L[i_].w; } \
        if (more_) CV_LOAD(L, (it_) + 2); \
        LDS_WAIT(); asm volatile("" ::: "memory"); \
        const int c = F.lane & 7; \
        _Pragma("unroll") for (int j = 0; j < 4; ++j) { const int n = (F.lane >> 3) + 8 * j; const LAS float* sp = scr + (8 * c) * 33 + n; \
            u32x2 o; o.x = pg8::pk4_fp8(sp[0 * 33] * pg8::FP8_SW, sp[1 * 33] * pg8::FP8_SW, sp[2 * 33] * pg8::FP8_SW, sp[3 * 33] * pg8::FP8_SW); \
            o.y = pg8::pk4_fp8(sp[4 * 33] * pg8::FP8_SW, sp[5 * 33] * pg8::FP8_SW, sp[6 * 33] * pg8::FP8_SW, sp[7 * 33] * pg8::FP8_SW); \
            *(GAS u32x2*)(dst + (size_t)n * 1024 + 8 * c) = o; } \
        LDS_WAIT(); asm volatile("" ::: "memory"); } while (0)
    if (cnt > 0) CV_LOAD(lA, it0);
    if (cnt > 1) CV_LOAD(lB, it0 + 1);
    for (int q = 0; q < cnt; q += 2) {
        CV_ITEM(lA, it0 + q, q + 2 < cnt);
        if (q + 1 < cnt) CV_ITEM(lB, it0 + q + 1, q + 3 < cnt);
    }
#undef CV_LOAD
#undef CV_ITEM
}
__device__ __forceinline__ void p6_phase(Frame& F, const float* o_norm_w_, const int rbeg, const int rend, const int rstep);
__device__ __forceinline__ void p5_phase(Frame& F, int rep, const float* qnw_, const float* o_norm_w_, const float* w_gate_, const float* w_up_, const float* w_down_) {
    if (blockIdx.x >= 192 && rep != 2) {
        const int chain = (int)blockIdx.x - 192;
        if (F.tid == 0) { unsigned sp = 0u;
            const unsigned need = F.MISC[9] != 0u ? F.MISC[9] : (unsigned)F.G;
            while (__hip_atomic_load(F.ctl + CW_TOP2, RLX_AGENT) < need && ++sp < (1u << 22)) __builtin_amdgcn_s_sleep(2);
            __builtin_amdgcn_fence(__ATOMIC_ACQUIRE, "agent");
            asm volatile("s_waitcnt vmcnt(0)" ::: "memory"); }
        __syncthreads();
        PROF_EV(21);
        dn_scan(F, chain);
        PROF_EV(22);
    }
    if (rep == 1) return;
    const attn_body::bf16* PA = (const attn_body::bf16*)WSP(bf16, WS_PA); attn_body::bf16* Y = (attn_body::bf16*)WSP(bf16, WS_Y);
    for (;;) {
        __syncthreads();
        if (F.tid == 0) F.MISC[0] = __hip_atomic_fetch_add(F.ctl + CW_ATTNQ + 64 * rep, 1u, RLX_AGENT);
        __syncthreads();
        const int u = (int)F.MISC[0];
        if (u >= ATT_NFULL + 2 * (512 - ATT_NFULL)) break;
        if (u < ATT_NFULL) {
            const int b = u >> 6, hq = (u >> 3) & 7, qb = u & 7;
            attn_body::attn_unit<8>(PA + ((size_t)b * TOK + CTXL + qb * 256) * 768 + hq * 64, PA + (size_t)b * TOK * 768 + 512 + (hq >> 2) * 64, PA + (size_t)b * TOK * 768 + 640 + (hq >> 2) * 64,
                                    Y + ((size_t)b * SEQL + qb * 256) * 1024 + hq * 64, (char*)F.ldsg, qnw_, WSP(float, WS_ROPE), qb * 256);
        } else {
            const int hu = u - ATT_NFULL, fu = ATT_NFULL + (hu >> 1), r0 = (fu & 7) * 256 + (hu & 1) * 128;
            const int b = fu >> 6, hq = (fu >> 3) & 7;
            if (F.wave < 4) attn_body::attn_unit<8>(PA + ((size_t)b * TOK + CTXL + r0) * 768 + hq * 64, PA + (size_t)b * TOK * 768 + 512 + (hq >> 2) * 64, PA + (size_t)b * TOK * 768 + 640 + (hq >> 2) * 64,
                                    Y + ((size_t)b * SEQL + r0) * 1024 + hq * 64, (char*)F.ldsg, qnw_, WSP(float, WS_ROPE), r0);
            else attn_body::attn_helper(PA + (size_t)b * TOK * 768 + 512 + (hq >> 2) * 64, PA + (size_t)b * TOK * 768 + 640 + (hq >> 2) * 64, (char*)F.ldsg);
        }
    }
    __syncthreads();
    PROF_EV(23);
    if (rep != 0) return;
    if (F.tid == 0) { unsigned sp = 0u;
        unsigned need = 64u;
        if (F.MISC[8] != 0u) { need = 0u;
#pragma unroll
            for (int j = 0; j < 16; ++j) need += __hip_atomic_load(F.ctl + CW_XCNTS + 16 * j, RLX_AGENT) != 0u ? 1u : 0u; }
        while (__hip_atomic_load(F.ctl + CW_SCAN, RLX_AGENT) < need && ++sp < (1u << 22)) __builtin_amdgcn_s_sleep(2);
        __builtin_amdgcn_fence(__ATOMIC_ACQUIRE, "agent");
        asm volatile("s_waitcnt vmcnt(0)" ::: "memory"); }
    __syncthreads();
    PROF_EV(24);
    for (;;) {
        __syncthreads();
        if (F.tid == 0) F.MISC[0] = __hip_atomic_fetch_add(F.ctl + CW_P6Q, 1u, RLX_AGENT);
        __syncthreads();
        const int c = (int)F.MISC[0];
        if (c >= NLAT / 64) break;
        p6_phase(F, o_norm_w_, c * 64 + F.wave, c * 64 + 64, 8);
    }
}


__device__ __forceinline__ void p6_phase(Frame& F, const float* o_norm_w_, const int rbeg, const int rend, const int rstep) {
    const bf16* DO = WSP(bf16, WS_DO); const bf16* PZ = WSP(bf16, WS_PZ); bf16* Y = WSP(bf16, WS_Y);
    const int lane = F.lane;
    const int ch = (8 * lane) & 127;
    v4u r0[8], r1[8], zr[8];
#pragma unroll
    for (int i = 0; i < 8; ++i) { const int row = rbeg + i * rstep, b = row >> 11, t = row & 2047;
        r0[i] = *(const v4u*)(DO + (size_t)row * 512 + 8 * lane); r1[i] = *(const v4u*)(DO + (size_t)(NLAT + row) * 512 + 8 * lane);
        zr[i] = *(const v4u*)(PZ + ((size_t)b * TOK + CTXL + t) * 512 + 8 * lane); }
    const f32x4 w0 = *(const f32x4*)(o_norm_w_ + ch), w1 = *(const f32x4*)(o_norm_w_ + ch + 4);
#pragma unroll
    for (int i = 0; i < 8; ++i) {
        const int row = rbeg + i * rstep;
        const f32x4 a0 = {bflo(r0[i].x) + bflo(r1[i].x), bfhi(r0[i].x) + bfhi(r1[i].x), bflo(r0[i].y) + bflo(r1[i].y), bfhi(r0[i].y) + bfhi(r1[i].y)}, a1 = {bflo(r0[i].z) + bflo(r1[i].z), bfhi(r0[i].z) + bfhi(r1[i].z), bflo(r0[i].w) + bflo(r1[i].w), bfhi(r0[i].w) + bfhi(r1[i].w)};
        float ss = (a0.x * a0.x + a0.y * a0.y) + (a0.z * a0.z + a0.w * a0.w) + (a1.x * a1.x + a1.y * a1.y) + (a1.z * a1.z + a1.w * a1.w);
        ss = row16_sum(ss);
        const float rstd = __builtin_amdgcn_rsqf(ss * (1.0f / 128.0f) + 1e-6f);
        const float z[8] = {bflo(zr[i].x), bfhi(zr[i].x), bflo(zr[i].y), bfhi(zr[i].y), bflo(zr[i].z), bfhi(zr[i].z), bflo(zr[i].w), bfhi(zr[i].w)};
        float y[8] = {a0.x * rstd * w0.x, a0.y * rstd * w0.y, a0.z * rstd * w0.z, a0.w * rstd * w0.w, a1.x * rstd * w1.x, a1.y * rstd * w1.y, a1.z * rstd * w1.z, a1.w * rstd * w1.w};
#pragma unroll
        for (int j = 0; j < 8; ++j) y[j] *= z[j] * __builtin_amdgcn_rcpf(1.0f + __expf(-z[j]));
        v4u o; o.x = pk2(y[0], y[1]); o.y = pk2(y[2], y[3]); o.z = pk2(y[4], y[5]); o.w = pk2(y[6], y[7]);
        *(v4u*)(Y + (size_t)row * 1024 + 512 + 8 * lane) = o;
    }
    (void)rend;
}

__device__ __forceinline__ void p9_phase(Frame& F);
__device__ __forceinline__ void p8_row(const f32x4 (&wr0)[16], const f32x4 (&v)[4], int row, int lane, const LAS float* wt, const LAS float* nwl, const LAS float* mdl, unsigned char* H2, float* AFF, bf16* X1) {
    const int b = row >> 11, t = row & 2047;
    const LAS float* mod = mdl + b * 2048;
#pragma unroll
    for (int j = 0; j < 4; ++j) { u32x2 w; w.x = cvtpk(v[j].x, v[j].y); w.y = cvtpk(v[j].z, v[j].w); *(u32x2*)(X1 + (size_t)row * 1024 + 4 * lane + 256 * j) = w; }
    float ss = 0.f;
#pragma unroll
    for (int j = 0; j < 4; ++j) ss += (v[j].x * v[j].x + v[j].y * v[j].y) + (v[j].z * v[j].z + v[j].w * v[j].w);
    const float rstd = __builtin_amdgcn_rsqf(wave_sum(ss) * (1.0f / 1024.0f) + 1e-6f);
    f32x4 acc4[4];
#pragma unroll
    for (int e = 0; e < 4; ++e) acc4[e] = (f32x4){0.f, 0.f, 0.f, 0.f};
#pragma unroll
    for (int j = 0; j < 4; ++j) { const int k = 4 * lane + 256 * j;
        const f32x4 nw = *(const LAS f32x4*)(nwl + k), sh = *(const LAS f32x4*)(mod + k), sc = *(const LAS f32x4*)(mod + 1024 + k);
        const f32x4 h = (v[j] * rstd) * nw * (sc + 1.0f) + sh;
        *(unsigned*)(H2 + (size_t)row * 1024 + k) = pg8::pk4_fp8(h.x * pg8::FP8_SH2, h.y * pg8::FP8_SH2, h.z * pg8::FP8_SH2, h.w * pg8::FP8_SH2);
#pragma unroll
        for (int c = 0; c < 4; ++c) { const float hk = h[c];
            if (j < 1) {
#pragma unroll
                for (int e4 = 0; e4 < 4; ++e4) acc4[e4] += wr0[c * 4 + e4] * hk;
            } else { const LAS f32x4* wp = (const LAS f32x4*)(wt + ((c + 4 * j) * 256 + lane) * 4);
#pragma unroll
                for (int e4 = 0; e4 < 4; ++e4) acc4[e4] += wp[e4 * 64] * hk; } }
        asm volatile("" ::: "memory"); }
    float acc[16];
#pragma unroll
    for (int e = 0; e < 16; ++e) acc[e] = acc4[e >> 2][e & 3];
    const float val = reduce16(acc, lane);
    float lg[16]; float mx = -3.0e38f;
#pragma unroll
    for (int e = 0; e < 16; ++e) { lg[e] = __shfl(val, e << 2); mx = fmaxf(mx, lg[e]); }
    float sum = 0.f;
#pragma unroll
    for (int e = 0; e < 16; ++e) { lg[e] = __expf(lg[e] - mx); sum += lg[e]; }
    float mine = 0.f;
#pragma unroll
    for (int e = 0; e < 16; ++e) mine = (lane == e) ? lg[e] : mine;
    if (lane < 16) AFF[((size_t)b * 16 + lane) * 2048 + t] = mine / sum;
}
__device__ __forceinline__ void p8_conv_pre(Frame& F, const float* w_gate_, const float* w_up_, const float* w_down_) {
    cv_run(F, w_gate_, w_up_, w_down_, (F.gw < 1024) ? F.gw * CV_S : 1024 * CV_S + (F.gw - 1024) * CV_O, CV_S);
}
__device__ __forceinline__ void p8_phase(Frame& F, const float* norm2_w_, const float* router_w_, const float* w_gate_, const float* w_up_, const float* w_down_, const float* x_, const bool pre_done) {
    LAS float* wt = (LAS float*)F.lds;
    LAS float* nwl = wt + 16384;
    LAS float* mdl = nwl + 1024;
    const float* MOD = WSP(float, WS_MOD); unsigned char* H2 = WSP(unsigned char, WS_H2); float* AFF = WSP(float, WS_AFF);
    {
        f32x4 tw[8], tm[8], tn;
#pragma unroll
        for (int q = 0; q < 8; ++q) { const int idx = F.tid + 512 * q; tw[q] = *(const f32x4*)(router_w_ + 4 * idx); }
#pragma unroll
        for (int q = 0; q < 8; ++q) { const int idx = F.tid + 512 * q; tm[q] = *(const f32x4*)(MOD + (size_t)(idx >> 9) * 6144 + 3072 + (idx & 511) * 4); }
        tn = *(const f32x4*)(norm2_w_ + 4 * (F.tid & 255));
#pragma unroll
        for (int q = 0; q < 8; ++q) { const int idx = F.tid + 512 * q, k = idx >> 2, e4 = idx & 3; *(LAS f32x4*)(wt + ((((k & 3) + 4 * (k >> 8)) * 4 + e4) * 64 + ((k & 255) >> 2)) * 4) = tw[q]; }
#pragma unroll
        for (int q = 0; q < 8; ++q) { const int idx = F.tid + 512 * q; *(LAS f32x4*)(mdl + (idx >> 9) * 2048 + (idx & 511) * 4) = tm[q]; }
        if (F.tid < 256) *(LAS f32x4*)(nwl + 4 * F.tid) = tn;
    }
    const int lane = F.lane;
    const bf16* YL = WSP(bf16, WS_XG); bf16* X1 = WSP(bf16, WS_X1);
#define P8_LOAD(P, row) do { _Pragma("unroll") for (int j_ = 0; j_ < 4; ++j_) P[j_] = *(const f32x4*)(x_ + (size_t)(row) * 1024 + 4 * lane + 256 * j_); } while (0)
#define P8_LOADY(Y, row) do { _Pragma("unroll") for (int j_ = 0; j_ < 4; ++j_) Y[j_] = *(const u32x2*)(YL + (size_t)(row) * 1024 + 4 * lane + 256 * j_); } while (0)
#define P8_ADDY(v, Y) do { _Pragma("unroll") for (int j_ = 0; j_ < 4; ++j_) { v[j_].x += bflo(Y[j_].x); v[j_].y += bfhi(Y[j_].x); v[j_].z += bflo(Y[j_].y); v[j_].w += bfhi(Y[j_].y); } } while (0)
    {
        f32x4 P0[4], P1[4]; u32x2 Y0[4], Y1[4];
        const int r0 = F.gw, st = F.NGW;
        if (r0 < NLAT) { P8_LOAD(P0, r0); P8_LOADY(Y0, r0); }
        if (r0 + st < NLAT) { P8_LOAD(P1, r0 + st); P8_LOADY(Y1, r0 + st); }
        __syncthreads();
        f32x4 wr0[16];
#pragma unroll
        for (int q = 0; q < 16; ++q) wr0[q] = *(const LAS f32x4*)(wt + ((q >> 2) * 256 + (q & 3) * 64 + lane) * 4);
        for (int row = r0; row < NLAT; row += 2 * st) {
            { f32x4 v[4];
#pragma unroll
              for (int j = 0; j < 4; ++j) v[j] = P0[j];
              P8_ADDY(v, Y0);
              if (row + 2 * st < NLAT) { P8_LOAD(P0, row + 2 * st); P8_LOADY(Y0, row + 2 * st); }
              p8_row(wr0, v, row, lane, wt, nwl, mdl, H2, AFF, X1); }
            if (row + st < NLAT) { f32x4 v[4];
#pragma unroll
              for (int j = 0; j < 4; ++j) v[j] = P1[j];
              P8_ADDY(v, Y1);
              if (row + 3 * st < NLAT) { P8_LOAD(P1, row + 3 * st); P8_LOADY(Y1, row + 3 * st); }
              p8_row(wr0, v, row + st, lane, wt, nwl, mdl, H2, AFF, X1); }
        }
    }
#undef P8_LOAD
#undef P8_LOADY
#undef P8_ADDY
    PROF_EV(26);
    asm volatile("s_waitcnt vmcnt(0)" ::: "memory");
    __syncthreads();
    if (F.tid == 0) {
        const unsigned nloc = F.MISC[8];
        bool flush = true;
        if (nloc != 0u) { const unsigned old = __hip_atomic_fetch_add(F.ctl + CW_XSUB3 + 64 * xb_xcc_id(), 1u, RLX_AGENT); flush = (old + 1u == nloc); }
        if (flush) { __builtin_amdgcn_fence(__ATOMIC_RELEASE, "agent"); asm volatile("s_waitcnt vmcnt(0)" ::: "memory"); (void)__hip_atomic_fetch_add(F.ctl + CW_ROWS, 1u, RLX_AGENT); }
        if (blockIdx.x < 128) { unsigned sp = 0u; const unsigned need = F.MISC[9] != 0u ? F.MISC[9] : (unsigned)F.G;
            while (__hip_atomic_load(F.ctl + CW_ROWS, RLX_AGENT) < need && ++sp < (1u << 22)) __builtin_amdgcn_s_sleep(2);
            __builtin_amdgcn_fence(__ATOMIC_ACQUIRE, "agent");
            asm volatile("s_waitcnt vmcnt(0)" ::: "memory"); }
    }
    __syncthreads();
    if (blockIdx.x < 128) p9_phase(F);
    PROF_EV(27);
#ifndef P8_NOCONV
    if (pre_done) { if (F.gw >= 1024) cv_run(F, w_gate_, w_up_, w_down_, 1024 * CV_S + (F.gw - 1024) * CV_O + CV_S, CV_O - CV_S); }
    else cv_run(F, w_gate_, w_up_, w_down_, (F.gw < 1024) ? F.gw * CV_S : 1024 * CV_S + (F.gw - 1024) * CV_O, (F.gw < 1024) ? CV_S : CV_O);
#endif
}

__device__ __forceinline__ void p9_phase(Frame& F) {
    const float* AFF = WSP(float, WS_AFF); int* IDX = WSP(int, WS_IDX); float* GATE = WSP(float, WS_GATE); int* INV = WSP(int, WS_INV);
    int* XROW = WSP(int, WS_XROW);
    LAS unsigned* hist = (LAS unsigned*)F.lds;
    LAS unsigned* wtot = hist + 1024;
    const int lane = F.lane;
    for (int be = blockIdx.x; be < 128; be += F.G) {
        const int b = be >> 4, e = be & 15;
        const f32x4 av = *(const f32x4*)(AFF + (size_t)be * 2048 + 4 * F.tid);
        const float af0 = av.x, af1 = av.y, af2 = av.z, af3 = av.w;
        const unsigned key[4] = {__builtin_bit_cast(unsigned, af0), __builtin_bit_cast(unsigned, af1), __builtin_bit_cast(unsigned, af2), __builtin_bit_cast(unsigned, af3)};
        __syncthreads();
        hist[F.tid] = 0u; hist[F.tid + 512] = 0u;
        __syncthreads();
        unsigned prefix = 0u, need = 256u;
#pragma unroll
        for (int pass = 0; pass < 4; ++pass) {
            const int shift = 24 - 8 * pass;
            LAS unsigned* h = hist + 256 * pass;
#pragma unroll
            for (int q = 0; q < 4; ++q) if (pass == 0 || ((key[q] ^ prefix) >> ((shift + 8) & 31)) == 0u) (void)__hip_atomic_fetch_add(h + ((key[q] >> shift) & 255u), 1u, __ATOMIC_RELAXED, __HIP_MEMORY_SCOPE_WORKGROUP);
            __syncthreads();
            const v4u hv = *(const LAS v4u*)(h + 4 * lane);
            const unsigned s4 = hv.x + hv.y + hv.z + hv.w;
            unsigned suf = s4;
#pragma unroll
            for (int o = 1; o < 64; o <<= 1) { const unsigned t = __shfl_down(suf, o); if (lane + o < 64) suf += t; }
            const unsigned a3 = suf - s4, a2 = a3 + hv.w, a1 = a2 + hv.z, a0 = a1 + hv.y;
            int fnd = -1; unsigned na = 0u;
            if (a3 < need && need <= a3 + hv.w) { fnd = 3; na = a3; }
            else if (a2 < need && need <= a2 + hv.z) { fnd = 2; na = a2; }
            else if (a1 < need && need <= a1 + hv.y) { fnd = 1; na = a1; }
            else if (a0 < need && need <= a0 + hv.x) { fnd = 0; na = a0; }
            const unsigned long long bm = __ballot(fnd >= 0);
            const int L = bm ? __builtin_ctzll(bm) : 0;
            const unsigned v = 4u * (unsigned)L + (unsigned)__shfl(fnd, L);
            need -= (unsigned)__shfl((int)na, L);
            prefix |= v << shift;
        }
        const unsigned T = prefix, R = need;
        unsigned gt[4], eq[4], c = 0u;
#pragma unroll
        for (int q = 0; q < 4; ++q) { gt[q] = key[q] > T ? 1u : 0u; eq[q] = key[q] == T ? 1u : 0u; c += gt[q] + (eq[q] << 16); }
        unsigned inc = c;
#pragma unroll
        for (int o = 1; o < 64; o <<= 1) { const unsigned t = __shfl_up(inc, o); if (lane >= o) inc += t; }
        if (lane == 63) wtot[F.wave] = inc;
        __syncthreads();
        unsigned base = 0u;
#pragma unroll
        for (int w = 0; w < 8; ++w) { const unsigned t = wtot[w]; if (w < F.wave) base += t; }
        unsigned run = base + inc - c;
        const unsigned G0 = 256u - R;
#pragma unroll
        for (int q = 0; q < 4; ++q) { const int tok = 4 * F.tid + q; const unsigned g = run & 0xffffu, er = run >> 16;
            const int p = gt[q] ? (int)g : ((eq[q] && er < R) ? (int)(G0 + er) : -1);
            if (p >= 0) { IDX[be * 256 + p] = tok; GATE[be * 256 + p] = __builtin_bit_cast(float, key[q]); XROW[(e * 8 + b) * 256 + p] = b * 2048 + tok; }
            INV[((size_t)b * 2048 + tok) * 16 + e] = p;
            run += gt[q] + (eq[q] << 16); }
    }
    __syncthreads();
}

#define ACC16(p, q) do { acc[0] += bflo(p.x); acc[1] += bfhi(p.x); acc[2] += bflo(p.y); acc[3] += bfhi(p.y); acc[4] += bflo(p.z); acc[5] += bfhi(p.z); acc[6] += bflo(p.w); acc[7] += bfhi(p.w); \
    acc[8] += bflo(q.x); acc[9] += bfhi(q.x); acc[10] += bflo(q.y); acc[11] += bfhi(q.y); acc[12] += bflo(q.z); acc[13] += bfhi(q.z); acc[14] += bflo(q.w); acc[15] += bfhi(q.w); } while (0)
typedef float f32x2v __attribute__((ext_vector_type(2)));
#define ACC16F8(p, g_) do { _Pragma("unroll") for (int d_ = 0; d_ < 4; ++d_) { const int w_ = (int)p[d_]; const f32x2v lo_ = __builtin_amdgcn_cvt_pk_f32_fp8(w_, false), hi_ = __builtin_amdgcn_cvt_pk_f32_fp8(w_, true); \
        acc[4 * d_] += g_ * lo_.x; acc[4 * d_ + 1] += g_ * lo_.y; acc[4 * d_ + 2] += g_ * hi_.x; acc[4 * d_ + 3] += g_ * hi_.y; } } while (0)
__device__ __forceinline__ void p13_phase(Frame& F, int rep, const float* x_) {
    const unsigned char* YB = WSP(unsigned char, WS_YB); const int* INV = WSP(int, WS_INV); const float* MOD = WSP(float, WS_MOD);
    const int lane = F.lane;
    const bf16* X1 = WSP(bf16, WS_X1);
    LAS float* g2l = (LAS float*)F.lds;
    { f32x4 t4[4];
#pragma unroll
      for (int q = 0; q < 4; ++q) { const int idx = F.tid + 512 * q; t4[q] = *(const f32x4*)(MOD + (size_t)(idx >> 8) * 6144 + 5120 + (idx & 255) * 4) * (1.0f / pg8::FP8_SYB); }
#pragma unroll
      for (int q = 0; q < 4; ++q) { const int idx = F.tid + 512 * q; *(LAS f32x4*)(g2l + (idx >> 8) * 1024 + (idx & 255) * 4) = t4[q]; } }
    const int st = F.NGW;
#define P13_INV(r_) (((r_) < NLAT && lane < 16) ? INV[(size_t)(r_) * 16 + lane] : -1)
#define P13_XY(Y0, Y1, r_) do { const v4u* yp_ = (const v4u*)(X1 + (size_t)(r_) * 1024 + 16 * lane); Y0 = yp_[0]; Y1 = yp_[1]; } while (0)
#define P13_SEL(inv_, b_, A0, A1, A2, W0, W1, W2, MR) do { const unsigned long long m0_ = __ballot((inv_) >= 0), m1_ = m0_ & (m0_ - 1), m2_ = m1_ & (m1_ - 1); MR = m2_ & (m2_ - 1); \
        const int e0_ = m0_ ? __builtin_ctzll(m0_) : 0, e1_ = m1_ ? __builtin_ctzll(m1_) : e0_, e2_ = m2_ ? __builtin_ctzll(m2_) : e0_; \
        const int s0_ = m0_ ? __shfl((inv_), e0_) : 0, s1_ = m1_ ? __shfl((inv_), e1_) : s0_, s2_ = m2_ ? __shfl((inv_), e2_) : s0_; \
        A0 = (const v4u*)(YB + ((size_t)(e0_ * 8 + (b_)) * 256 + s0_) * 1024 + 16 * lane); A1 = (const v4u*)(YB + ((size_t)(e1_ * 8 + (b_)) * 256 + s1_) * 1024 + 16 * lane); \
        A2 = (const v4u*)(YB + ((size_t)(e2_ * 8 + (b_)) * 256 + s2_) * 1024 + 16 * lane); W0 = m0_ ? 1.f : 0.f; W1 = m1_ ? 1.f : 0.f; W2 = m2_ ? 1.f : 0.f; } while (0)
    int inv_c, inv_n; v4u yc0, yc1, yn0, yn1;
    v4u pc[3], pn[3]; float wc[3], wn[3]; unsigned long long mrc, mrn;
    const int r0 = F.gw;
    if (r0 >= NLAT) return;
    inv_c = P13_INV(r0); inv_n = P13_INV(r0 + st);
    P13_XY(yc0, yc1, r0);
    { const v4u *a0, *a1, *a2; P13_SEL(inv_c, r0 >> 11, a0, a1, a2, wc[0], wc[1], wc[2], mrc); pc[0] = a0[0]; pc[1] = a1[0]; pc[2] = a2[0]; }
    __syncthreads();
    for (int row = r0; row < NLAT; row += st) {
        const int b = row >> 11; const int rn = row + st; const bool more = rn < NLAT;
        int inv_nn = -1;
        if (more) { const v4u *a0, *a1, *a2; P13_SEL(inv_n, rn >> 11, a0, a1, a2, wn[0], wn[1], wn[2], mrn); pn[0] = a0[0]; pn[1] = a1[0]; pn[2] = a2[0];
            P13_XY(yn0, yn1, rn); inv_nn = P13_INV(rn + st); }
        f32x4 xv4[4];
        xv4[0] = (f32x4){bflo(yc0.x), bfhi(yc0.x), bflo(yc0.y), bfhi(yc0.y)}; xv4[1] = (f32x4){bflo(yc0.z), bfhi(yc0.z), bflo(yc0.w), bfhi(yc0.w)};
        xv4[2] = (f32x4){bflo(yc1.x), bfhi(yc1.x), bflo(yc1.y), bfhi(yc1.y)}; xv4[3] = (f32x4){bflo(yc1.z), bfhi(yc1.z), bflo(yc1.w), bfhi(yc1.w)};
        float acc[16];
#pragma unroll
        for (int j = 0; j < 16; ++j) acc[j] = 0.f;
        ACC16F8(pc[0], wc[0]); ACC16F8(pc[1], wc[1]); ACC16F8(pc[2], wc[2]);
        unsigned long long mm = mrc;
        while (mm) { const int e = __builtin_ctzll(mm); mm &= mm - 1; const int slot = __shfl(inv_c, e);
            const v4u p = *(const v4u*)(YB + ((size_t)(e * 8 + b) * 256 + slot) * 1024 + 16 * lane); ACC16F8(p, 1.0f); }
        float* op = F.out + (size_t)row * 1024 + 16 * lane;
#pragma unroll
        for (int q = 0; q < 4; ++q) { const f32x4 gv = *(const LAS f32x4*)(g2l + b * 1024 + 16 * lane + 4 * q);
            *(f32x4*)(op + 4 * q) = xv4[q] + gv * (f32x4){acc[4 * q], acc[4 * q + 1], acc[4 * q + 2], acc[4 * q + 3]}; }
        inv_c = inv_n; inv_n = inv_nn; mrc = mrn;
        yc0 = yn0; yc1 = yn1;
#pragma unroll
        for (int e = 0; e < 3; ++e) { pc[e] = pn[e]; wc[e] = wn[e]; }
    }
#undef P13_INV
#undef P13_XY
#undef P13_SEL
    (void)rep; (void)x_;
}
#undef ACC16F8
#undef ACC16

struct Args { const float* in[20]; float* out; unsigned char* ws; int ph_lo, ph_hi, rep, pad; };
__global__ void __launch_bounds__(512, 2) hyb_fwd(Args args) {
    extern __shared__ __attribute__((aligned(16))) unsigned char lds[];
    Frame F;
    F.lds = (LAS unsigned char*)lds; F.ldsg = lds;
    F.MISC = (volatile LAS unsigned*)(F.lds + MISC_OFF);
    F.tid = threadIdx.x; F.lane = F.tid & 63; F.wave = __builtin_amdgcn_readfirstlane(F.tid >> 6);
    F.G = gridDim.x; F.gw = blockIdx.x * 8 + F.wave; F.NGW = F.G * 8;
    F.ws = args.ws; F.ctl = (gu32*)(args.ws + WS_CTL); F.out = args.out;
    for (int u = F.tid; u < (LDS_BYTES - 131072) / 4; u += 512) ((LAS unsigned*)(F.lds + 131072))[u] = 0u;
    __syncthreads();
    const int lo = args.ph_lo, hi = args.ph_hi;
    XcdBarrier bar; bar.bar = (unsigned*)(F.ctl + CW_BAR); bar.x = 0; bar.st = nullptr;
    if (hi - lo > 1) bar = xcd_barrier_post((unsigned*)(F.ctl + CW_BAR), F.MISC + 8);
    if (hi - lo > 1 && blockIdx.x >= 192 && F.tid == 0) (void)__hip_atomic_fetch_add(F.ctl + CW_XCNTS + 16 * xb_xcc_id(), 1u, RLX_AGENT);
#define IN(k) (lo <= (k) && (k) < hi)
#ifndef PHMASK
#define PHMASK 0xFFFF
#endif
#define PHEN(k) (((PHMASK) >> (k)) & 1)
#define SEAM(k) do { if (IN(k) && IN((k) + 1)) xcd_barrier(bar); } while (0)
    PROF_EV(0);
    if (IN(0) && PHEN(0)) p0_phase(F, args.in[1], args.in[3], args.in[4], args.in[5], args.in[8], args.in[15]);
    PROF_EV(1);
    SEAM(0);
    PROF_EV(2);
    if (IN(1) && PHEN(1)) p1_phase(F, args.in[0], args.in[2], args.in[6], args.in[8], args.in[12], args.in[13], args.rep);
    PROF_EV(3);
    SEAM(1);
    PROF_EV(4);
    if (IN(2) && PHEN(2)) { pg8::Gemm g{WSP(bf16, WS_XN), WSP(bf16, WS_WIN), MROWS, NIN, 1024, nullptr}; pg8::SchedIn S{F.G, (int)blockIdx.x}; pg8::EpiIn E{WSP(bf16, WS_PA), WSP(bf16, WS_PD), WSP(bf16, WS_PZ)};
        pg8::gemm_phase<pg8::EpiIn, pg8::SchedIn, true, true>(F.lds, g, S, E); }
    PROF_EV(5);
    SEAM(2);
    PROF_EV(6);
    if (IN(3) && PHEN(3)) p3_phase(F, args.in[9], args.in[10], args.in[11], args.rep);
    PROF_EV(7);
    SEAM(3);
    PROF_EV(8);
    if (IN(4) && PHEN(4)) {
        if (args.rep == 0) {
            p4_phase(F, 0, 2048);
            PROF_EV(20);
            asm volatile("s_waitcnt vmcnt(0)" ::: "memory");
            __syncthreads();
            if (F.tid == 0) {
                const unsigned nloc = F.MISC[8];
                bool flush = true;
                if (nloc != 0u) { const unsigned old = __hip_atomic_fetch_add(F.ctl + CW_XSUB2 + 64 * xb_xcc_id(), 1u, RLX_AGENT); flush = (old + 1u == nloc); }
                if (flush) { __builtin_amdgcn_fence(__ATOMIC_RELEASE, "agent"); asm volatile("s_waitcnt vmcnt(0)" ::: "memory"); (void)__hip_atomic_fetch_add(F.ctl + CW_TOP2, 1u, RLX_AGENT); }
            }
            if (blockIdx.x < 32) {
                p4_phase(F, 2048, 2304);
                asm volatile("s_waitcnt vmcnt(0)" ::: "memory");
                __syncthreads();
                if (F.tid == 0) { __builtin_amdgcn_fence(__ATOMIC_RELEASE, "agent"); asm volatile("s_waitcnt vmcnt(0)" ::: "memory"); }
                __syncthreads();
                if (F.tid < 8) { const int gw = (int)blockIdx.x * 8 + F.tid; (void)__hip_atomic_fetch_add(F.ctl + CW_CHAIN2 + (gw >> 3) * 2 + (gw & 1), 1u, RLX_AGENT); }
            }
            PROF_EV(25);
        }
        __syncthreads(); p5_phase(F, args.rep, args.in[9], args.in[14], args.in[17], args.in[18], args.in[19]); }
    PROF_EV(9);
    SEAM(4);
    PROF_EV(10);
    if (IN(5) && PHEN(5)) { pg8::Gemm g{WSP(bf16, WS_Y), WSP(bf16, WS_WOUT), NLAT, 1024, 1024, nullptr}; pg8::StaticOrder S; S.init(NLAT, 1024, F.G, (int)blockIdx.x); pg8::EpiOut E{WSP(float, WS_MOD), WSP(bf16, WS_XG)};
        pg8::gemm_phase<pg8::EpiOut, pg8::StaticOrder, false, true>(F.lds, g, S, E); }
    PROF_EV(11);
#ifndef SPLIT5
#define SPLIT5 1
#endif
    const bool split5 = SPLIT5 && IN(5) && IN(6);
    if (split5) { xcd_barrier_arrive(bar, F.MISC + 12); p8_conv_pre(F, args.in[17], args.in[18], args.in[19]); xcd_barrier_wait(bar, F.MISC + 12); }
    else SEAM(5);
    PROF_EV(12);
    if (IN(6) && PHEN(6)) p8_phase(F, args.in[7], args.in[16], args.in[17], args.in[18], args.in[19], args.in[0], split5);
    PROF_EV(13);
    SEAM(6);
    PROF_EV(14);
    if (IN(7) && PHEN(7)) { pg8::Gemm g{WSP(bf16, WS_H2), WSP(bf16, WS_WGU), 32768, 32768, 512, WSP(int, WS_XROW)}; pg8::SchedExp<8> S{F.G, (int)blockIdx.x}; pg8::EpiGLU E{WSP(unsigned char, WS_HID)};
        pg8::gemm_phase<pg8::EpiGLU, pg8::SchedExp<8>, true, true, true, true>(F.lds, g, S, E); }
    PROF_EV(15);
    SEAM(7);
    PROF_EV(16);
    if (IN(8) && PHEN(8)) { pg8::Gemm g{WSP(bf16, WS_HID), WSP(bf16, WS_WD), 32768, 16384, 512, nullptr}; pg8::SchedExp<4> S{F.G, (int)blockIdx.x}; pg8::EpiDown E{WSP(unsigned char, WS_YB), WSP(float, WS_GATE)};
        pg8::gemm_phase<pg8::EpiDown, pg8::SchedExp<4>, true, true, false, true>(F.lds, g, S, E); }
    PROF_EV(17);
    SEAM(8);
    PROF_EV(18);
    if (IN(9) && PHEN(9)) p13_phase(F, args.rep, args.in[0]);
    PROF_EV(19);
#ifdef PROF
    if (hi - lo > 1) { asm volatile("s_waitcnt vmcnt(0)" ::: "memory"); __syncthreads(); if (F.tid == 0) { asm volatile("s_waitcnt vmcnt(0)" ::: "memory"); (void)__hip_atomic_fetch_add(F.ctl + PROF_WORD - 64, 1u, RLX_AGENT); } }
    if (blockIdx.x == 0 && hi - lo > 1) {
        LAS unsigned* pm = (LAS unsigned*)(F.lds + 131072);
        if (F.tid == 0) { unsigned sp = 0u; while (__hip_atomic_load(F.ctl + PROF_WORD - 64, RLX_AGENT) < (unsigned)F.G && ++sp < (1u << 22)) __builtin_amdgcn_s_sleep(2); }
        __syncthreads();
        if (F.tid < 4) pm[F.tid] = (F.tid & 1) ? 0u : 0xffffffffu;
        __syncthreads();
        if (F.tid < 256) { const int b_ = F.tid;
            (void)__hip_atomic_fetch_min(pm + 0, __hip_atomic_load(F.ctl + PROF_WORD + PROF_REF_A * 256 + b_, RLX_AGENT), __ATOMIC_RELAXED, __HIP_MEMORY_SCOPE_WORKGROUP);
            if (b_ >= PROF_LO_A && b_ < PROF_HI_A) { const unsigned va = __hip_atomic_load(F.ctl + PROF_WORD + PROF_EV_A * 256 + b_, RLX_AGENT); (void)__hip_atomic_fetch_min(pm + 2, va, __ATOMIC_RELAXED, __HIP_MEMORY_SCOPE_WORKGROUP); (void)__hip_atomic_fetch_max(pm + 3, va, __ATOMIC_RELAXED, __HIP_MEMORY_SCOPE_WORKGROUP); } }
        __syncthreads();
        if (F.tid == 0) { const int ticks = (int)((PROF_MAX_A ? pm[3] : pm[2]) - pm[0]); const unsigned long long t0 = __builtin_amdgcn_s_memrealtime();
            if (ticks > 0 && ticks < 100000) while ((long long)(__builtin_amdgcn_s_memrealtime() - t0) < (long long)ticks * PROF_MULT) __builtin_amdgcn_s_sleep(8); }
    }
#endif
#undef IN
#undef SEAM
}

extern "C" void kernel_launch(void* const* d_in, const int* in_sizes, int n_in, void* d_out, int out_size, void* d_ws, size_t ws_size, hipStream_t stream) {
    static int grid = 0;
    if (grid == 0) {
        if (n_in != 20 || out_size != NLAT * 1024 || ws_size < WS_NEED) { fprintf(stderr, "kernel_launch: unexpected problem (n_in %d, out %d, ws %zu < %zu)\n", n_in, out_size, ws_size, (size_t)WS_NEED); grid = -1; return; }
        int dev = 0, cus = 0;
        if (hipGetDevice(&dev) != hipSuccess || hipDeviceGetAttribute(&cus, hipDeviceAttributeMultiprocessorCount, dev) != hipSuccess) { grid = -1; return; }
        if (hipFuncSetAttribute((const void*)hyb_fwd, hipFuncAttributeMaxDynamicSharedMemorySize, LDS_BYTES) != hipSuccess) { fprintf(stderr, "kernel_launch: hipFuncSetAttribute failed\n"); grid = -1; return; }
        (void)hipGetLastError();
        int per_cu = 0;
        if (hipOccupancyMaxActiveBlocksPerMultiprocessor(&per_cu, (const void*)hyb_fwd, 512, LDS_BYTES) != hipSuccess || per_cu < 1 || (long)cus * per_cu < 256) {
            fprintf(stderr, "kernel_launch: %d CUs x %d resident workgroups per CU cannot hold the 256-workgroup grid\n", cus, per_cu); grid = -1; return; }
        grid = 256;
        if (cus != 256) fprintf(stderr, "kernel_launch: device reports %d CUs; this kernel is built for 256\n", cus);
    }
    if (grid < 0) return;
    (void)hipMemsetAsync((char*)d_ws + WS_CTL, 0, CTL_ZERO_BYTES, stream);
    Args a{};
    for (int i = 0; i < 20; ++i) a.in[i] = (const float*)d_in[i];
    a.out = (float*)d_out; a.ws = (unsigned char*)d_ws;
#if MK_MULTI
    for (int p = 0; p <= NPHASE; ++p) { a.ph_lo = p; a.ph_hi = p + 1; a.rep = 0; hipLaunchKernelGGL(hyb_fwd, dim3(grid), dim3(512), LDS_BYTES, stream, a);
#ifdef REP_PHASE
        if (p == REP_PHASE) { a.rep = REP_VAL; hipLaunchKernelGGL(hyb_fwd, dim3(grid), dim3(512), LDS_BYTES, stream, a); }
#endif
    }
#else
    a.ph_lo = 0; a.ph_hi = NPHASE + 1;
    hipLaunchKernelGGL(hyb_fwd, dim3(grid), dim3(512), LDS_BYTES, stream, a);
#endif
}
```
